# Optimizing an MI355X kernel written in HIP

```python
import jax, jax.numpy as jnp
from jax import lax
import numpy as np

D_MODEL = 1024
BATCH = 8
SEQ = 2048
DEPTH = 1
DEC_BATCH = 128
DEC_SEQ = 1
PAST_LEN = 16384
PAGE_SIZE = 128

MIX_W = D_MODEL
CONV_CH = MIX_W // 2
RW = MIX_W - CONV_CH
HEAD_DIM = 64
N_HEADS = RW // HEAD_DIM
CONV_K = 3
LORA_W = 64
LORA_A = 64
D_PLE = 256
SHIFT_W = 3 * RW + LORA_W + LORA_A
IN_W = 4 * CONV_CH + SHIFT_W + RW
RMS_EPS = 1e-6
GN_EPS = 64e-5

kernel_name = "hymba_conv_rwkv7_step"


def _rmsnorm(x, g):
    xf = x.astype(jnp.float32)
    y = xf * lax.rsqrt(jnp.mean(xf * xf, axis=-1, keepdims=True) + RMS_EPS)
    return (y * g.astype(jnp.float32)).astype(x.dtype)


def _wkv7(r, decay, k, v, kk, a, s0):
    seq = tuple(jnp.moveaxis(t, 1, 0) for t in (r, decay, k, v, kk, a))

    def step(s, inp):
        r_t, w_t, k_t, v_t, kk_t, a_t = inp
        sa = jnp.einsum('bhvk,bhk->bhv', s, -kk_t)
        s = (s * w_t[:, :, None, :]
             + sa[..., None] * (kk_t * a_t)[:, :, None, :]
             + v_t[..., None] * k_t[:, :, None, :])
        y = jnp.einsum('bhvk,bhk->bhv', s, r_t)
        return s, y

    s_T, ys = lax.scan(step, s0, seq)
    return jnp.moveaxis(ys, 0, 1), s_T


def _layer(h, p, conv_buf, shift_buf, wkv_state, norm_g, w_in, conv_w, mu_shift, w0, w_up,
           a0, a_up, k_k, k_a, r_k, ln_w, ln_b, w_out, w_pg, w_pp):
    bsz, t_len, _ = h.shape
    f32 = jnp.float32
    xn = _rmsnorm(h, norm_g)
    z = xn @ w_in
    zB, zC, zh, gA, zs, gR = jnp.split(
        z, [CONV_CH, 2 * CONV_CH, 3 * CONV_CH, 4 * CONV_CH, 4 * CONV_CH + SHIFT_W], axis=-1)

    u = zC * zh
    u_ext = jnp.concatenate([conv_buf.astype(u.dtype), u], axis=1)
    conv = (conv_w[0] * u_ext[:, :t_len] + conv_w[1] * u_ext[:, 1:t_len + 1]
            + conv_w[2] * u_ext[:, 2:t_len + 2])
    y_a = zB * conv * jax.nn.silu(gA)
    new_conv = u_ext[:, -(CONV_K - 1):]

    zs_prev = jnp.concatenate([shift_buf.astype(zs.dtype)[:, None], zs[:, :-1]], axis=1)
    zm = zs + (zs_prev - zs) * mu_shift
    new_shift = zs[:, -1]
    r, k, v, wd, ad = jnp.split(zm, [RW, 2 * RW, 3 * RW, 3 * RW + LORA_W], axis=-1)
    r, k, v, wd, ad = (t.astype(f32) for t in (r, k, v, wd, ad))
    wlog = -jax.nn.softplus(-(w0.astype(f32) + jnp.tanh(wd) @ w_up.astype(f32))) - 0.5
    decay = jnp.exp(-jnp.exp(wlog))
    a = jax.nn.sigmoid(a0.astype(f32) + ad @ a_up.astype(f32))
    kk = k * k_k.astype(f32)
    k = k * (1.0 + (a - 1.0) * k_a.astype(f32))

    def hd(t):
        return t.reshape(bsz, t_len, N_HEADS, HEAD_DIM)

    r, decay, k, v, kk, a = (hd(t) for t in (r, decay, k, v, kk, a))
    kk = kk / jnp.maximum(jnp.sqrt(jnp.sum(kk * kk, axis=-1, keepdims=True)), 1e-12)
    o, s_T = _wkv7(r, decay, k, v, kk, a, wkv_state.astype(f32))
    mean = jnp.mean(o, axis=-1, keepdims=True)
    var = jnp.mean(jnp.square(o - mean), axis=-1, keepdims=True)
    o = (o - mean) * lax.rsqrt(var + GN_EPS)
    o = o.reshape(bsz, t_len, RW) * ln_w.astype(f32) + ln_b.astype(f32)
    bonus = jnp.sum(r * k * r_k.astype(f32), axis=-1, keepdims=True) * v
    o = o + bonus.reshape(bsz, t_len, RW)
    y_r = o.astype(h.dtype) * jax.nn.silu(gR)

    h = h + jnp.concatenate([y_a, y_r], axis=-1) @ w_out
    h = h + jax.nn.sigmoid(h @ w_pg) * (p @ w_pp)
    return h, new_conv, new_shift, s_T


def setup_inputs(seed: int = 0) -> dict:
    key = jax.random.key(seed)
    ks = jax.random.split(key, 24)

    def nrm(k, shape, scale):
        return jax.random.normal(k, shape, jnp.float32) * scale

    return {
        "x_prompt": nrm(ks[0], (BATCH, SEQ, D_MODEL), 1.0),
        "x_sample": nrm(ks[1], (DEC_BATCH, DEC_SEQ, D_MODEL), 1.0),
        "p_prompt": nrm(ks[2], (DEPTH, BATCH, SEQ, D_PLE), 1.0),
        "p_sample": nrm(ks[3], (DEPTH, DEC_BATCH, DEC_SEQ, D_PLE), 1.0),
        "state_conv": nrm(ks[4], (DEPTH, DEC_BATCH, CONV_K - 1, CONV_CH), 1.0),
        "state_shift": nrm(ks[5], (DEPTH, DEC_BATCH, SHIFT_W), 1.0),
        "state_wkv": nrm(ks[6], (DEPTH, DEC_BATCH, N_HEADS, HEAD_DIM, HEAD_DIM), 0.3),
        "norm_g": 1.0 + nrm(ks[7], (DEPTH, D_MODEL), 0.02),
        "w_in": nrm(ks[8], (DEPTH, D_MODEL, IN_W), D_MODEL ** -0.5),
        "conv_w": nrm(ks[9], (DEPTH, CONV_K, CONV_CH), CONV_K ** -0.5),
        "mu_shift": jax.random.uniform(ks[10], (DEPTH, SHIFT_W), jnp.float32, 0.0, 1.0),
        "w0": jax.random.uniform(ks[11], (DEPTH, RW), jnp.float32, -4.0, -0.5),
        "w_up": nrm(ks[12], (DEPTH, LORA_W, RW), 0.5 * LORA_W ** -0.5),
        "a0": nrm(ks[13], (DEPTH, RW), 0.1),
        "a_up": nrm(ks[14], (DEPTH, LORA_A, RW), LORA_A ** -0.5),
        "k_k": 0.85 + nrm(ks[15], (DEPTH, RW), 0.05),
        "k_a": 1.0 + nrm(ks[16], (DEPTH, RW), 0.05),
        "r_k": nrm(ks[17], (DEPTH, N_HEADS, HEAD_DIM), 0.1),
        "ln_w": 1.0 + nrm(ks[18], (DEPTH, RW), 0.02),
        "ln_b": nrm(ks[19], (DEPTH, RW), 0.02),
        "w_out": nrm(ks[20], (DEPTH, MIX_W, D_MODEL), MIX_W ** -0.5),
        "w_pg": nrm(ks[21], (DEPTH, D_MODEL, D_MODEL), D_MODEL ** -0.5),
        "w_pp": nrm(ks[22], (DEPTH, D_PLE, D_MODEL), D_PLE ** -0.5),
        "final_g": 1.0 + nrm(ks[23], (D_MODEL,), 0.02),
    }


def reference(x_prompt, x_sample, p_prompt, p_sample, state_conv, state_shift, state_wkv,
              norm_g, w_in, conv_w, mu_shift, w0, w_up, a0, a_up, k_k, k_a, r_k, ln_w, ln_b,
              w_out, w_pg, w_pp, final_g):
    hp, hs = x_prompt, x_sample
    bp = x_prompt.shape[0]
    cps, sps, wps, css, sss, wss = [], [], [], [], [], []
    for i in range(DEPTH):
        wi = (norm_g[i], w_in[i], conv_w[i], mu_shift[i], w0[i], w_up[i], a0[i], a_up[i],
              k_k[i], k_a[i], r_k[i], ln_w[i], ln_b[i], w_out[i], w_pg[i], w_pp[i])
        zc = jnp.zeros((bp, CONV_K - 1, CONV_CH), hp.dtype)
        zsh = jnp.zeros((bp, SHIFT_W), hp.dtype)
        zw = jnp.zeros((bp, N_HEADS, HEAD_DIM, HEAD_DIM), jnp.float32)
        hp, cp, sp, wp = _layer(hp, p_prompt[i], zc, zsh, zw, *wi)
        hs, cs, ss, ws = _layer(hs, p_sample[i], state_conv[i], state_shift[i], state_wkv[i], *wi)
        cps.append(cp); sps.append(sp); wps.append(wp)
        css.append(cs); sss.append(ss); wss.append(ws)
    y_prompt = _rmsnorm(hp, final_g)
    y_sample = _rmsnorm(hs, final_g)
    return (y_prompt, y_sample, jnp.stack(cps), jnp.stack(sps), jnp.stack(wps),
            jnp.stack(css), jnp.stack(sss), jnp.stack(wss))
```

```cpp
#include <hip/hip_runtime.h>
#include <hip/hip_cooperative_groups.h>
#include <cstdio>
namespace pg8 {
#define PG8_LAS __attribute__((address_space(3)))
typedef unsigned short bf16_t;
typedef short bf16x8 __attribute__((ext_vector_type(8)));
typedef float f32x4 __attribute__((ext_vector_type(4)));
typedef unsigned u32x4 __attribute__((ext_vector_type(4)));
constexpr int BM = 256, BK = 64, HALF = 128, HTB = HALF * BK * 2  , STAGE_BYTES = 8 * HTB, NXCD = 8, WGM = 8;

__host__ __device__ __forceinline__ int lds_byte(int r, int c) { const int st = (r >> 4) * 2 + (c >> 5), rr = r & 15, cc = c & 31, ob = rr * 64 + cc * 2; return st * 1024 + (ob ^ (((ob >> 9) & 1) << 5)); }
__host__ __device__ __forceinline__ void stage_rc(int b, int& R, int& C) { const int st = b / 1024, sb = b % 1024, swz = sb ^ (((sb >> 9) & 1) << 5); R = (st >> 1) * 16 + swz / 64; C = (st & 1) * 32 + (swz % 64) / 2; }
__host__ __device__ __forceinline__ int perm32(int rho) { const int n = rho >> 4, i = rho & 15; return 8 * (i >> 2) + 4 * n + (i & 3); }

struct Unit { int pm, pn; };
struct Gemm { const bf16_t* A; const bf16_t* Bt; int M, N, K; };

struct StaticOrder {
    int nM, nN, nwg, G, c;
    __host__ __device__ void init(int M, int N, int G_, int c_) { nM = M / BM; nN = N / BM; nwg = nM * nN; G = G_; c = c_; }
    __host__ __device__ bool next(int i, Unit& u) const {
        const long L = (long)i * G + c; if (L >= nwg) return false;
        int wgid = (int)L; { const int q = nwg / NXCD, r = nwg % NXCD, xcd = wgid % NXCD, off = wgid / NXCD; wgid = (xcd < r ? xcd * (q + 1) : r * (q + 1) + (xcd - r) * q) + off; }
        const int nig = WGM * nN, gid = wgid / nig, fm = gid * WGM, gsz = (nM - fm) < WGM ? (nM - fm) : WGM;
        u.pm = fm + ((wgid % nig) % gsz); u.pn = (wgid % nig) / gsz; return true;
    }
    __device__ __forceinline__ void a_ready(const Unit&) const {}
    __device__ __forceinline__ void done(const Unit&) const {}
};
__device__ __forceinline__ unsigned cvt_pk_bf16(float lo, float hi) { unsigned r; asm volatile("v_cvt_pk_bf16_f32 %0, %1, %2" : "=v"(r) : "v"(lo), "v"(hi)); return r; }
template <class Epi, class Sched, bool STAMP = false>
__device__ __forceinline__ void gemm_phase(PG8_LAS unsigned char* lds, const Gemm g, const Sched& S, const Epi& E, unsigned long long* stamps) {
    const int tid = threadIdx.x, wid = __builtin_amdgcn_readfirstlane(tid >> 6), lane = tid & 63, wr = wid >> 2, wc = wid & 3, fr = lane & 15, fq = lane >> 4;
    const int K = g.K, nt = K / BK;
    int ts_lo = 0, ts_hi = 0, nts = 0; const unsigned long long rt_entry = STAMP ? (unsigned long long)wall_clock64() : 0ull;
#define PG8_STAMP() do { if (STAMP && wid == 0 && nts < 64) { const unsigned long long _c = (unsigned long long)clock64(); \
        ts_lo = (lane == nts) ? (int)(unsigned)_c : ts_lo; ts_hi = (lane == nts) ? (int)(unsigned)(_c >> 32) : ts_hi; ++nts; } } while (0)
    PG8_STAMP();
    unsigned voffA[2], voffB[2];
#pragma unroll
    for (int i = 0; i < 2; ++i) { int R, C; stage_rc(tid * 16 + i * 8192, R, C); const int Rb = Epi::PERM ? ((R & ~31) + perm32(R & 31)) : R;
        voffA[i] = (unsigned)(R * K + C) * 2u; voffB[i] = (unsigned)(Rb * K + C) * 2u; }
    const size_t kstep = (size_t)(BK * 2);
    const size_t hstep = (size_t)HALF * K * 2;
    const size_t tstep = 2 * hstep;
    const unsigned ldsw = (unsigned)wid * 1024u;
    const int aoff = lds_byte(wr * 64 + fr, fq * 8), boff = lds_byte(wc * 32 + fr, fq * 8);
#define PG8_SA(b, h) (((b) * 2 + (h)) * HTB)
#define PG8_SB(b, h) ((4 + (b) * 2 + (h)) * HTB)
#define PG8_STAGE(bufoff, gbase, voff) do { _Pragma("unroll") for (int _i = 0; _i < 2; ++_i) \
        __builtin_amdgcn_global_load_lds((const unsigned*)((const char*)(gbase) + (voff)[_i]), (PG8_LAS unsigned*)(lds + (bufoff) + ldsw + _i * 8192), 16, 0, 0); } while (0)
#define PG8_LDA(dst, b, h) do { _Pragma("unroll") for (int m = 0; m < 4; ++m) _Pragma("unroll") for (int k = 0; k < 2; ++k) dst[m][k] = *(const PG8_LAS bf16x8*)(lds + PG8_SA(b, h) + aoff + m * 2048 + k * 1024); } while (0)
#define PG8_LDB(dst, b, h) do { _Pragma("unroll") for (int n = 0; n < 2; ++n) _Pragma("unroll") for (int k = 0; k < 2; ++k) dst[n][k] = *(const PG8_LAS bf16x8*)(lds + PG8_SB(b, h) + boff + n * 2048 + k * 1024); } while (0)
#define PG8_MMA(ai, bj, At, Bt) do { __builtin_amdgcn_s_setprio(1); _Pragma("unroll") for (int m = 0; m < 4; ++m) _Pragma("unroll") for (int n = 0; n < 2; ++n) _Pragma("unroll") for (int k = 0; k < 2; ++k) \
        acc[ai][bj][m][n] = __builtin_amdgcn_mfma_f32_16x16x32_bf16(Bt[n][k], At[m][k], acc[ai][bj][m][n], 0, 0, 0); __builtin_amdgcn_s_setprio(0); } while (0)
#define PG8_WAIT_V(n) asm volatile("s_waitcnt vmcnt(" #n ")" ::: "memory")
#define PG8_WAIT_L(n) asm volatile("s_waitcnt lgkmcnt(" #n ")" ::: "memory")
#define PG8_BAR __builtin_amdgcn_s_barrier()
#define PG8_SCHED __builtin_amdgcn_sched_barrier(0)
    Unit cur, nxt; int ui = 0;
    if (!S.next(0, cur)) return;
    f32x4 acc[2][2][4][2];
#pragma unroll
    for (int a = 0; a < 2; ++a)
#pragma unroll
        for (int b = 0; b < 2; ++b)
#pragma unroll
            for (int m = 0; m < 4; ++m)
#pragma unroll
                for (int n = 0; n < 2; ++n) acc[a][b][m][n] = (f32x4){0.f, 0.f, 0.f, 0.f};
    bf16x8 At[4][2], B0[2][2], B1[2][2];
    const char* cA = (const char*)g.A + (size_t)cur.pm * tstep; const char* cB = (const char*)g.Bt + (size_t)cur.pn * tstep;
    S.a_ready(cur);
    PG8_STAGE(PG8_SB(0, 0), cB, voffB); PG8_STAGE(PG8_SA(0, 0), cA, voffA); PG8_STAGE(PG8_SB(0, 1), cB + hstep, voffB); PG8_STAGE(PG8_SA(0, 1), cA + hstep, voffA);
    if (wr == 1) PG8_BAR;
    PG8_WAIT_V(4); PG8_BAR;
    PG8_STAGE(PG8_SB(1, 0), cB + kstep, voffB); PG8_STAGE(PG8_SA(1, 0), cA + kstep, voffA); PG8_STAGE(PG8_SB(1, 1), cB + hstep + kstep, voffB);
    PG8_WAIT_V(6); PG8_BAR;
    PG8_STAMP();
    for (;;) {
        const bool has_next = S.next(ui + 1, nxt);
        const char* nA = has_next ? (const char*)g.A + (size_t)nxt.pm * tstep : cA; const char* nB = has_next ? (const char*)g.Bt + (size_t)nxt.pn * tstep : cB;
        for (int t = 0; t < nt; t += 2) {
            const bool last = (t == nt - 2);
            const char* a1 = cA + (size_t)(t + 1) * kstep;
            const char* a2 = last ? nA : cA + (size_t)(t + 2) * kstep; const char* b2 = last ? nB : cB + (size_t)(t + 2) * kstep;
            const char* a3 = a2 + kstep; const char* b3 = b2 + kstep;
            if (last && has_next) S.a_ready(nxt);
            PG8_LDB(B0, 0, 0); PG8_SCHED; PG8_LDA(At, 0, 0); PG8_STAGE(PG8_SA(1, 1), a1 + hstep, voffA);
            PG8_WAIT_L(8); PG8_BAR; PG8_WAIT_L(0); PG8_MMA(0, 0, At, B0); PG8_BAR; PG8_SCHED;
            PG8_LDB(B1, 0, 1); PG8_STAGE(PG8_SB(0, 0), b2, voffB);
            PG8_BAR; PG8_WAIT_L(0); PG8_MMA(0, 1, At, B1); PG8_BAR;
            PG8_LDA(At, 0, 1); PG8_STAGE(PG8_SA(0, 0), a2, voffA);
            PG8_BAR; PG8_WAIT_L(0); PG8_MMA(1, 0, At, B0); PG8_BAR; PG8_SCHED;
            PG8_STAGE(PG8_SB(0, 1), b2 + hstep, voffB);
            PG8_WAIT_V(6); PG8_BAR; PG8_MMA(1, 1, At, B1); PG8_BAR;
            PG8_LDB(B0, 1, 0); PG8_SCHED; PG8_LDA(At, 1, 0); PG8_STAGE(PG8_SA(0, 1), a2 + hstep, voffA);
            PG8_WAIT_L(8); PG8_BAR; PG8_WAIT_L(0); PG8_MMA(0, 0, At, B0); PG8_BAR; PG8_SCHED;
            PG8_LDB(B1, 1, 1); PG8_STAGE(PG8_SB(1, 0), b3, voffB);
            PG8_BAR; PG8_WAIT_L(0); PG8_MMA(0, 1, At, B1); PG8_BAR;
            PG8_LDA(At, 1, 1); PG8_STAGE(PG8_SA(1, 0), a3, voffA);
            PG8_BAR; PG8_WAIT_L(0); PG8_MMA(1, 0, At, B0); PG8_BAR; PG8_SCHED;
            PG8_STAGE(PG8_SB(1, 1), b3 + hstep, voffB);
            PG8_WAIT_V(6); PG8_BAR; PG8_MMA(1, 1, At, B1); PG8_BAR;
        }
        PG8_STAMP();
        if constexpr (!Epi::AFTER_DRAIN) { E(acc, cur, wr, wc, fr, fq); S.done(cur); }
        PG8_STAMP();
        if (!has_next) break;
#pragma unroll
        for (int a = 0; a < 2; ++a)
#pragma unroll
            for (int b = 0; b < 2; ++b)
#pragma unroll
                for (int m = 0; m < 4; ++m)
#pragma unroll
                    for (int n = 0; n < 2; ++n) acc[a][b][m][n] = (f32x4){0.f, 0.f, 0.f, 0.f};
        cur = nxt; cA = nA; cB = nB; ++ui;
    }
    PG8_WAIT_V(0);
    if (wr == 0) PG8_BAR;
    PG8_BAR;
    if constexpr (Epi::AFTER_DRAIN) { E.fused(acc, cur, wr, wc, fr, fq, lds, wid, lane); S.done(cur); }
    PG8_STAMP();
    if (STAMP && wid == 0) { stamps[lane] = lane < nts ? (((unsigned long long)(unsigned)ts_hi << 32) | (unsigned)ts_lo) : 0ull;
        if (lane == 62) stamps[62] = rt_entry; if (lane == 63) stamps[63] = (unsigned long long)wall_clock64(); }
#undef PG8_STAMP
#undef PG8_SA
#undef PG8_SB
#undef PG8_STAGE
#undef PG8_LDA
#undef PG8_LDB
#undef PG8_MMA
#undef PG8_WAIT_V
#undef PG8_WAIT_L
#undef PG8_BAR
#undef PG8_SCHED
}
}

namespace cg = cooperative_groups;
using pg8::bf16_t; using pg8::bf16x8; using pg8::f32x4; using pg8::u32x4; using pg8::Unit; using pg8::cvt_pk_bf16;
typedef unsigned u32x2 __attribute__((ext_vector_type(2)));
#define LAS __attribute__((address_space(3)))

constexpr int D = 1024, TSEQ = 2048, NB = 8, MP = NB * TSEQ, MS = 128, MT = MP + MS;
constexpr int RW = 512, NH = 8, SW = 1664, NZ = 4224, NZP = 4352, DP = 256;
constexpr int ZC_S = 2048, ZC_GR = 3712;
constexpr int LDS_BYTES = 131072;

constexpr size_t OFF_WIN = 0;
constexpr size_t OFF_WOUT = OFF_WIN + (size_t)NZP * D * 2;
constexpr size_t OFF_WPG = OFF_WOUT + (size_t)D * D * 2;
constexpr size_t OFF_WPP = OFF_WPG + (size_t)D * D * 2;
constexpr size_t OFF_WUP = OFF_WPP + (size_t)D * DP * 2;
constexpr size_t OFF_AUP = OFF_WUP + (size_t)RW * 64 * 2;
constexpr size_t OFF_RS = OFF_AUP + (size_t)RW * 64 * 2;
constexpr size_t OFF_PB = OFF_RS + (size_t)16640 * 4;
constexpr size_t OFF_Z = OFF_PB + (size_t)MT * DP * 2;
constexpr size_t OFF_SCN = OFF_Z + (size_t)MT * NZ * 2;
constexpr size_t WS_END = OFF_SCN + (size_t)MT * NH * 384 * 2;
constexpr size_t OFF_H1 = OFF_Z;
constexpr size_t OFF_H1B = OFF_H1 + (size_t)MT * D * 4;
constexpr size_t OFF_PP = OFF_SCN;
static_assert(OFF_H1B + (size_t)MT * D * 2 <= OFF_SCN, "overlay");
static_assert(OFF_PP + (size_t)MT * D * 4 <= WS_END, "overlay");
constexpr size_t O_Y = 0, O_CONVP = (size_t)MT * D, O_SHIFTP = O_CONVP + 8 * 2 * 512, O_WKVP = O_SHIFTP + 8 * SW,
                 O_CONVS = O_WKVP + 8 * 8 * 64 * 64, O_SHIFTS = O_CONVS + 128 * 2 * 512, O_WKVS = O_SHIFTS + 128 * SW;

struct Args { const float* in[24]; float* out; unsigned char* ws; int ph_lo, ph_hi; };

__device__ __forceinline__ float bf2f(unsigned short b) { return __uint_as_float(((unsigned)b) << 16); }
__device__ __forceinline__ float bflo(unsigned w) { return __uint_as_float(w << 16); }
__device__ __forceinline__ float bfhi(unsigned w) { return __uint_as_float(w & 0xffff0000u); }
__device__ __forceinline__ unsigned short f2bf(float f) { return (unsigned short)(cvt_pk_bf16(f, 0.f) & 0xffffu); }
__device__ __forceinline__ void unpack8(const u32x4 q, float (&f)[8]) {
    f[0] = bflo(q.x); f[1] = bfhi(q.x); f[2] = bflo(q.y); f[3] = bfhi(q.y); f[4] = bflo(q.z); f[5] = bfhi(q.z); f[6] = bflo(q.w); f[7] = bfhi(q.w); }
__device__ __forceinline__ void unpack4(const u32x2 q, float (&f)[4]) { f[0] = bflo(q.x); f[1] = bfhi(q.x); f[2] = bflo(q.y); f[3] = bfhi(q.y); }
__device__ __forceinline__ u32x4 pack8(const float (&f)[8]) { u32x4 q; q.x = cvt_pk_bf16(f[0], f[1]); q.y = cvt_pk_bf16(f[2], f[3]); q.z = cvt_pk_bf16(f[4], f[5]); q.w = cvt_pk_bf16(f[6], f[7]); return q; }
__device__ __forceinline__ u32x2 pack4(float a, float b, float c, float d) { u32x2 q; q.x = cvt_pk_bf16(a, b); q.y = cvt_pk_bf16(c, d); return q; }
__device__ __forceinline__ float sigmoidf_(float x) { return 1.0f / (1.0f + __expf(-x)); }
__device__ __forceinline__ float siluf_(float x) { return x / (1.0f + __expf(-x)); }
template <int CTRL> __device__ __forceinline__ float dppf(float x) { return __int_as_float(__builtin_amdgcn_update_dpp(0, __float_as_int(x), CTRL, 0xf, 0xf, false)); }
__device__ __forceinline__ float rowsum16(float x) { x += dppf<0x128>(x); x += dppf<0x124>(x); x += dppf<0x122>(x); x += dppf<0x121>(x); return x; }

__device__ __forceinline__ f32x4 mini_tile(const bf16_t* arow, const bf16_t* brow, int K, int fq) {
    f32x4 acc = {0.f, 0.f, 0.f, 0.f};
    const bf16_t* ap = arow + fq * 8; const bf16_t* bp = brow + fq * 8;
    for (int k0 = 0; k0 < K; k0 += 256) {
        bf16x8 av[8], bv[8];
#pragma unroll
        for (int j = 0; j < 8; ++j) { av[j] = *(const bf16x8*)(ap + k0 + j * 32); bv[j] = *(const bf16x8*)(bp + k0 + j * 32); }
#pragma unroll
        for (int j = 0; j < 8; ++j) acc = __builtin_amdgcn_mfma_f32_16x16x32_bf16(bv[j], av[j], acc, 0, 0, 0);
    }
    return acc;
}

struct EpiZ {
    static constexpr bool PERM = false, AFTER_DRAIN = false;
    bf16_t* Z; const float* rs;
    __device__ __forceinline__ void operator()(const f32x4 (&acc)[2][2][4][2], const Unit& u, int wr, int wc, int fr, int fq) const {
        const int row0 = u.pm * 256 + wr * 64 + fr, col0 = u.pn * 256 + wc * 32 + 4 * fq;
#pragma unroll
        for (int ai = 0; ai < 2; ++ai)
#pragma unroll
            for (int m = 0; m < 4; ++m) { const int row = row0 + ai * 128 + m * 16; const float s = rs[row]; bf16_t* rp = Z + (size_t)row * NZ + col0;
#pragma unroll
                for (int bj = 0; bj < 2; ++bj)
#pragma unroll
                    for (int n = 0; n < 2; ++n) { if (col0 + bj * 128 + n * 16 < NZ) { const f32x4 v = acc[ai][bj][m][n] * s; *(u32x2*)(rp + bj * 128 + n * 16) = pack4(v[0], v[1], v[2], v[3]); } } }
    }
};
struct EpiH1 {
    static constexpr bool PERM = false, AFTER_DRAIN = false;
    const float* x; float* H1; bf16_t* H1B;
    __device__ __forceinline__ void operator()(const f32x4 (&acc)[2][2][4][2], const Unit& u, int wr, int wc, int fr, int fq) const {
        const int row0 = u.pm * 256 + wr * 64 + fr, col0 = u.pn * 256 + wc * 32 + 4 * fq;
#pragma unroll
        for (int ai = 0; ai < 2; ++ai)
#pragma unroll
            for (int m = 0; m < 4; ++m) { const size_t off = (size_t)(row0 + ai * 128 + m * 16) * D + col0;
#pragma unroll
                for (int bj = 0; bj < 2; ++bj)
#pragma unroll
                    for (int n = 0; n < 2; ++n) { const size_t o = off + bj * 128 + n * 16; const f32x4 v = *(const f32x4*)(x + o) + acc[ai][bj][m][n];
                        *(f32x4*)(H1 + o) = v; *(u32x2*)(H1B + o) = pack4(v[0], v[1], v[2], v[3]); } }
    }
};
struct EpiF32 {
    static constexpr bool PERM = false, AFTER_DRAIN = false;
    float* C;
    __device__ __forceinline__ void operator()(const f32x4 (&acc)[2][2][4][2], const Unit& u, int wr, int wc, int fr, int fq) const {
        const int row0 = u.pm * 256 + wr * 64 + fr, col0 = u.pn * 256 + wc * 32 + 4 * fq;
#pragma unroll
        for (int ai = 0; ai < 2; ++ai)
#pragma unroll
            for (int m = 0; m < 4; ++m) { const size_t off = (size_t)(row0 + ai * 128 + m * 16) * D + col0;
#pragma unroll
                for (int bj = 0; bj < 2; ++bj)
#pragma unroll
                    for (int n = 0; n < 2; ++n) *(f32x4*)(C + off + bj * 128 + n * 16) = acc[ai][bj][m][n]; }
    }
};
struct EpiH2 {
    static constexpr bool PERM = false, AFTER_DRAIN = false;
    const float* H1; const float* PP; float* out;
    __device__ __forceinline__ void operator()(const f32x4 (&acc)[2][2][4][2], const Unit& u, int wr, int wc, int fr, int fq) const {
        const int row0 = u.pm * 256 + wr * 64 + fr, col0 = u.pn * 256 + wc * 32 + 4 * fq;
#pragma unroll
        for (int ai = 0; ai < 2; ++ai)
#pragma unroll
            for (int m = 0; m < 4; ++m) { const size_t off = (size_t)(row0 + ai * 128 + m * 16) * D + col0;
#pragma unroll
                for (int bj = 0; bj < 2; ++bj)
#pragma unroll
                    for (int n = 0; n < 2; ++n) { const size_t o = off + bj * 128 + n * 16; const f32x4 h = *(const f32x4*)(H1 + o), p = *(const f32x4*)(PP + o); const f32x4 g = acc[ai][bj][m][n];
                        f32x4 v; v[0] = h[0] + sigmoidf_(g[0]) * p[0]; v[1] = h[1] + sigmoidf_(g[1]) * p[1]; v[2] = h[2] + sigmoidf_(g[2]) * p[2]; v[3] = h[3] + sigmoidf_(g[3]) * p[3];
                        *(f32x4*)(out + o) = v; } }
    }
};

__device__ void p0_prep(const Args& a, LAS unsigned char* lds) {
    const int tid = threadIdx.x, G = gridDim.x, blk = blockIdx.x, wave = tid >> 6, lane = tid & 63;
    LAS float* tile = (LAS float*)lds;
    unsigned char* ws = a.ws;
    constexpr int NJ_IN = 16 * 68, NJ_SQ = 256, NJ_PP = 64, NJ_LO = 8, NJOBS = NJ_IN + 2 * NJ_SQ + NJ_PP + 2 * NJ_LO;
    for (int job = blk; job < NJOBS; job += G) {
        const float* src; bf16_t* dst; const float* gsc = nullptr; int K, N, kt, nt; int j = job;
        if (j < NJ_IN) { src = a.in[8]; dst = (bf16_t*)(ws + OFF_WIN); gsc = a.in[7]; K = 1024; N = NZ; kt = j & 15; nt = j >> 4; }
        else if ((j -= NJ_IN) < NJ_SQ) { src = a.in[20]; dst = (bf16_t*)(ws + OFF_WOUT); K = 1024; N = 1024; kt = j & 15; nt = j >> 4; }
        else if ((j -= NJ_SQ) < NJ_SQ) { src = a.in[21]; dst = (bf16_t*)(ws + OFF_WPG); K = 1024; N = 1024; kt = j & 15; nt = j >> 4; }
        else if ((j -= NJ_SQ) < NJ_PP) { src = a.in[22]; dst = (bf16_t*)(ws + OFF_WPP); K = 256; N = 1024; kt = j & 3; nt = j >> 2; }
        else if ((j -= NJ_PP) < NJ_LO) { src = a.in[12]; dst = (bf16_t*)(ws + OFF_WUP); K = 64; N = 512; kt = 0; nt = j; }
        else { j -= NJ_LO; src = a.in[14]; dst = (bf16_t*)(ws + OFF_AUP); K = 64; N = 512; kt = 0; nt = j; }
        const int k0 = kt * 64, n0 = nt * 64;
#pragma unroll
        for (int it = 0; it < 8; ++it) { const int i = it * 8 + wave, jj = lane; float v = 0.f;
            if (n0 + jj < N) { v = src[(size_t)(k0 + i) * N + n0 + jj]; if (gsc) v *= gsc[k0 + i]; }
            tile[i * 65 + jj] = v; }
        __syncthreads();
#pragma unroll
        for (int it = 0; it < 8; ++it) { const int jj = it * 8 + wave, i = lane; dst[(size_t)(n0 + jj) * K + k0 + i] = f2bf(tile[i * 65 + jj]); }
        __syncthreads();
    }
    bf16_t* XB = (bf16_t*)a.out; float* RS = (float*)(ws + OFF_RS);
    for (int row = blk * 8 + wave; row < MT; row += G * 8) {
        const float* src = row < MP ? a.in[0] + (size_t)row * D : a.in[1] + (size_t)(row - MP) * D;
        float ss = 0.f;
#pragma unroll
        for (int i = 0; i < 4; ++i) { const f32x4 v = *(const f32x4*)(src + i * 256 + lane * 4); ss += v[0] * v[0] + v[1] * v[1] + v[2] * v[2] + v[3] * v[3];
            *(u32x2*)(XB + (size_t)row * D + i * 256 + lane * 4) = pack4(v[0], v[1], v[2], v[3]); }
#pragma unroll
        for (int o = 32; o >= 1; o >>= 1) ss += __shfl_xor(ss, o);
        if (lane == 0) RS[row] = rsqrtf(ss * (1.0f / D) + 1e-6f);
    }
    bf16_t* PB = (bf16_t*)(ws + OFF_PB);
    for (size_t i = (size_t)blk * 512 + tid; i < (size_t)MT * DP / 4; i += (size_t)G * 512) {
        const size_t e = i * 4; const f32x4 v = e < (size_t)MP * DP ? *(const f32x4*)(a.in[2] + e) : *(const f32x4*)(a.in[3] + (e - (size_t)MP * DP));
        *(u32x2*)(PB + e) = pack4(v[0], v[1], v[2], v[3]);
    }
}

__device__ void p1_gemm_in(const Args& a, LAS unsigned char* lds) {
    const int tid = threadIdx.x, G = gridDim.x, blk = blockIdx.x, wave = tid >> 6, lane = tid & 63, fr = lane & 15, fq = lane >> 4;
    unsigned char* ws = a.ws;
    const bf16_t* XB = (const bf16_t*)a.out; const bf16_t* WinT = (const bf16_t*)(ws + OFF_WIN); const float* RS = (const float*)(ws + OFF_RS); bf16_t* Z = (bf16_t*)(ws + OFF_Z);
    {
        pg8::Gemm g{XB, WinT, MP, NZP, D}; pg8::StaticOrder S; S.init(MP, NZP, G, blk); EpiZ E{Z, RS};
        pg8::gemm_phase<EpiZ, pg8::StaticOrder>(lds, g, S, E, nullptr);
    }
    const int first = (G == 256) ? 64 : 0;
    if (blk >= first)
        for (int t = (blk - first) * 8 + wave; t < 8 * (NZ / 16); t += (G - first) * 8) {
            const int rt = t & 7, ct = t >> 3; const int row = MP + rt * 16 + fr;
            const f32x4 acc = mini_tile(XB + (size_t)row * D, WinT + (size_t)(ct * 16 + fr) * D, D, fq);
            const float s = RS[row];
            *(u32x2*)(Z + (size_t)row * NZ + ct * 16 + 4 * fq) = pack4(acc[0] * s, acc[1] * s, acc[2] * s, acc[3] * s);
        }
}

__device__ void p2_tile(const Args& a, LAS unsigned char* lds, int tile) {
    const int tid = threadIdx.x, wave = tid >> 6, lane = tid & 63, fr = lane & 15, fq = lane >> 4;
    unsigned char* ws = a.ws;
    const bool smp = tile >= 256;
    const int m0 = smp ? MP + (tile - 256) * 64 : tile * 64;
    const int t0 = smp ? 0 : (tile & 31) * 64;
    const int bidx = tile >> 5;
    const bf16_t* Z = (const bf16_t*)(ws + OFF_Z); bf16_t* YC = (bf16_t*)a.out; bf16_t* SCN = (bf16_t*)(ws + OFF_SCN);
    const float* state_conv = a.in[4]; const float* state_shift = a.in[5]; const float* conv_w = a.in[9]; const float* mu = a.in[10];
    for (int idx = tid; idx < 64 * 64; idx += 512) {
        const int tok = idx >> 6, c0 = (idx & 63) * 8, m = m0 + tok, t = t0 + tok;
        const bf16_t* zr = Z + (size_t)m * NZ;
        float fB[8], fC[8], fH[8], fG[8], u0[8], u1[8], u2[8];
        unpack8(*(const u32x4*)(zr + c0), fB); unpack8(*(const u32x4*)(zr + 512 + c0), fC); unpack8(*(const u32x4*)(zr + 1024 + c0), fH); unpack8(*(const u32x4*)(zr + 1536 + c0), fG);
#pragma unroll
        for (int i = 0; i < 8; ++i) u0[i] = fC[i] * fH[i];
        if (smp) {
            const float* sc = state_conv + (size_t)(m - MP) * 1024 + c0;
            const f32x4 a0 = *(const f32x4*)(sc), a1 = *(const f32x4*)(sc + 4), b0 = *(const f32x4*)(sc + 512), b1 = *(const f32x4*)(sc + 516);
#pragma unroll
            for (int i = 0; i < 4; ++i) { u2[i] = a0[i]; u2[4 + i] = a1[i]; u1[i] = b0[i]; u1[4 + i] = b1[i]; }
        } else {
            if (t >= 1) { float c1[8], h1[8]; unpack8(*(const u32x4*)(zr - NZ + 512 + c0), c1); unpack8(*(const u32x4*)(zr - NZ + 1024 + c0), h1);
#pragma unroll
                for (int i = 0; i < 8; ++i) u1[i] = c1[i] * h1[i]; }
            else {
#pragma unroll
                for (int i = 0; i < 8; ++i) u1[i] = 0.f; }
            if (t >= 2) { float c2[8], h2[8]; unpack8(*(const u32x4*)(zr - 2 * NZ + 512 + c0), c2); unpack8(*(const u32x4*)(zr - 2 * NZ + 1024 + c0), h2);
#pragma unroll
                for (int i = 0; i < 8; ++i) u2[i] = c2[i] * h2[i]; }
            else {
#pragma unroll
                for (int i = 0; i < 8; ++i) u2[i] = 0.f; }
        }
        float y[8];
#pragma unroll
        for (int i = 0; i < 8; ++i) { const float cv = conv_w[c0 + i] * u2[i] + conv_w[512 + c0 + i] * u1[i] + conv_w[1024 + c0 + i] * u0[i]; y[i] = fB[i] * cv * siluf_(fG[i]); }
        *(u32x4*)(YC + (size_t)m * D + c0) = pack8(y);
        float* co = nullptr;
        if (smp) co = a.out + O_CONVS + (size_t)(m - MP) * 1024 + c0; else if (t == TSEQ - 1) co = a.out + O_CONVP + (size_t)bidx * 1024 + c0;
        if (co) {
#pragma unroll
            for (int i = 0; i < 8; ++i) { co[i] = u1[i]; co[512 + i] = u0[i]; } }
    }
    LAS bf16_t* Awd = (LAS bf16_t*)lds; LAS bf16_t* Aad = Awd + 64 * 72;
    for (int idx = tid; idx < 64 * 128; idx += 512) {
        const int tok = idx >> 7, j = idx & 127, m = m0 + tok;
        const float cur = bf2f(Z[(size_t)m * NZ + ZC_S + 1536 + j]);
        float prev = 0.f;
        if (smp) prev = state_shift[(size_t)(m - MP) * SW + 1536 + j]; else if (t0 + tok >= 1) prev = bf2f(Z[(size_t)(m - 1) * NZ + ZC_S + 1536 + j]);
        const float zm = cur + (prev - cur) * mu[1536 + j];
        if (j < 64) { const float e2 = __expf(2.0f * zm); Awd[tok * 72 + j] = f2bf(1.0f - 2.0f / (e2 + 1.0f)); } else Aad[tok * 72 + (j - 64)] = f2bf(zm);
    }
    __syncthreads();
    {
        const int h = wave;
        const bf16_t* WupT = (const bf16_t*)(ws + OFF_WUP); const bf16_t* AupT = (const bf16_t*)(ws + OFF_AUP);
        const float* w0 = a.in[11]; const float* a0p = a.in[13]; const float* k_k = a.in[15]; const float* k_a = a.in[16];
#pragma unroll 1
        for (int mt = 0; mt < 4; ++mt) {
            bf16x8 aw[2], aa[2];
#pragma unroll
            for (int ks = 0; ks < 2; ++ks) { aw[ks] = *(const LAS bf16x8*)(Awd + (mt * 16 + fr) * 72 + ks * 32 + fq * 8); aa[ks] = *(const LAS bf16x8*)(Aad + (mt * 16 + fr) * 72 + ks * 32 + fq * 8); }
            f32x4 accw[4], acca[4];
#pragma unroll
            for (int nt = 0; nt < 4; ++nt) { accw[nt] = (f32x4){0.f, 0.f, 0.f, 0.f}; acca[nt] = (f32x4){0.f, 0.f, 0.f, 0.f};
#pragma unroll
                for (int ks = 0; ks < 2; ++ks) { const size_t bo = (size_t)(h * 64 + nt * 16 + fr) * 64 + ks * 32 + fq * 8;
                    accw[nt] = __builtin_amdgcn_mfma_f32_16x16x32_bf16(*(const bf16x8*)(WupT + bo), aw[ks], accw[nt], 0, 0, 0);
                    acca[nt] = __builtin_amdgcn_mfma_f32_16x16x32_bf16(*(const bf16x8*)(AupT + bo), aa[ks], acca[nt], 0, 0, 0); } }
            const int tok = mt * 16 + fr, m = m0 + tok, t = t0 + tok;
            const bf16_t* zr = Z + (size_t)m * NZ + ZC_S;
            const bool hasprev = (!smp) && (t >= 1);
            bf16_t* so = SCN + ((size_t)m * 8 + h) * 384 + 4 * fq;
            float kk[4][4], av[4][4]; float ss = 0.f;
#pragma unroll
            for (int nt = 0; nt < 4; ++nt) {
                const int c = h * 64 + nt * 16 + 4 * fq;
                float cr[4], ck[4], cv[4], pr[4] = {0.f, 0.f, 0.f, 0.f}, pk[4] = {0.f, 0.f, 0.f, 0.f}, pv[4] = {0.f, 0.f, 0.f, 0.f};
                unpack4(*(const u32x2*)(zr + c), cr); unpack4(*(const u32x2*)(zr + 512 + c), ck); unpack4(*(const u32x2*)(zr + 1024 + c), cv);
                if (smp) { const float* sp = state_shift + (size_t)(m - MP) * SW + c; const f32x4 x0 = *(const f32x4*)sp, x1 = *(const f32x4*)(sp + 512), x2 = *(const f32x4*)(sp + 1024);
#pragma unroll
                    for (int i = 0; i < 4; ++i) { pr[i] = x0[i]; pk[i] = x1[i]; pv[i] = x2[i]; } }
                else if (hasprev) { unpack4(*(const u32x2*)(zr - NZ + c), pr); unpack4(*(const u32x2*)(zr - NZ + 512 + c), pk); unpack4(*(const u32x2*)(zr - NZ + 1024 + c), pv); }
                const f32x4 mr = *(const f32x4*)(mu + c), mk = *(const f32x4*)(mu + 512 + c), mv = *(const f32x4*)(mu + 1024 + c);
                const f32x4 w0v = *(const f32x4*)(w0 + c), a0v = *(const f32x4*)(a0p + c), kkv = *(const f32x4*)(k_k + c), kav = *(const f32x4*)(k_a + c);
                float r_[4], e_[4], kp[4], v_[4];
#pragma unroll
                for (int i = 0; i < 4; ++i) {
                    r_[i] = cr[i] + (pr[i] - cr[i]) * mr[i]; const float k = ck[i] + (pk[i] - ck[i]) * mk[i]; v_[i] = cv[i] + (pv[i] - cv[i]) * mv[i];
                    e_[i] = 0.60653065971f * sigmoidf_(w0v[i] + accw[nt][i]);
                    const float al = sigmoidf_(a0v[i] + acca[nt][i]); av[nt][i] = al;
                    const float kq = k * kkv[i]; kk[nt][i] = kq; ss += kq * kq;
                    kp[i] = k * (1.0f + (al - 1.0f) * kav[i]);
                }
                *(u32x2*)(so + 0 * 64 + nt * 16) = pack4(r_[0], r_[1], r_[2], r_[3]);
                *(u32x2*)(so + 1 * 64 + nt * 16) = pack4(e_[0], e_[1], e_[2], e_[3]);
                *(u32x2*)(so + 2 * 64 + nt * 16) = pack4(kp[0], kp[1], kp[2], kp[3]);
                *(u32x2*)(so + 3 * 64 + nt * 16) = pack4(v_[0], v_[1], v_[2], v_[3]);
            }
            ss += __shfl_xor(ss, 16); ss += __shfl_xor(ss, 32);
            const float inv = 1.0f / fmaxf(sqrtf(ss), 1e-12f);
#pragma unroll
            for (int nt = 0; nt < 4; ++nt) {
                float q[4], b[4];
#pragma unroll
                for (int i = 0; i < 4; ++i) { q[i] = kk[nt][i] * inv; b[i] = q[i] * av[nt][i]; }
                *(u32x2*)(so + 4 * 64 + nt * 16) = pack4(q[0], q[1], q[2], q[3]);
                *(u32x2*)(so + 5 * 64 + nt * 16) = pack4(b[0], b[1], b[2], b[3]);
            }
        }
    }
    if (smp) { for (int idx = tid; idx < 64 * SW; idx += 512) { const int tok = idx / SW, j = idx - tok * SW; a.out[O_SHIFTS + (size_t)(m0 - MP + tok) * SW + j] = bf2f(Z[(size_t)(m0 + tok) * NZ + ZC_S + j]); } }
    else if ((tile & 31) == 31) { for (int j = tid; j < SW; j += 512) a.out[O_SHIFTP + (size_t)bidx * SW + j] = bf2f(Z[(size_t)(m0 + 63) * NZ + ZC_S + j]); }
    __syncthreads();
}

__device__ void p3_scan(const Args& a, LAS unsigned char* lds) {
    const int tid = threadIdx.x, G = gridDim.x, blk = blockIdx.x, wave = tid >> 6, lane = tid & 63;
    unsigned char* ws = a.ws;
    const bf16_t* SCN = (const bf16_t*)(ws + OFF_SCN); bf16_t* YC = (bf16_t*)a.out;
    constexpr int CH = 32, NCH = TSEQ / CH;
    LAS float* buf = (LAS float*)lds;
    for (int item = blk; item < 256; item += G) {
        const int bh = item >> 2, q = item & 3, b = bh >> 3, h = bh & 7;
        const bf16_t* scn = SCN + ((size_t)(b * TSEQ) * 8 + h) * 384;
        if (wave >= 4) {
            const int ptid = tid - 256;
            u32x4 regs[6];
#define P3_LOAD(c) do { _Pragma("unroll") for (int i = 0; i < 6; ++i) { const int p = ptid + 256 * i, st = p / 48, o8 = p - st * 48; regs[i] = *(const u32x4*)(scn + (size_t)((c) * CH + st) * 3072 + o8 * 8); } } while (0)
#define P3_WRITE(c) do { _Pragma("unroll") for (int i = 0; i < 6; ++i) { const int p = ptid + 256 * i, st = p / 48, o8 = p - st * 48; float f[8]; unpack8(regs[i], f); \
            if ((o8 >> 3) == 1) { _Pragma("unroll") for (int j = 0; j < 8; ++j) f[j] = __expf(-f[j]); } \
            LAS float* d = buf + ((c) & 1) * (CH * 384) + st * 384 + o8 * 8; *(LAS f32x4*)d = (f32x4){f[0], f[1], f[2], f[3]}; *(LAS f32x4*)(d + 4) = (f32x4){f[4], f[5], f[6], f[7]}; } } while (0)
            P3_LOAD(0); P3_WRITE(0); P3_LOAD(1);
            __syncthreads();
            for (int c = 0; c < NCH; ++c) {
                if (c + 1 < NCH) { P3_WRITE(c + 1); if (c + 2 < NCH) P3_LOAD(c + 2); }
                __syncthreads();
            }
#undef P3_LOAD
#undef P3_WRITE
        } else {
            const int vrow = q * 16 + wave * 4 + (lane >> 4), cj = lane & 15;
            float s0 = 0.f, s1 = 0.f, s2 = 0.f, s3 = 0.f;
            bf16_t* yo = YC + (size_t)(b * TSEQ) * D + 512 + h * 64 + vrow;
            __syncthreads();
            for (int c = 0; c < NCH; ++c) {
                const LAS float* bc = buf + (c & 1) * (CH * 384);
#pragma unroll 4
                for (int st = 0; st < CH; ++st) {
                    const LAS float* p = bc + st * 384;
                    const f32x4 r4 = *(const LAS f32x4*)(p + 4 * cj), w4 = *(const LAS f32x4*)(p + 64 + 4 * cj), k4 = *(const LAS f32x4*)(p + 128 + 4 * cj),
                                kk4 = *(const LAS f32x4*)(p + 256 + 4 * cj), b4 = *(const LAS f32x4*)(p + 320 + 4 * cj);
                    const float vv = p[192 + vrow];
                    float d = s0 * kk4[0] + s1 * kk4[1] + s2 * kk4[2] + s3 * kk4[3];
                    d = rowsum16(d);
                    const float sa = -d;
                    s0 = s0 * w4[0] + (sa * b4[0] + vv * k4[0]); s1 = s1 * w4[1] + (sa * b4[1] + vv * k4[1]);
                    s2 = s2 * w4[2] + (sa * b4[2] + vv * k4[2]); s3 = s3 * w4[3] + (sa * b4[3] + vv * k4[3]);
                    float y = s0 * r4[0] + s1 * r4[1] + s2 * r4[2] + s3 * r4[3];
                    y = rowsum16(y);
                    if (cj == 0) yo[(size_t)(c * CH + st) * D] = f2bf(y);
                }
                __syncthreads();
            }
            *(f32x4*)(a.out + O_WKVP + ((size_t)(b * 8 + h) * 64 + vrow) * 64 + 4 * cj) = (f32x4){s0, s1, s2, s3};
        }
    }
    const float* state_wkv = a.in[6];
    for (int it = blk; it < MS * NH; it += G) {
        const int s = it >> 3, h = it & 7, m = MP + s, row = tid >> 3, c0 = (tid & 7) * 8;
        const bf16_t* sc = SCN + ((size_t)m * 8 + h) * 384;
        float r_[8], e_[8], kp[8], kq[8], bb[8];
        unpack8(*(const u32x4*)(sc + c0), r_); unpack8(*(const u32x4*)(sc + 64 + c0), e_); unpack8(*(const u32x4*)(sc + 128 + c0), kp); unpack8(*(const u32x4*)(sc + 256 + c0), kq); unpack8(*(const u32x4*)(sc + 320 + c0), bb);
        const float vv = bf2f(sc[192 + row]);
        const size_t so = ((size_t)(s * 8 + h) * 64 + row) * 64 + c0;
        const f32x4 sA = *(const f32x4*)(state_wkv + so), sB = *(const f32x4*)(state_wkv + so + 4);
        float S[8] = {sA[0], sA[1], sA[2], sA[3], sB[0], sB[1], sB[2], sB[3]};
        float d = 0.f;
#pragma unroll
        for (int i = 0; i < 8; ++i) d += S[i] * kq[i];
        d += __shfl_xor(d, 1); d += __shfl_xor(d, 2); d += __shfl_xor(d, 4);
        float y = 0.f;
#pragma unroll
        for (int i = 0; i < 8; ++i) { S[i] = S[i] * __expf(-e_[i]) + (-d) * bb[i] + vv * kp[i]; y += S[i] * r_[i]; }
        y += __shfl_xor(y, 1); y += __shfl_xor(y, 2); y += __shfl_xor(y, 4);
        *(f32x4*)(a.out + O_WKVS + so) = (f32x4){S[0], S[1], S[2], S[3]}; *(f32x4*)(a.out + O_WKVS + so + 4) = (f32x4){S[4], S[5], S[6], S[7]};
        if ((tid & 7) == 0) YC[(size_t)m * D + 512 + h * 64 + row] = f2bf(y);
    }
}

__device__ void p4_gn(const Args& a) {
    const int tid = threadIdx.x, G = gridDim.x, blk = blockIdx.x, wave = tid >> 6, lane = tid & 63;
    unsigned char* ws = a.ws;
    const bf16_t* SCN = (const bf16_t*)(ws + OFF_SCN); const bf16_t* Z = (const bf16_t*)(ws + OFF_Z); bf16_t* YC = (bf16_t*)a.out;
    const float* r_k = a.in[17]; const float* ln_w = a.in[18]; const float* ln_b = a.in[19];
    const int c = lane * 8, h = lane >> 3, cc = (lane & 7) * 8;
    float rkw[8], lw[8], lb[8];
#pragma unroll
    for (int i = 0; i < 8; ++i) { rkw[i] = r_k[h * 64 + cc + i]; lw[i] = ln_w[c + i]; lb[i] = ln_b[c + i]; }
    for (int m = blk * 8 + wave; m < MT; m += G * 8) {
        bf16_t* yp = YC + (size_t)m * D + 512 + c;
        float o[8], r_[8], kp[8], v_[8], g[8];
        unpack8(*(const u32x4*)yp, o);
        const bf16_t* sc = SCN + ((size_t)m * 8 + h) * 384 + cc;
        unpack8(*(const u32x4*)(sc), r_); unpack8(*(const u32x4*)(sc + 128), kp); unpack8(*(const u32x4*)(sc + 192), v_);
        unpack8(*(const u32x4*)(Z + (size_t)m * NZ + ZC_GR + c), g);
        float sm = 0.f, rk = 0.f;
#pragma unroll
        for (int i = 0; i < 8; ++i) { sm += o[i]; rk += r_[i] * kp[i] * rkw[i]; }
        sm += __shfl_xor(sm, 1); sm += __shfl_xor(sm, 2); sm += __shfl_xor(sm, 4);
        rk += __shfl_xor(rk, 1); rk += __shfl_xor(rk, 2); rk += __shfl_xor(rk, 4);
        const float mean = sm * (1.0f / 64.0f);
        float var = 0.f;
#pragma unroll
        for (int i = 0; i < 8; ++i) { o[i] -= mean; var += o[i] * o[i]; }
        var += __shfl_xor(var, 1); var += __shfl_xor(var, 2); var += __shfl_xor(var, 4);
        const float rstd = rsqrtf(var * (1.0f / 64.0f) + 64e-5f);
        float y[8];
#pragma unroll
        for (int i = 0; i < 8; ++i) y[i] = (o[i] * rstd * lw[i] + lb[i] + rk * v_[i]) * siluf_(g[i]);
        *(u32x4*)yp = pack8(y);
    }
}

__device__ void p5_out(const Args& a, LAS unsigned char* lds) {
    const int tid = threadIdx.x, G = gridDim.x, blk = blockIdx.x, wave = tid >> 6, lane = tid & 63, fr = lane & 15, fq = lane >> 4;
    unsigned char* ws = a.ws;
    const bf16_t* YC = (const bf16_t*)a.out; const bf16_t* WoutT = (const bf16_t*)(ws + OFF_WOUT); const bf16_t* PB = (const bf16_t*)(ws + OFF_PB); const bf16_t* WppT = (const bf16_t*)(ws + OFF_WPP);
    float* H1 = (float*)(ws + OFF_H1); bf16_t* H1B = (bf16_t*)(ws + OFF_H1B); float* PP = (float*)(ws + OFF_PP);
    { pg8::Gemm g{YC, WoutT, MP, D, D}; pg8::StaticOrder S; S.init(MP, D, G, blk); EpiH1 E{a.in[0], H1, H1B}; pg8::gemm_phase<EpiH1, pg8::StaticOrder>(lds, g, S, E, nullptr); }
    { pg8::Gemm g{PB, WppT, MP, D, DP}; pg8::StaticOrder S; S.init(MP, D, G, blk); EpiF32 E{PP}; pg8::gemm_phase<EpiF32, pg8::StaticOrder>(lds, g, S, E, nullptr); }
    for (int t = blk * 8 + wave; t < 1024; t += G * 8) {
        const int tt = t & 511, rt = tt & 7, ct = tt >> 3; const int row = MP + rt * 16 + fr; const size_t o = (size_t)row * D + ct * 16 + 4 * fq;
        if (t < 512) {
            const f32x4 acc = mini_tile(YC + (size_t)row * D, WoutT + (size_t)(ct * 16 + fr) * D, D, fq);
            const f32x4 v = *(const f32x4*)(a.in[1] + (size_t)(row - MP) * D + ct * 16 + 4 * fq) + acc;
            *(f32x4*)(H1 + o) = v; *(u32x2*)(H1B + o) = pack4(v[0], v[1], v[2], v[3]);
        } else {
            const f32x4 acc = mini_tile(PB + (size_t)row * DP, WppT + (size_t)(ct * 16 + fr) * DP, DP, fq);
            *(f32x4*)(PP + o) = acc;
        }
    }
}

__device__ void p6_gate(const Args& a, LAS unsigned char* lds) {
    const int tid = threadIdx.x, G = gridDim.x, blk = blockIdx.x, wave = tid >> 6, lane = tid & 63, fr = lane & 15, fq = lane >> 4;
    unsigned char* ws = a.ws;
    const bf16_t* WpgT = (const bf16_t*)(ws + OFF_WPG); const float* H1 = (const float*)(ws + OFF_H1); const bf16_t* H1B = (const bf16_t*)(ws + OFF_H1B); const float* PP = (const float*)(ws + OFF_PP);
    { pg8::Gemm g{H1B, WpgT, MP, D, D}; pg8::StaticOrder S; S.init(MP, D, G, blk); EpiH2 E{H1, PP, a.out}; pg8::gemm_phase<EpiH2, pg8::StaticOrder>(lds, g, S, E, nullptr); }
    for (int t = blk * 8 + wave; t < 512; t += G * 8) {
        const int rt = t & 7, ct = t >> 3; const int row = MP + rt * 16 + fr; const size_t o = (size_t)row * D + ct * 16 + 4 * fq;
        const f32x4 g = mini_tile(H1B + (size_t)row * D, WpgT + (size_t)(ct * 16 + fr) * D, D, fq);
        const f32x4 h = *(const f32x4*)(H1 + o), p = *(const f32x4*)(PP + o);
        f32x4 v; v[0] = h[0] + sigmoidf_(g[0]) * p[0]; v[1] = h[1] + sigmoidf_(g[1]) * p[1]; v[2] = h[2] + sigmoidf_(g[2]) * p[2]; v[3] = h[3] + sigmoidf_(g[3]) * p[3];
        *(f32x4*)(a.out + o) = v;
    }
}

__device__ void p7_norm(const Args& a) {
    const int tid = threadIdx.x, G = gridDim.x, blk = blockIdx.x, wave = tid >> 6, lane = tid & 63;
    const float* fg = a.in[23];
    f32x4 gv[4];
#pragma unroll
    for (int i = 0; i < 4; ++i) gv[i] = *(const f32x4*)(fg + i * 256 + lane * 4);
    for (int row = blk * 8 + wave; row < MT; row += G * 8) {
        float* p = a.out + (size_t)row * D + lane * 4;
        f32x4 v[4]; float ss = 0.f;
#pragma unroll
        for (int i = 0; i < 4; ++i) { v[i] = *(const f32x4*)(p + i * 256); ss += v[i][0] * v[i][0] + v[i][1] * v[i][1] + v[i][2] * v[i][2] + v[i][3] * v[i][3]; }
#pragma unroll
        for (int o = 32; o >= 1; o >>= 1) ss += __shfl_xor(ss, o);
        const float rs = rsqrtf(ss * (1.0f / D) + 1e-6f);
#pragma unroll
        for (int i = 0; i < 4; ++i) *(f32x4*)(p + i * 256) = v[i] * rs * gv[i];
    }
}

__global__ void __launch_bounds__(512, 2) fwd(Args a) {
    extern __shared__ __attribute__((aligned(16))) unsigned char lds_raw[];
    LAS unsigned char* lds = (LAS unsigned char*)lds_raw;
    cg::grid_group grid = cg::this_grid();
#define IN(k) (a.ph_lo <= (k) && (k) < a.ph_hi)
#define SEAM(k) do { if (IN(k) && IN((k) + 1)) grid.sync(); } while (0)
    if (IN(0)) p0_prep(a, lds);
    SEAM(0);
    if (IN(1)) p1_gemm_in(a, lds);
    SEAM(1);
    if (IN(2)) { for (int t = blockIdx.x; t < 258; t += gridDim.x) p2_tile(a, lds, t); }
    SEAM(2);
    if (IN(3)) p3_scan(a, lds);
    SEAM(3);
    if (IN(4)) p4_gn(a);
    SEAM(4);
    if (IN(5)) p5_out(a, lds);
    SEAM(5);
    if (IN(6)) p6_gate(a, lds);
    SEAM(6);
    if (IN(7)) p7_norm(a);
}

#ifndef N_LAUNCH_MODE
#define N_LAUNCH_MODE 8
#endif
extern "C" void kernel_launch(void* const* d_in, const int* in_sizes, int n_in, void* d_out, int out_size, void* d_ws, size_t ws_size, hipStream_t stream) {
    static int grid = 0;
    if (grid == 0) {
        if (n_in != 24 || ws_size < WS_END) { fprintf(stderr, "kernel_launch: unexpected n_in %d / ws_size %zu (need %zu)\n", n_in, ws_size, (size_t)WS_END); grid = -1; return; }
        int dev = 0, cus = 0, per_cu = 0;
        (void)hipGetDevice(&dev); (void)hipDeviceGetAttribute(&cus, hipDeviceAttributeMultiprocessorCount, dev);
        if (hipFuncSetAttribute((const void*)fwd, hipFuncAttributeMaxDynamicSharedMemorySize, LDS_BYTES) != hipSuccess) { fprintf(stderr, "kernel_launch: hipFuncSetAttribute failed\n"); grid = -1; return; }
        if (hipOccupancyMaxActiveBlocksPerMultiprocessor(&per_cu, (const void*)fwd, 512, LDS_BYTES) != hipSuccess || per_cu < 1) { fprintf(stderr, "kernel_launch: occupancy query gives %d\n", per_cu); per_cu = 1; }
        (void)hipGetLastError();
        grid = cus;
    }
    if (grid < 0) return;
    Args a{};
    for (int i = 0; i < 24; ++i) a.in[i] = (const float*)d_in[i];
    a.out = (float*)d_out; a.ws = (unsigned char*)d_ws;
    if (N_LAUNCH_MODE == 1) {
        a.ph_lo = 0; a.ph_hi = 8;
        void* args[] = {&a};
        hipError_t e = hipLaunchCooperativeKernel((const void*)fwd, dim3(grid), dim3(512), args, LDS_BYTES, stream);
        if (e != hipSuccess) fprintf(stderr, "kernel_launch: cooperative launch failed: %s (grid %d)\n", hipGetErrorString(e), grid);
    } else {
        for (int ph = 0; ph < 8; ++ph) { a.ph_lo = ph; a.ph_hi = ph + 1; hipLaunchKernelGGL(fwd, dim3(grid), dim3(512), LDS_BYTES, stream, a); }
    }
}
```

```cpp
#include <hip/hip_runtime.h>
#include <hip/hip_cooperative_groups.h>
#include <cstdio>
namespace pg8 {
#define PG8_LAS __attribute__((address_space(3)))
typedef unsigned short bf16_t;
typedef short bf16x8 __attribute__((ext_vector_type(8)));
typedef float f32x4 __attribute__((ext_vector_type(4)));
typedef unsigned u32x4 __attribute__((ext_vector_type(4)));
constexpr int BM = 256, BK = 64, HALF = 128, HTB = HALF * BK * 2  , STAGE_BYTES = 8 * HTB, NXCD = 8, WGM = 8;

__host__ __device__ __forceinline__ int lds_byte(int r, int c) { const int st = (r >> 4) * 2 + (c >> 5), rr = r & 15, cc = c & 31, ob = rr * 64 + cc * 2; return st * 1024 + (ob ^ (((ob >> 9) & 1) << 5)); }
__host__ __device__ __forceinline__ void stage_rc(int b, int& R, int& C) { const int st = b / 1024, sb = b % 1024, swz = sb ^ (((sb >> 9) & 1) << 5); R = (st >> 1) * 16 + swz / 64; C = (st & 1) * 32 + (swz % 64) / 2; }
__host__ __device__ __forceinline__ int perm32(int rho) { const int n = rho >> 4, i = rho & 15; return 8 * (i >> 2) + 4 * n + (i & 3); }

struct Unit { int pm, pn; };
struct Gemm { const bf16_t* A; const bf16_t* Bt; int M, N, K; };

struct StaticOrder {
    int nM, nN, nwg, G, c;
    __host__ __device__ void init(int M, int N, int G_, int c_) { nM = M / BM; nN = N / BM; nwg = nM * nN; G = G_; c = c_; }
    __host__ __device__ bool next(int i, Unit& u) const {
        const long L = (long)i * G + c; if (L >= nwg) return false;
        int wgid = (int)L; { const int q = nwg / NXCD, r = nwg % NXCD, xcd = wgid % NXCD, off = wgid / NXCD; wgid = (xcd < r ? xcd * (q + 1) : r * (q + 1) + (xcd - r) * q) + off; }
        const int nig = WGM * nN, gid = wgid / nig, fm = gid * WGM, gsz = (nM - fm) < WGM ? (nM - fm) : WGM;
        u.pm = fm + ((wgid % nig) % gsz); u.pn = (wgid % nig) / gsz; return true;
    }
    __device__ __forceinline__ void a_ready(const Unit&) const {}
    __device__ __forceinline__ void done(const Unit&) const {}
};
typedef __bf16 bf16v2_t __attribute__((ext_vector_type(2)));
typedef float f32v2_t __attribute__((ext_vector_type(2)));
__device__ __forceinline__ unsigned cvt_pk_bf16(float lo, float hi) { const bf16v2_t r = __builtin_convertvector((f32v2_t){lo, hi}, bf16v2_t); return __builtin_bit_cast(unsigned, r); }
template <class Epi, class Sched, bool STAMP = false>
__device__ __forceinline__ void gemm_phase(PG8_LAS unsigned char* lds, const Gemm g, const Sched& S, const Epi& E, unsigned long long* stamps) {
    const int tid = threadIdx.x, wid = __builtin_amdgcn_readfirstlane(tid >> 6), lane = tid & 63, wr = wid >> 2, wc = wid & 3, fr = lane & 15, fq = lane >> 4;
    const int K = g.K, nt = K / BK;
    int ts_lo = 0, ts_hi = 0, nts = 0; const unsigned long long rt_entry = STAMP ? (unsigned long long)wall_clock64() : 0ull;
#define PG8_STAMP() do { if (STAMP && wid == 0 && nts < 64) { const unsigned long long _c = (unsigned long long)clock64(); \
        ts_lo = (lane == nts) ? (int)(unsigned)_c : ts_lo; ts_hi = (lane == nts) ? (int)(unsigned)(_c >> 32) : ts_hi; ++nts; } } while (0)
    PG8_STAMP();
    unsigned voffA[2], voffB[2];
#pragma unroll
    for (int i = 0; i < 2; ++i) { int R, C; stage_rc(tid * 16 + i * 8192, R, C); const int Rb = Epi::PERM ? ((R & ~31) + perm32(R & 31)) : R;
        voffA[i] = (unsigned)(R * K + C) * 2u; voffB[i] = (unsigned)(Rb * K + C) * 2u; }
    const size_t kstep = (size_t)(BK * 2);
    const size_t hstep = (size_t)HALF * K * 2;
    const size_t tstep = 2 * hstep;
    const unsigned ldsw = (unsigned)wid * 1024u;
    const int aoff = lds_byte(wr * 64 + fr, fq * 8), boff = lds_byte(wc * 32 + fr, fq * 8);
#define PG8_SA(b, h) (((b) * 2 + (h)) * HTB)
#define PG8_SB(b, h) ((4 + (b) * 2 + (h)) * HTB)
#define PG8_STAGE(bufoff, gbase, voff) do { _Pragma("unroll") for (int _i = 0; _i < 2; ++_i) \
        __builtin_amdgcn_global_load_lds((const unsigned*)((const char*)(gbase) + (voff)[_i]), (PG8_LAS unsigned*)(lds + (bufoff) + ldsw + _i * 8192), 16, 0, 0); } while (0)
#define PG8_LDA(dst, b, h) do { _Pragma("unroll") for (int m = 0; m < 4; ++m) _Pragma("unroll") for (int k = 0; k < 2; ++k) dst[m][k] = *(const PG8_LAS bf16x8*)(lds + PG8_SA(b, h) + aoff + m * 2048 + k * 1024); } while (0)
#define PG8_LDB(dst, b, h) do { _Pragma("unroll") for (int n = 0; n < 2; ++n) _Pragma("unroll") for (int k = 0; k < 2; ++k) dst[n][k] = *(const PG8_LAS bf16x8*)(lds + PG8_SB(b, h) + boff + n * 2048 + k * 1024); } while (0)
#define PG8_MMA(ai, bj, At, Bt) do { __builtin_amdgcn_s_setprio(1); _Pragma("unroll") for (int m = 0; m < 4; ++m) _Pragma("unroll") for (int n = 0; n < 2; ++n) _Pragma("unroll") for (int k = 0; k < 2; ++k) \
        acc[ai][bj][m][n] = __builtin_amdgcn_mfma_f32_16x16x32_bf16(Bt[n][k], At[m][k], acc[ai][bj][m][n], 0, 0, 0); __builtin_amdgcn_s_setprio(0); } while (0)
#define PG8_WAIT_V(n) asm volatile("s_waitcnt vmcnt(" #n ")" ::: "memory")
#define PG8_WAIT_L(n) asm volatile("s_waitcnt lgkmcnt(" #n ")" ::: "memory")
#define PG8_BAR __builtin_amdgcn_s_barrier()
#define PG8_SCHED __builtin_amdgcn_sched_barrier(0)
    Unit cur, nxt; int ui = 0;
    if (!S.next(0, cur)) return;
    f32x4 acc[2][2][4][2];
#pragma unroll
    for (int a = 0; a < 2; ++a)
#pragma unroll
        for (int b = 0; b < 2; ++b)
#pragma unroll
            for (int m = 0; m < 4; ++m)
#pragma unroll
                for (int n = 0; n < 2; ++n) acc[a][b][m][n] = (f32x4){0.f, 0.f, 0.f, 0.f};
    bf16x8 At[4][2], B0[2][2], B1[2][2];
    const char* cA = (const char*)g.A + (size_t)cur.pm * tstep; const char* cB = (const char*)g.Bt + (size_t)cur.pn * tstep;
    S.a_ready(cur);
    PG8_STAGE(PG8_SB(0, 0), cB, voffB); PG8_STAGE(PG8_SA(0, 0), cA, voffA); PG8_STAGE(PG8_SB(0, 1), cB + hstep, voffB); PG8_STAGE(PG8_SA(0, 1), cA + hstep, voffA);
    if (wr == 1) PG8_BAR;
    PG8_WAIT_V(4); PG8_BAR;
    PG8_STAGE(PG8_SB(1, 0), cB + kstep, voffB); PG8_STAGE(PG8_SA(1, 0), cA + kstep, voffA); PG8_STAGE(PG8_SB(1, 1), cB + hstep + kstep, voffB);
    PG8_WAIT_V(6); PG8_BAR;
    PG8_STAMP();
    for (;;) {
        const bool has_next = S.next(ui + 1, nxt);
        const char* nA = has_next ? (const char*)g.A + (size_t)nxt.pm * tstep : cA; const char* nB = has_next ? (const char*)g.Bt + (size_t)nxt.pn * tstep : cB;
        for (int t = 0; t < nt; t += 2) {
            const bool last = (t == nt - 2);
            const char* a1 = cA + (size_t)(t + 1) * kstep;
            const char* a2 = last ? nA : cA + (size_t)(t + 2) * kstep; const char* b2 = last ? nB : cB + (size_t)(t + 2) * kstep;
            const char* a3 = a2 + kstep; const char* b3 = b2 + kstep;
            if (last && has_next) S.a_ready(nxt);
            PG8_LDB(B0, 0, 0); PG8_SCHED; PG8_LDA(At, 0, 0); PG8_STAGE(PG8_SA(1, 1), a1 + hstep, voffA);
            PG8_WAIT_L(8); PG8_BAR; PG8_WAIT_L(0); PG8_MMA(0, 0, At, B0); PG8_BAR; PG8_SCHED;
            PG8_LDB(B1, 0, 1); PG8_STAGE(PG8_SB(0, 0), b2, voffB);
            PG8_BAR; PG8_WAIT_L(0); PG8_MMA(0, 1, At, B1); PG8_BAR;
            PG8_LDA(At, 0, 1); PG8_STAGE(PG8_SA(0, 0), a2, voffA);
            PG8_BAR; PG8_WAIT_L(0); PG8_MMA(1, 0, At, B0); PG8_BAR; PG8_SCHED;
            PG8_STAGE(PG8_SB(0, 1), b2 + hstep, voffB);
            PG8_WAIT_V(6); PG8_BAR; PG8_MMA(1, 1, At, B1); PG8_BAR;
            PG8_LDB(B0, 1, 0); PG8_SCHED; PG8_LDA(At, 1, 0); PG8_STAGE(PG8_SA(0, 1), a2 + hstep, voffA);
            PG8_WAIT_L(8); PG8_BAR; PG8_WAIT_L(0); PG8_MMA(0, 0, At, B0); PG8_BAR; PG8_SCHED;
            PG8_LDB(B1, 1, 1); PG8_STAGE(PG8_SB(1, 0), b3, voffB);
            PG8_BAR; PG8_WAIT_L(0); PG8_MMA(0, 1, At, B1); PG8_BAR;
            PG8_LDA(At, 1, 1); PG8_STAGE(PG8_SA(1, 0), a3, voffA);
            PG8_BAR; PG8_WAIT_L(0); PG8_MMA(1, 0, At, B0); PG8_BAR; PG8_SCHED;
            PG8_STAGE(PG8_SB(1, 1), b3 + hstep, voffB);
            PG8_WAIT_V(6); PG8_BAR; PG8_MMA(1, 1, At, B1); PG8_BAR;
        }
        PG8_STAMP();
        if constexpr (!Epi::AFTER_DRAIN) { E(acc, cur, wr, wc, fr, fq); S.done(cur); }
        PG8_STAMP();
        if (!has_next) break;
#pragma unroll
        for (int a = 0; a < 2; ++a)
#pragma unroll
            for (int b = 0; b < 2; ++b)
#pragma unroll
                for (int m = 0; m < 4; ++m)
#pragma unroll
                    for (int n = 0; n < 2; ++n) acc[a][b][m][n] = (f32x4){0.f, 0.f, 0.f, 0.f};
        cur = nxt; cA = nA; cB = nB; ++ui;
    }
    PG8_WAIT_V(0);
    if (wr == 0) PG8_BAR;
    PG8_BAR;
    if constexpr (Epi::AFTER_DRAIN) { E.fused(acc, cur, wr, wc, fr, fq, lds, wid, lane); S.done(cur); }
    PG8_STAMP();
    if (STAMP && wid == 0) { stamps[lane] = lane < nts ? (((unsigned long long)(unsigned)ts_hi << 32) | (unsigned)ts_lo) : 0ull;
        if (lane == 62) stamps[62] = rt_entry; if (lane == 63) stamps[63] = (unsigned long long)wall_clock64(); }
#undef PG8_STAMP
#undef PG8_SA
#undef PG8_SB
#undef PG8_STAGE
#undef PG8_LDA
#undef PG8_LDB
#undef PG8_MMA
#undef PG8_WAIT_V
#undef PG8_WAIT_L
#undef PG8_BAR
#undef PG8_SCHED
}
}

namespace cg = cooperative_groups;
using pg8::bf16_t; using pg8::bf16x8; using pg8::f32x4; using pg8::u32x4; using pg8::Unit; using pg8::cvt_pk_bf16;
typedef unsigned u32x2 __attribute__((ext_vector_type(2)));
#define LAS __attribute__((address_space(3)))
#define LBAR() do { asm volatile("s_waitcnt lgkmcnt(0)" ::: "memory"); __builtin_amdgcn_s_barrier(); asm volatile("" ::: "memory"); } while (0)

constexpr int D = 1024, TSEQ = 2048, NB = 8, MP = NB * TSEQ, MS = 128, MT = MP + MS;
constexpr int RW = 512, NH = 8, SW = 1664, NZ = 4224, NZP = 4352, DP = 256;
constexpr int ZC_S = 2048, ZC_GR = 3712;
constexpr int LDS_BYTES = 159744;

constexpr size_t OFF_WIN = 0;
constexpr size_t OFF_WOUT = OFF_WIN + (size_t)NZP * D * 2;
constexpr size_t OFF_WPG = OFF_WOUT + (size_t)D * D * 2;
constexpr size_t OFF_WPP = OFF_WPG + (size_t)D * D * 2;
constexpr size_t OFF_WUP = OFF_WPP + (size_t)D * DP * 2;
constexpr size_t OFF_AUP = OFF_WUP + (size_t)RW * 64 * 2;
constexpr size_t OFF_RS = OFF_AUP + (size_t)RW * 64 * 2;
constexpr size_t OFF_PB = OFF_RS + (size_t)16640 * 4;
constexpr size_t OFF_Z = OFF_PB + (size_t)MT * DP * 2;
constexpr size_t OFF_SCN = OFF_Z + (size_t)MT * NZ * 2;
constexpr size_t OFF_BAR = OFF_SCN + (size_t)MT * NH * 384 * 2;
constexpr size_t WS_END = OFF_BAR + 16384;
constexpr size_t OFF_H1B = OFF_Z;
constexpr size_t OFF_PPB = OFF_H1B + (size_t)MT * D * 2;
static_assert(OFF_PPB + (size_t)MT * D * 2 <= OFF_SCN, "overlay");
constexpr size_t OFF_CHK = OFF_SCN;
constexpr size_t OFF_SALL = OFF_CHK + (size_t)2048 * 16384 * 2;
constexpr size_t OFF_OS = OFF_SALL + (size_t)2048 * 4096 * 2;
constexpr size_t OFF_SCNS = OFF_OS + (size_t)128 * 512 * 2;
constexpr size_t OFF_RK = OFF_SCNS + (size_t)MS * NH * 384 * 2;
static_assert(OFF_RK + (size_t)2048 * 64 * 4 <= OFF_BAR, "overlay");
constexpr size_t O_Y = 0, O_CONVP = (size_t)MT * D, O_SHIFTP = O_CONVP + 8 * 2 * 512, O_WKVP = O_SHIFTP + 8 * SW,
                 O_CONVS = O_WKVP + 8 * 8 * 64 * 64, O_SHIFTS = O_CONVS + 128 * 2 * 512, O_WKVS = O_SHIFTS + 128 * SW;

struct Args { const float* in[24]; float* out; unsigned char* ws; int ph_lo, ph_hi; };

__device__ __forceinline__ float bf2f(unsigned short b) { return __uint_as_float(((unsigned)b) << 16); }
__device__ __forceinline__ float bflo(unsigned w) { return __uint_as_float(w << 16); }
__device__ __forceinline__ float bfhi(unsigned w) { return __uint_as_float(w & 0xffff0000u); }
__device__ __forceinline__ unsigned short f2bf(float f) { return (unsigned short)(cvt_pk_bf16(f, 0.f) & 0xffffu); }
__device__ __forceinline__ void unpack8(const u32x4 q, float (&f)[8]) {
    f[0] = bflo(q.x); f[1] = bfhi(q.x); f[2] = bflo(q.y); f[3] = bfhi(q.y); f[4] = bflo(q.z); f[5] = bfhi(q.z); f[6] = bflo(q.w); f[7] = bfhi(q.w); }
__device__ __forceinline__ void unpack4(const u32x2 q, float (&f)[4]) { f[0] = bflo(q.x); f[1] = bfhi(q.x); f[2] = bflo(q.y); f[3] = bfhi(q.y); }
__device__ __forceinline__ u32x4 pack8(const float (&f)[8]) { u32x4 q; q.x = cvt_pk_bf16(f[0], f[1]); q.y = cvt_pk_bf16(f[2], f[3]); q.z = cvt_pk_bf16(f[4], f[5]); q.w = cvt_pk_bf16(f[6], f[7]); return q; }
__device__ __forceinline__ u32x2 pack4(float a, float b, float c, float d) { u32x2 q; q.x = cvt_pk_bf16(a, b); q.y = cvt_pk_bf16(c, d); return q; }
__device__ __forceinline__ float sigmoidf_(float x) { return __builtin_amdgcn_rcpf(1.0f + __expf(-x)); }
__device__ __forceinline__ float siluf_(float x) { return x * __builtin_amdgcn_rcpf(1.0f + __expf(-x)); }
template <int CTRL> __device__ __forceinline__ float dppf(float x) { return __int_as_float(__builtin_amdgcn_update_dpp(0, __float_as_int(x), CTRL, 0xf, 0xf, false)); }
__device__ __forceinline__ float rowsum16(float x) { x += dppf<0x128>(x); x += dppf<0x124>(x); x += dppf<0x122>(x); x += dppf<0x121>(x); return x; }

__device__ __forceinline__ f32x4 mini_tile(const bf16_t* arow, const bf16_t* brow, int K, int fq) {
    f32x4 acc = {0.f, 0.f, 0.f, 0.f};
    const bf16_t* ap = arow + fq * 8; const bf16_t* bp = brow + fq * 8;
    for (int k0 = 0; k0 < K; k0 += 256) {
        bf16x8 av[8], bv[8];
#pragma unroll
        for (int j = 0; j < 8; ++j) { av[j] = *(const bf16x8*)(ap + k0 + j * 32); bv[j] = *(const bf16x8*)(bp + k0 + j * 32); }
#pragma unroll
        for (int j = 0; j < 8; ++j) acc = __builtin_amdgcn_mfma_f32_16x16x32_bf16(bv[j], av[j], acc, 0, 0, 0);
    }
    return acc;
}

template <int NSTEP> __device__ __forceinline__ f32x4 mini_tile_k(const bf16_t* arow, const bf16_t* brow, int fq) {
    f32x4 acc = {0.f, 0.f, 0.f, 0.f};
    bf16x8 av[NSTEP], bv[NSTEP];
#pragma unroll
    for (int j = 0; j < NSTEP; ++j) { av[j] = *(const bf16x8*)(arow + fq * 8 + j * 32); bv[j] = *(const bf16x8*)(brow + fq * 8 + j * 32); }
#pragma unroll
    for (int j = 0; j < NSTEP; ++j) acc = __builtin_amdgcn_mfma_f32_16x16x32_bf16(bv[j], av[j], acc, 0, 0, 0);
    return acc;
}
__device__ __forceinline__ f32x4 splitk_reduce(LAS unsigned char* lds, f32x4 acc, int wave, int lane) {
    LAS f32x4* red = (LAS f32x4*)lds;
    __syncthreads();
    red[wave * 64 + lane] = acc;
    __syncthreads();
    if ((wave & 3) == 0) acc = (acc + red[(wave + 1) * 64 + lane]) + (red[(wave + 2) * 64 + lane] + red[(wave + 3) * 64 + lane]);
    return acc;
}

struct EpiZ {
    static constexpr bool PERM = true, AFTER_DRAIN = false;
    bf16_t* Z; const float* rs;
    __device__ __forceinline__ void operator()(const f32x4 (&acc)[2][2][4][2], const Unit& u, int wr, int wc, int fr, int fq) const {
        const int row0 = u.pm * 256 + wr * 64 + fr, col0 = u.pn * 256 + wc * 32 + 8 * fq;
        float sc[2][4];
#pragma unroll
        for (int ai = 0; ai < 2; ++ai)
#pragma unroll
            for (int m = 0; m < 4; ++m) sc[ai][m] = rs[row0 + ai * 128 + m * 16];
#pragma unroll
        for (int ai = 0; ai < 2; ++ai)
#pragma unroll
            for (int m = 0; m < 4; ++m) { const int row = row0 + ai * 128 + m * 16; const float s = sc[ai][m]; bf16_t* rp = Z + (size_t)row * NZ + col0;
#pragma unroll
                for (int bj = 0; bj < 2; ++bj) { if (col0 + bj * 128 < NZ) { const f32x4 v0 = acc[ai][bj][m][0] * s, v1 = acc[ai][bj][m][1] * s; u32x4 w;
                    w.x = cvt_pk_bf16(v0[0], v0[1]); w.y = cvt_pk_bf16(v0[2], v0[3]); w.z = cvt_pk_bf16(v1[0], v1[1]); w.w = cvt_pk_bf16(v1[2], v1[3]); *(u32x4*)(rp + bj * 128) = w; } } }
    }
};
struct EpiH1 {
    static constexpr bool PERM = true, AFTER_DRAIN = false;
    const float* x; bf16_t* H1B;
    __device__ __forceinline__ void operator()(const f32x4 (&acc)[2][2][4][2], const Unit& u, int wr, int wc, int fr, int fq) const {
        const int row0 = u.pm * 256 + wr * 64 + fr, col0 = u.pn * 256 + wc * 32 + 8 * fq;
#pragma unroll
        for (int ai = 0; ai < 2; ++ai)
#pragma unroll
            for (int mp = 0; mp < 2; ++mp) {
                f32x4 xv[2][2][2];
#pragma unroll
                for (int mm = 0; mm < 2; ++mm)
#pragma unroll
                    for (int bj = 0; bj < 2; ++bj) { const size_t o = (size_t)(row0 + ai * 128 + (mp * 2 + mm) * 16) * D + col0 + bj * 128; xv[mm][bj][0] = *(const f32x4*)(x + o); xv[mm][bj][1] = *(const f32x4*)(x + o + 4); }
#pragma unroll
                for (int mm = 0; mm < 2; ++mm)
#pragma unroll
                    for (int bj = 0; bj < 2; ++bj) { const int m = mp * 2 + mm; const size_t o = (size_t)(row0 + ai * 128 + m * 16) * D + col0 + bj * 128;
                        const f32x4 v0 = xv[mm][bj][0] + acc[ai][bj][m][0], v1 = xv[mm][bj][1] + acc[ai][bj][m][1]; u32x4 w;
                        w.x = cvt_pk_bf16(v0[0], v0[1]); w.y = cvt_pk_bf16(v0[2], v0[3]); w.z = cvt_pk_bf16(v1[0], v1[1]); w.w = cvt_pk_bf16(v1[2], v1[3]); *(u32x4*)(H1B + o) = w; }
                asm volatile("" ::: "memory"); }
    }
};
struct EpiF32 {
    static constexpr bool PERM = true, AFTER_DRAIN = false;
    bf16_t* C;
    __device__ __forceinline__ void operator()(const f32x4 (&acc)[2][2][4][2], const Unit& u, int wr, int wc, int fr, int fq) const {
        const int row0 = u.pm * 256 + wr * 64 + fr, col0 = u.pn * 256 + wc * 32 + 8 * fq;
#pragma unroll
        for (int ai = 0; ai < 2; ++ai)
#pragma unroll
            for (int m = 0; m < 4; ++m) { const size_t off = (size_t)(row0 + ai * 128 + m * 16) * D + col0;
#pragma unroll
                for (int bj = 0; bj < 2; ++bj) { const f32x4 v0 = acc[ai][bj][m][0], v1 = acc[ai][bj][m][1]; u32x4 w;
                    w.x = cvt_pk_bf16(v0[0], v0[1]); w.y = cvt_pk_bf16(v0[2], v0[3]); w.z = cvt_pk_bf16(v1[0], v1[1]); w.w = cvt_pk_bf16(v1[2], v1[3]); *(u32x4*)(C + off + bj * 128) = w; } }
    }
};
struct EpiH2 {
    static constexpr bool PERM = true, AFTER_DRAIN = false;
    const bf16_t* H1; const bf16_t* PP; float* out;
    __device__ __forceinline__ void operator()(const f32x4 (&acc)[2][2][4][2], const Unit& u, int wr, int wc, int fr, int fq) const {
        const int row0 = u.pm * 256 + wr * 64 + fr, col0 = u.pn * 256 + wc * 32 + 8 * fq;
#pragma unroll
        for (int ai = 0; ai < 2; ++ai)
#pragma unroll
            for (int mp = 0; mp < 2; ++mp) {
                u32x4 qh[2][2], qp[2][2];
#pragma unroll
                for (int mm = 0; mm < 2; ++mm)
#pragma unroll
                    for (int bj = 0; bj < 2; ++bj) { const size_t o = (size_t)(row0 + ai * 128 + (mp * 2 + mm) * 16) * D + col0 + bj * 128; qh[mm][bj] = *(const u32x4*)(H1 + o); qp[mm][bj] = *(const u32x4*)(PP + o); }
#pragma unroll
                for (int mm = 0; mm < 2; ++mm)
#pragma unroll
                    for (int bj = 0; bj < 2; ++bj) { const int m = mp * 2 + mm; const size_t o = (size_t)(row0 + ai * 128 + m * 16) * D + col0 + bj * 128; float h[8], p[8]; unpack8(qh[mm][bj], h); unpack8(qp[mm][bj], p);
                        const f32x4 g0 = acc[ai][bj][m][0], g1 = acc[ai][bj][m][1]; f32x4 v0, v1;
#pragma unroll
                        for (int e = 0; e < 4; ++e) { v0[e] = h[e] + sigmoidf_(g0[e]) * p[e]; v1[e] = h[4 + e] + sigmoidf_(g1[e]) * p[4 + e]; }
                        *(f32x4*)(out + o) = v0; *(f32x4*)(out + o + 4) = v1; }
                asm volatile("" ::: "memory"); }
    }
};

struct P0Job { const float* src; bf16_t* dst; const float* gsc; int K, N, k0, n0; };
__device__ __forceinline__ P0Job p0_decode(const Args& a, int job) {
    constexpr int NJ_IN = 16 * 68, NJ_SQ = 256, NJ_PP = 64, NJ_LO = 8;
    unsigned char* ws = a.ws; P0Job J; J.gsc = nullptr; int kt, nt; int j = job;
    if (j < NJ_IN) { J.src = a.in[8]; J.dst = (bf16_t*)(ws + OFF_WIN); J.gsc = a.in[7]; J.K = 1024; J.N = NZ; kt = j & 15; nt = j >> 4; }
    else if ((j -= NJ_IN) < NJ_SQ) { J.src = a.in[20]; J.dst = (bf16_t*)(ws + OFF_WOUT); J.K = 1024; J.N = 1024; kt = j & 15; nt = j >> 4; }
    else if ((j -= NJ_SQ) < NJ_SQ) { J.src = a.in[21]; J.dst = (bf16_t*)(ws + OFF_WPG); J.K = 1024; J.N = 1024; kt = j & 15; nt = j >> 4; }
    else if ((j -= NJ_SQ) < NJ_PP) { J.src = a.in[22]; J.dst = (bf16_t*)(ws + OFF_WPP); J.K = 256; J.N = 1024; kt = j & 3; nt = j >> 2; }
    else if ((j -= NJ_PP) < NJ_LO) { J.src = a.in[12]; J.dst = (bf16_t*)(ws + OFF_WUP); J.K = 64; J.N = 512; kt = 0; nt = j; }
    else { j -= NJ_LO; J.src = a.in[14]; J.dst = (bf16_t*)(ws + OFF_AUP); J.K = 64; J.N = 512; kt = 0; nt = j; }
    J.k0 = kt * 64; J.n0 = nt * 64; return J;
}
__device__ void p0_prep(const Args& a, LAS unsigned char* lds) {
    const int tid = threadIdx.x, G = gridDim.x, blk = blockIdx.x, wave = tid >> 6, lane = tid & 63;
    LAS float* tile = (LAS float*)lds;
    unsigned char* ws = a.ws;
    constexpr int NJOBS = 16 * 68 + 2 * 256 + 64 + 2 * 8, MAXJ = 7;
    const int li = tid >> 4, lj = (tid & 15) * 4;
    for (int base = blk; base < NJOBS; base += G * MAXJ) {
        f32x4 v[MAXJ][2];
#pragma unroll
        for (int sl = 0; sl < MAXJ; ++sl) { const int job = base + sl * G;
            if (job < NJOBS) { const P0Job J = p0_decode(a, job);
#pragma unroll
                for (int q = 0; q < 2; ++q) { const int i = li + 32 * q; f32x4 x = {0.f, 0.f, 0.f, 0.f};
                    if (J.n0 + lj < J.N) { x = *(const f32x4*)(J.src + (size_t)(J.k0 + i) * J.N + J.n0 + lj); if (J.gsc) x = x * J.gsc[J.k0 + i]; }
                    v[sl][q] = x; } } }
#pragma unroll
        for (int sl = 0; sl < MAXJ; ++sl) { const int job = base + sl * G;
            if (job < NJOBS) { const P0Job J = p0_decode(a, job);
#pragma unroll
                for (int q = 0; q < 2; ++q) { const int i = li + 32 * q;
#pragma unroll
                    for (int e = 0; e < 4; ++e) tile[i * 65 + lj + e] = v[sl][q][e]; }
                LBAR();
#pragma unroll
                for (int it = 0; it < 4; ++it) { const int item = it * 512 + tid, jj = item >> 5, i2 = item & 31;
                    *(unsigned*)(J.dst + (size_t)(J.n0 + jj) * J.K + J.k0 + 2 * i2) = cvt_pk_bf16(tile[(2 * i2) * 65 + jj], tile[(2 * i2 + 1) * 65 + jj]); }
                LBAR(); } }
    }
    bf16_t* XB = (bf16_t*)a.out; float* RS = (float*)(ws + OFF_RS);
    for (int row0 = (blk * 8 + wave) * 2; row0 < MT; row0 += G * 16) {
        f32x4 v[2][4];
#pragma unroll
        for (int r = 0; r < 2; ++r) { const int row = row0 + r; const float* src = row < MP ? a.in[0] + (size_t)row * D : a.in[1] + (size_t)(row - MP) * D;
#pragma unroll
            for (int i = 0; i < 4; ++i) v[r][i] = *(const f32x4*)(src + i * 256 + lane * 4); }
#pragma unroll
        for (int r = 0; r < 2; ++r) { const int row = row0 + r; float ss = 0.f;
#pragma unroll
            for (int i = 0; i < 4; ++i) { const f32x4 x = v[r][i]; ss += x[0] * x[0] + x[1] * x[1] + x[2] * x[2] + x[3] * x[3];
                *(u32x2*)(XB + (size_t)row * D + i * 256 + lane * 4) = pack4(x[0], x[1], x[2], x[3]); }
#pragma unroll
            for (int o = 32; o >= 1; o >>= 1) ss += __shfl_xor(ss, o);
            if (lane == 0) RS[row] = rsqrtf(ss * (1.0f / D) + 1e-6f); }
    }
    bf16_t* PB = (bf16_t*)(ws + OFF_PB);
    constexpr size_t NP4 = (size_t)MT * DP / 4;
    for (size_t i0 = (size_t)blk * 512 + tid; i0 < NP4; i0 += (size_t)G * 512 * 4) {
        f32x4 v[4];
#pragma unroll
        for (int u = 0; u < 4; ++u) { const size_t i = i0 + (size_t)u * G * 512; const size_t e = i * 4;
            if (i < NP4) v[u] = e < (size_t)MP * DP ? *(const f32x4*)(a.in[2] + e) : *(const f32x4*)(a.in[3] + (e - (size_t)MP * DP)); }
#pragma unroll
        for (int u = 0; u < 4; ++u) { const size_t i = i0 + (size_t)u * G * 512; if (i < NP4) *(u32x2*)(PB + i * 4) = pack4(v[u][0], v[u][1], v[u][2], v[u][3]); }
    }
}

__device__ void p1_gemm_in(const Args& a, LAS unsigned char* lds) {
    const int tid = threadIdx.x, G = gridDim.x, blk = blockIdx.x, wave = tid >> 6, lane = tid & 63, fr = lane & 15, fq = lane >> 4;
    unsigned char* ws = a.ws;
    const bf16_t* XB = (const bf16_t*)a.out; const bf16_t* WinT = (const bf16_t*)(ws + OFF_WIN); const float* RS = (const float*)(ws + OFF_RS); bf16_t* Z = (bf16_t*)(ws + OFF_Z);
    {
        pg8::Gemm g{XB, WinT, MP, NZP, D}; pg8::StaticOrder S; S.init(MP, NZP, G, blk); EpiZ E{Z, RS};
        pg8::gemm_phase<EpiZ, pg8::StaticOrder>(lds, g, S, E, nullptr);
    }
    const int first = (G == 256) ? 64 : 0;
    if (blk >= first)
        for (int t = (blk - first) * 8 + wave; t < 8 * (NZ / 16); t += (G - first) * 8) {
            const int rt = t & 7, ct = t >> 3; const int row = MP + rt * 16 + fr;
            const f32x4 acc = mini_tile(XB + (size_t)row * D, WinT + (size_t)(ct * 16 + fr) * D, D, fq);
            const float s = RS[row];
            *(u32x2*)(Z + (size_t)row * NZ + ct * 16 + 4 * fq) = pack4(acc[0] * s, acc[1] * s, acc[2] * s, acc[3] * s);
        }
}

template <bool smp> __device__ void p2_tile(const Args& a, LAS unsigned char* lds, int tile) {
    const int tid = threadIdx.x, wave = tid >> 6, lane = tid & 63, fr = lane & 15, fq = lane >> 4;
    unsigned char* ws = a.ws;
    const int ntok = smp ? 8 : 64;
    const int m0 = smp ? MP + (tile - 256) * 8 : tile * 64;
    const int t0 = smp ? 0 : (tile & 31) * 64;
    const int bidx = tile >> 5;
    const bf16_t* __restrict__ Z = (const bf16_t*)(ws + OFF_Z); bf16_t* __restrict__ YC = (bf16_t*)a.out; bf16_t* __restrict__ SCN = (bf16_t*)(ws + OFF_SCNS) - (size_t)MP * 8 * 384;
    const float* state_conv = a.in[4]; const float* state_shift = a.in[5]; const float* conv_w = a.in[9]; const float* mu = a.in[10];
    {
        const int c0 = (tid & 63) * 8;
        float cw0[8], cw1[8], cw2[8];
#pragma unroll
        for (int i = 0; i < 8; ++i) { cw0[i] = conv_w[c0 + i]; cw1[i] = conv_w[512 + c0 + i]; cw2[i] = conv_w[1024 + c0 + i]; }
#pragma unroll 2
        for (int tok = tid >> 6; tok < ntok; tok += 8) {
            const int m = m0 + tok, t = t0 + tok;
            const bf16_t* zr = Z + (size_t)m * NZ;
            float fB[8], fC[8], fH[8], fG[8], u0[8], u1[8], u2[8];
            const u32x4 qB = *(const u32x4*)(zr + c0), qC = *(const u32x4*)(zr + 512 + c0), qH = *(const u32x4*)(zr + 1024 + c0), qG = *(const u32x4*)(zr + 1536 + c0);
            if (smp) {
                const float* sc = state_conv + (size_t)(m - MP) * 1024 + c0;
                const f32x4 x0 = *(const f32x4*)(sc), x1 = *(const f32x4*)(sc + 4), y0 = *(const f32x4*)(sc + 512), y1 = *(const f32x4*)(sc + 516);
#pragma unroll
                for (int i = 0; i < 4; ++i) { u2[i] = x0[i]; u2[4 + i] = x1[i]; u1[i] = y0[i]; u1[4 + i] = y1[i]; }
            } else {
                const bf16_t* z1 = t >= 1 ? zr - NZ : zr; const bf16_t* z2 = t >= 2 ? zr - 2 * NZ : zr;
                const u32x4 qC1 = *(const u32x4*)(z1 + 512 + c0), qH1 = *(const u32x4*)(z1 + 1024 + c0), qC2 = *(const u32x4*)(z2 + 512 + c0), qH2 = *(const u32x4*)(z2 + 1024 + c0);
                float c1[8], h1[8], c2[8], h2[8]; unpack8(qC1, c1); unpack8(qH1, h1); unpack8(qC2, c2); unpack8(qH2, h2);
                const float f1 = t >= 1 ? 1.f : 0.f, f2 = t >= 2 ? 1.f : 0.f;
#pragma unroll
                for (int i = 0; i < 8; ++i) { u1[i] = c1[i] * h1[i] * f1; u2[i] = c2[i] * h2[i] * f2; }
            }
            unpack8(qB, fB); unpack8(qC, fC); unpack8(qH, fH); unpack8(qG, fG);
            float y[8];
#pragma unroll
            for (int i = 0; i < 8; ++i) { u0[i] = fC[i] * fH[i]; const float cv = cw0[i] * u2[i] + cw1[i] * u1[i] + cw2[i] * u0[i]; y[i] = fB[i] * cv * siluf_(fG[i]); }
            *(u32x4*)(YC + (size_t)m * D + c0) = pack8(y);
            { float gr[8]; unpack8(*(const u32x4*)(zr + ZC_GR + c0), gr);
#pragma unroll
              for (int i = 0; i < 8; ++i) gr[i] = siluf_(gr[i]);
              *(u32x4*)(YC + (size_t)m * D + 512 + c0) = pack8(gr); }
            float* co = nullptr;
            if (smp) co = a.out + O_CONVS + (size_t)(m - MP) * 1024 + c0; else if (t == TSEQ - 1) co = a.out + O_CONVP + (size_t)bidx * 1024 + c0;
            if (co) {
                *(f32x4*)(co) = (f32x4){u1[0], u1[1], u1[2], u1[3]}; *(f32x4*)(co + 4) = (f32x4){u1[4], u1[5], u1[6], u1[7]};
                *(f32x4*)(co + 512) = (f32x4){u0[0], u0[1], u0[2], u0[3]}; *(f32x4*)(co + 516) = (f32x4){u0[4], u0[5], u0[6], u0[7]}; }
        }
    }
    LAS bf16_t* Awd = (LAS bf16_t*)lds; LAS bf16_t* Aad = Awd + 64 * 72;
    if (smp) {
        const int j0 = (tid & 15) * 8;
        f32x4 m0v = *(const f32x4*)(mu + 1536 + j0), m1v = *(const f32x4*)(mu + 1536 + j0 + 4);
#pragma unroll 2
        for (int tok = tid >> 4; tok < ntok; tok += 32) {
            const int m = m0 + tok;
            const bf16_t* zr = Z + (size_t)m * NZ + ZC_S + 1536 + j0;
            float cur[8], prev[8], zm[8];
            unpack8(*(const u32x4*)zr, cur);
            if (smp) { const float* sp = state_shift + (size_t)(m - MP) * SW + 1536 + j0; const f32x4 x0 = *(const f32x4*)sp, x1 = *(const f32x4*)(sp + 4);
#pragma unroll
                for (int i = 0; i < 4; ++i) { prev[i] = x0[i]; prev[4 + i] = x1[i]; } }
            else { const bool hp = (t0 + tok) >= 1; unpack8(*(const u32x4*)(hp ? zr - NZ : zr), prev);
                if (!hp) {
#pragma unroll
                    for (int i = 0; i < 8; ++i) prev[i] = 0.f; } }
#pragma unroll
            for (int i = 0; i < 8; ++i) { const float mm = i < 4 ? m0v[i] : m1v[i - 4]; zm[i] = cur[i] + (prev[i] - cur[i]) * mm; }
            if (j0 < 64) {
#pragma unroll
                for (int i = 0; i < 8; ++i) { const float e2 = __expf(2.0f * zm[i]); zm[i] = 1.0f - 2.0f * __builtin_amdgcn_rcpf(e2 + 1.0f); }
                *(LAS u32x4*)(Awd + tok * 72 + j0) = pack8(zm);
            } else *(LAS u32x4*)(Aad + tok * 72 + (j0 - 64)) = pack8(zm);
        }
    }
    __syncthreads();
    if (smp) {
        const int h = wave;
        const bf16_t* WupT = (const bf16_t*)(ws + OFF_WUP); const bf16_t* AupT = (const bf16_t*)(ws + OFF_AUP);
        const float* __restrict__ w0 = a.in[11]; const float* __restrict__ a0p = a.in[13]; const float* __restrict__ k_k = a.in[15]; const float* __restrict__ k_a = a.in[16];
        const int nmt = (ntok + 15) >> 4;
#pragma unroll 1
        for (int mt = 0; mt < nmt; ++mt) {
            u32x2 zc[4][3], zq[4][3];
            {   const int tok_ = (mt * 16 + fr) < ntok ? (mt * 16 + fr) : 0; const bf16_t* zr_ = Z + (size_t)(m0 + tok_) * NZ + ZC_S; const bf16_t* zp_ = ((!smp) && (t0 + tok_ >= 1)) ? zr_ - NZ : zr_;
#pragma unroll
                for (int nt = 0; nt < 4; ++nt) { const int c = h * 64 + nt * 16 + 4 * fq;
                    zc[nt][0] = *(const u32x2*)(zr_ + c); zc[nt][1] = *(const u32x2*)(zr_ + 512 + c); zc[nt][2] = *(const u32x2*)(zr_ + 1024 + c);
                    if (!smp) { zq[nt][0] = *(const u32x2*)(zp_ + c); zq[nt][1] = *(const u32x2*)(zp_ + 512 + c); zq[nt][2] = *(const u32x2*)(zp_ + 1024 + c); } } }
            bf16x8 aw[2], aa[2];
#pragma unroll
            for (int ks = 0; ks < 2; ++ks) { aw[ks] = *(const LAS bf16x8*)(Awd + (mt * 16 + fr) * 72 + ks * 32 + fq * 8); aa[ks] = *(const LAS bf16x8*)(Aad + (mt * 16 + fr) * 72 + ks * 32 + fq * 8); }
            f32x4 accw[4], acca[4];
#pragma unroll
            for (int nt = 0; nt < 4; ++nt) { accw[nt] = (f32x4){0.f, 0.f, 0.f, 0.f}; acca[nt] = (f32x4){0.f, 0.f, 0.f, 0.f};
#pragma unroll
                for (int ks = 0; ks < 2; ++ks) { const size_t bo = (size_t)(h * 64 + nt * 16 + fr) * 64 + ks * 32 + fq * 8;
                    accw[nt] = __builtin_amdgcn_mfma_f32_16x16x32_bf16(*(const bf16x8*)(WupT + bo), aw[ks], accw[nt], 0, 0, 0);
                    acca[nt] = __builtin_amdgcn_mfma_f32_16x16x32_bf16(*(const bf16x8*)(AupT + bo), aa[ks], acca[nt], 0, 0, 0); } }
            const bool valid = (mt * 16 + fr) < ntok;
            const int tok = valid ? (mt * 16 + fr) : 0, m = m0 + tok, t = t0 + tok;
            const bf16_t* zr = Z + (size_t)m * NZ + ZC_S;
            const bool hasprev = (!smp) && (t >= 1);
            const bf16_t* zp = hasprev ? zr - NZ : zr;
            const float fp = hasprev ? 1.f : 0.f;
            bf16_t* so = SCN + ((size_t)m * 8 + h) * 384 + 4 * fq;
            float kk[4][4], av[4][4]; float ss = 0.f;
#pragma unroll
            for (int nt = 0; nt < 4; ++nt) {
                const int c = h * 64 + nt * 16 + 4 * fq;
                float cr[4], ck[4], cv[4], pr[4], pk[4], pv[4];
                unpack4(zc[nt][0], cr); unpack4(zc[nt][1], ck); unpack4(zc[nt][2], cv);
                if (smp) { const float* sp = state_shift + (size_t)(m - MP) * SW + c; const f32x4 x0 = *(const f32x4*)sp, x1 = *(const f32x4*)(sp + 512), x2 = *(const f32x4*)(sp + 1024);
#pragma unroll
                    for (int i = 0; i < 4; ++i) { pr[i] = x0[i]; pk[i] = x1[i]; pv[i] = x2[i]; } }
                else { unpack4(zq[nt][0], pr); unpack4(zq[nt][1], pk); unpack4(zq[nt][2], pv);
#pragma unroll
                    for (int i = 0; i < 4; ++i) { pr[i] *= fp; pk[i] *= fp; pv[i] *= fp; } }
                const f32x4 mr = *(const f32x4*)(mu + c), mk = *(const f32x4*)(mu + 512 + c), mv = *(const f32x4*)(mu + 1024 + c);
                const f32x4 w0v = *(const f32x4*)(w0 + c), a0v = *(const f32x4*)(a0p + c), kkv = *(const f32x4*)(k_k + c), kav = *(const f32x4*)(k_a + c);
                float r_[4], e_[4], kp[4], v_[4];
#pragma unroll
                for (int i = 0; i < 4; ++i) {
                    r_[i] = cr[i] + (pr[i] - cr[i]) * mr[i]; const float k = ck[i] + (pk[i] - ck[i]) * mk[i]; v_[i] = cv[i] + (pv[i] - cv[i]) * mv[i];
                    e_[i] = 0.60653065971f * sigmoidf_(w0v[i] + accw[nt][i]);
                    const float al = sigmoidf_(a0v[i] + acca[nt][i]); av[nt][i] = al;
                    const float kq = k * kkv[i]; kk[nt][i] = kq; ss += kq * kq;
                    kp[i] = k * (1.0f + (al - 1.0f) * kav[i]);
                }
                if (valid) {
                *(u32x2*)(so + 0 * 64 + nt * 16) = pack4(r_[0], r_[1], r_[2], r_[3]);
                *(u32x2*)(so + 1 * 64 + nt * 16) = pack4(e_[0], e_[1], e_[2], e_[3]);
                *(u32x2*)(so + 2 * 64 + nt * 16) = pack4(kp[0], kp[1], kp[2], kp[3]);
                *(u32x2*)(so + 3 * 64 + nt * 16) = pack4(v_[0], v_[1], v_[2], v_[3]); }
            }
            ss += __shfl_xor(ss, 16); ss += __shfl_xor(ss, 32);
            const float inv = 1.0f / fmaxf(sqrtf(ss), 1e-12f);
#pragma unroll
            for (int nt = 0; nt < 4; ++nt) {
                float q[4], b[4];
#pragma unroll
                for (int i = 0; i < 4; ++i) { q[i] = kk[nt][i] * inv; b[i] = q[i] * av[nt][i]; }
                if (valid) {
                *(u32x2*)(so + 4 * 64 + nt * 16) = pack4(q[0], q[1], q[2], q[3]);
                *(u32x2*)(so + 5 * 64 + nt * 16) = pack4(b[0], b[1], b[2], b[3]); }
            }
        }
    }
    if (!smp && (tile & 31) == 31) { for (int j = tid; j < SW; j += 512) a.out[O_SHIFTP + (size_t)bidx * SW + j] = bf2f(Z[(size_t)(m0 + 63) * NZ + ZC_S + j]); }
    __syncthreads();
}
__device__ void p2_all(const Args& a, LAS unsigned char* lds) {
    const int tid = threadIdx.x, G = gridDim.x, blk = blockIdx.x;
    for (int t = blk; t < 272; t += G) { if (t < 256) p2_tile<false>(a, lds, t); else p2_tile<true>(a, lds, t); }
    const bf16_t* Z = (const bf16_t*)(a.ws + OFF_Z);
    for (int idx = blk * 512 + tid; idx < MS * SW; idx += G * 512) { const int sidx = idx / SW, j = idx - sidx * SW; a.out[O_SHIFTS + idx] = bf2f(Z[(size_t)(MP + sidx) * NZ + ZC_S + j]); }
}

constexpr int SLOT = 64 * 72;
__device__ __forceinline__ void mm_nt(const LAS bf16_t* X, const LAS bf16_t* Y, int it, int jt0, int fr, int fq, f32x4 (&acc)[2]) {
    bf16x8 xa[2];
#pragma unroll
    for (int ks = 0; ks < 2; ++ks) xa[ks] = *(const LAS bf16x8*)(X + (it * 16 + fr) * 72 + ks * 32 + fq * 8);
#pragma unroll
    for (int u = 0; u < 2; ++u)
#pragma unroll
        for (int ks = 0; ks < 2; ++ks) acc[u] = __builtin_amdgcn_mfma_f32_16x16x32_bf16(*(const LAS bf16x8*)(Y + ((jt0 + u) * 16 + fr) * 72 + ks * 32 + fq * 8), xa[ks], acc[u], 0, 0, 0);
}
template <int MASK> __device__ __forceinline__ f32x4 mask4(f32x4 v, int i, int j0) {
#pragma unroll
    for (int e = 0; e < 4; ++e) { const int j = j0 + e; const bool keep = MASK == 0 ? true : MASK == 1 ? (j < i) : MASK == 2 ? (j > i) : (j <= i); v[e] = keep ? v[e] : 0.f; }
    return v;
}
__device__ __forceinline__ void st4(LAS bf16_t* dst, int i, int j0, f32x4 v) { *(LAS u32x2*)(dst + i * 72 + j0) = pack4(v[0], v[1], v[2], v[3]); }
__device__ __forceinline__ f32x4 ld4(const LAS bf16_t* src, int i, int j0) { float f[4]; unpack4(*(const LAS u32x2*)(src + i * 72 + j0), f); return (f32x4){f[0], f[1], f[2], f[3]}; }
__device__ __forceinline__ void st4t(LAS bf16_t* dst, int i, int j0, f32x4 v) {
    const unsigned lo = cvt_pk_bf16(v[0], v[1]), hi = cvt_pk_bf16(v[2], v[3]);
    dst[(j0 + 0) * 72 + i] = (bf16_t)(lo & 0xffffu); dst[(j0 + 1) * 72 + i] = (bf16_t)(lo >> 16); dst[(j0 + 2) * 72 + i] = (bf16_t)(hi & 0xffffu); dst[(j0 + 3) * 72 + i] = (bf16_t)(hi >> 16); }
__device__ __forceinline__ void stg4(bf16_t* dst, int i, int j0, f32x4 v) { *(u32x2*)(dst + i * 64 + j0) = pack4(v[0], v[1], v[2], v[3]); }
#define ZACC() do { acc[0] = (f32x4){0.f, 0.f, 0.f, 0.f}; acc[1] = (f32x4){0.f, 0.f, 0.f, 0.f}; } while (0)

__device__ void p3a_chunks(const Args& a, LAS unsigned char* lds) {
    const int tid = threadIdx.x, G = gridDim.x, blk = blockIdx.x, wave = tid >> 6, lane = tid & 63, fr = lane & 15, fq = lane >> 4;
    unsigned char* ws = a.ws;
    const bf16_t* SCN = (const bf16_t*)(ws + OFF_SCNS) - (size_t)MP * 8 * 384;
    bf16_t* CHK = (bf16_t*)(ws + OFF_CHK); const bf16_t* Z = (const bf16_t*)(ws + OFF_Z); float* RK = (float*)(ws + OFF_RK);
    const bf16_t* WupT = (const bf16_t*)(ws + OFF_WUP); const bf16_t* AupT = (const bf16_t*)(ws + OFF_AUP);
    LAS bf16_t* SL = (LAS bf16_t*)lds;
#define S_(n) (SL + (n) * SLOT)
    LAS bf16_t* zraw = S_(8);
    LAS float* tot = (LAS float*)(lds + 17 * SLOT * 2);
    LAS float* pc = tot + 512;
    LAS float* LWf = (LAS float*)(lds + 2 * SLOT * 2);
    LAS float* LAf = (LAS float*)(lds + 4 * SLOT * 2);
    const int it = wave >> 1, jt0 = (wave & 1) * 2, irow = it * 16 + fr;
    u32x4 rg[6];
#define P3A_LOAD(unit_) do { const int bh_ = (unit_) >> 5, c_ = (unit_) & 31; const int mm0 = (bh_ >> 3) * TSEQ + c_ * 64; const int hh = bh_ & 7; \
        _Pragma("unroll") for (int i = 0; i < 6; ++i) { const int p = tid + 512 * i; if (p < 65 * 40) { const int rr = p / 40, sg = p - rr * 40, seg = sg >> 3, o8 = sg & 7; \
            const int col = seg < 3 ? (ZC_S + seg * 512 + hh * 64) : (ZC_S + 1536 + (seg - 3) * 64); const int mrow = (rr == 0 && c_ == 0) ? mm0 : (mm0 - 1 + rr); \
            rg[i] = *(const u32x4*)(Z + (size_t)mrow * NZ + col + o8 * 8); } } } while (0)
    if (blk < 2048) P3A_LOAD(blk);
    int hcur = -1;
    float mur = 0.f, muk = 0.f, muv = 0.f, muwd = 0.f, muad = 0.f, w0k = 0.f, a0k = 0.f, kkk = 0.f, kak = 0.f, rkk = 0.f;
    for (int unit = blk; unit < 2048; unit += G) {
        const int h = (unit >> 5) & 7, c = unit & 31, k = tid & 63, g = tid >> 6;
        if (h != hcur) {
            const float* mu = a.in[10];
            mur = mu[h * 64 + k]; muk = mu[512 + h * 64 + k]; muv = mu[1024 + h * 64 + k]; muwd = mu[1536 + k]; muad = mu[1600 + k];
            w0k = a.in[11][h * 64 + k]; a0k = a.in[13][h * 64 + k]; kkk = a.in[15][h * 64 + k]; kak = a.in[16][h * 64 + k]; rkk = a.in[17][h * 64 + k];
            const int row = tid >> 3, o8 = tid & 7;
            *(LAS u32x4*)(S_(15) + row * 72 + o8 * 8) = *(const u32x4*)(WupT + (size_t)(h * 64 + row) * 64 + o8 * 8);
            *(LAS u32x4*)(S_(16) + row * 72 + o8 * 8) = *(const u32x4*)(AupT + (size_t)(h * 64 + row) * 64 + o8 * 8);
            hcur = h; }
#pragma unroll
        for (int i = 0; i < 6; ++i) { const int p = tid + 512 * i; if (p < 65 * 40) { const int rr = p / 40, sg = p - rr * 40, seg = sg >> 3, o8 = sg & 7; *(LAS u32x4*)(zraw + rr * 320 + seg * 64 + o8 * 8) = rg[i]; } }
        LBAR();
        float r_[8], kx[8], v_[8];
        {
            const float fp0 = (c != 0) ? 1.f : 0.f;
            float zz[9][5];
#pragma unroll
            for (int rr = 0; rr < 9; ++rr) { const LAS bf16_t* zp_ = zraw + (g * 8 + rr) * 320 + k;
#pragma unroll
                for (int sg = 0; sg < 5; ++sg) zz[rr][sg] = bf2f(zp_[sg * 64]); }
            if (g == 0) {
#pragma unroll
                for (int sg = 0; sg < 5; ++sg) zz[0][sg] *= fp0; }
#pragma unroll
            for (int j = 0; j < 8; ++j) { const int t = g * 8 + j;
                const float c0 = zz[j + 1][0], c1 = zz[j + 1][1], c2 = zz[j + 1][2], c3 = zz[j + 1][3], c4 = zz[j + 1][4];
                const float p0 = zz[j][0], p1 = zz[j][1], p2 = zz[j][2], p3 = zz[j][3], p4 = zz[j][4];
                r_[j] = c0 + (p0 - c0) * mur; kx[j] = c1 + (p1 - c1) * muk; v_[j] = c2 + (p2 - c2) * muv;
                const float wd = c3 + (p3 - c3) * muwd, ad = c4 + (p4 - c4) * muad;
                const float e2 = __expf(2.0f * wd);
                S_(0)[t * 72 + k] = f2bf(1.0f - 2.0f * __builtin_amdgcn_rcpf(e2 + 1.0f)); S_(1)[t * 72 + k] = f2bf(ad); }
        }
        LBAR();
        f32x4 acc[2];
        ZACC(); mm_nt(S_(0), S_(15), it, jt0, fr, fq, acc);
#pragma unroll
        for (int u = 0; u < 2; ++u) *(LAS f32x4*)(LWf + irow * 64 + (jt0 + u) * 16 + 4 * fq) = acc[u];
        ZACC(); mm_nt(S_(1), S_(16), it, jt0, fr, fq, acc);
#pragma unroll
        for (int u = 0; u < 2; ++u) *(LAS f32x4*)(LAf + irow * 64 + (jt0 + u) * 16 + 4 * fq) = acc[u];
        LBAR();
        {
            float ev[8], cs[8], qn[8], bbv[8], kpv[8]; float run = 0.f;
#pragma unroll
            for (int j = 0; j < 8; ++j) { const int t = g * 8 + j;
                const float e = 0.60653065971f * sigmoidf_(w0k + LWf[t * 64 + k]); const float al = sigmoidf_(a0k + LAf[t * 64 + k]);
                const float kq = kx[j] * kkk, kp = kx[j] * (1.0f + (al - 1.0f) * kak);
                float ss = kq * kq, rs_ = r_[j] * kp * rkk;
                ss = rowsum16(ss); rs_ = rowsum16(rs_);
                ss += __shfl_xor(ss, 16); rs_ += __shfl_xor(rs_, 16); ss += __shfl_xor(ss, 32); rs_ += __shfl_xor(rs_, 32);
                const float inv = __builtin_amdgcn_rsqf(fmaxf(ss, 1e-24f));
                qn[j] = kq * inv; bbv[j] = qn[j] * al; kpv[j] = kp;
                if (lane == 0) RK[(size_t)unit * 64 + t] = rs_;
                ev[j] = e; run += e; cs[j] = run; }
            tot[g * 64 + k] = run;
            LBAR();
            float off = 0.f;
#pragma unroll
            for (int gg = 0; gg < 7; ++gg) { const float tv = tot[gg * 64 + k]; off += gg < g ? tv : 0.f; }
            float ak[8], bk[8], kk_[8];
#pragma unroll
            for (int j = 0; j < 8; ++j) { const int t = g * 8 + j; const float cum = off + cs[j];
                const float P = __expf(-cum), Pm1 = __expf(ev[j] - cum), iP = __builtin_amdgcn_rcpf(P);
                const float at = -qn[j] * Pm1, bt = bbv[j] * iP, kt = kpv[j] * iP, rt = r_[j] * P;
                S_(0)[t * 72 + k] = f2bf(at); S_(1)[t * 72 + k] = f2bf(bt); S_(2)[t * 72 + k] = f2bf(kt); S_(3)[t * 72 + k] = f2bf(rt);
                ak[j] = at; bk[j] = bt; kk_[j] = kt;
                if (j == 7 && g == 7) pc[k] = P; }
            *(LAS u32x4*)(S_(4) + k * 72 + g * 8) = pack8(ak); *(LAS u32x4*)(S_(5) + k * 72 + g * 8) = pack8(bk);
            *(LAS u32x4*)(S_(6) + k * 72 + g * 8) = pack8(kk_); *(LAS u32x4*)(S_(7) + k * 72 + g * 8) = pack8(v_);
        }
        LBAR();
        { const int nxt = (unit + G < 2048) ? unit + G : unit; P3A_LOAD(nxt); }
        ZACC(); mm_nt(S_(0), S_(1), it, jt0, fr, fq, acc);
#pragma unroll
        for (int u = 0; u < 2; ++u) { const int j0 = (jt0 + u) * 16 + 4 * fq; f32x4 v = mask4<1>(acc[u], irow, j0); st4(S_(11), irow, j0, v); st4t(S_(12), irow, j0, v);
#pragma unroll
            for (int e = 0; e < 4; ++e) v[e] += (j0 + e == irow) ? 1.f : 0.f;
            st4(S_(13), irow, j0, v); }
        ZACC(); mm_nt(S_(0), S_(2), it, jt0, fr, fq, acc);
#pragma unroll
        for (int u = 0; u < 2; ++u) { const int j0 = (jt0 + u) * 16 + 4 * fq; st4(S_(8), irow, j0, mask4<1>(acc[u], irow, j0)); }
        ZACC(); mm_nt(S_(3), S_(1), it, jt0, fr, fq, acc);
#pragma unroll
        for (int u = 0; u < 2; ++u) { const int j0 = (jt0 + u) * 16 + 4 * fq; st4(S_(9), irow, j0, mask4<3>(acc[u], irow, j0)); }
        ZACC(); mm_nt(S_(3), S_(2), it, jt0, fr, fq, acc);
#pragma unroll
        for (int u = 0; u < 2; ++u) { const int j0 = (jt0 + u) * 16 + 4 * fq; st4(S_(10), irow, j0, mask4<3>(acc[u], irow, j0)); }
        LBAR();
        ZACC(); mm_nt(S_(11), S_(12), it, jt0, fr, fq, acc);
#pragma unroll
        for (int u = 0; u < 2; ++u) { st4(S_(1), irow, (jt0 + u) * 16 + 4 * fq, acc[u]); st4t(S_(2), irow, (jt0 + u) * 16 + 4 * fq, acc[u]); }
        ZACC(); mm_nt(S_(7), S_(8), it, jt0, fr, fq, acc);
#pragma unroll
        for (int u = 0; u < 2; ++u) st4(S_(0), irow, (jt0 + u) * 16 + 4 * fq, acc[u]);
        LBAR();
#pragma unroll
        for (int sgi = 0; sgi < 4; ++sgi) {
            const int pa = (sgi & 1) ? 11 : 1, pta = (sgi & 1) ? 12 : 2, pb = (sgi & 1) ? 1 : 11, ptb = (sgi & 1) ? 2 : 12, tla = (sgi & 1) ? 14 : 13, tlb = (sgi & 1) ? 13 : 14;
            ZACC(); mm_nt(S_(tla), S_(pta), it, jt0, fr, fq, acc);
#pragma unroll
            for (int u = 0; u < 2; ++u) { const int j0 = (jt0 + u) * 16 + 4 * fq; st4(S_(tlb), irow, j0, acc[u] + ld4(S_(tla), irow, j0)); }
            ZACC(); mm_nt(S_(pa), S_(pta), it, jt0, fr, fq, acc);
#pragma unroll
            for (int u = 0; u < 2; ++u) { if (sgi < 3) st4(S_(pb), irow, (jt0 + u) * 16 + 4 * fq, acc[u]); st4t(S_(ptb), irow, (jt0 + u) * 16 + 4 * fq, acc[u]); }
            LBAR();
        }
        ZACC(); mm_nt(S_(13), S_(2), it, jt0, fr, fq, acc);
#pragma unroll
        for (int u = 0; u < 2; ++u) { const int j0 = (jt0 + u) * 16 + 4 * fq; st4(S_(14), irow, j0, acc[u] + ld4(S_(13), irow, j0)); }
        LBAR();
        ZACC(); mm_nt(S_(0), S_(14), it, jt0, fr, fq, acc);
#pragma unroll
        for (int u = 0; u < 2; ++u) st4(S_(1), irow, (jt0 + u) * 16 + 4 * fq, acc[u]);
        ZACC(); mm_nt(S_(4), S_(14), it, jt0, fr, fq, acc);
#pragma unroll
        for (int u = 0; u < 2; ++u) st4(S_(2), irow, (jt0 + u) * 16 + 4 * fq, acc[u]);
        LBAR();
        bf16_t* chk = CHK + (size_t)unit * 16384;
        ZACC();
        mm_nt(S_(9), S_(2), it, jt0, fr, fq, acc);
#pragma unroll
        for (int u = 0; u < 2; ++u) { const int j0 = (jt0 + u) * 16 + 4 * fq; stg4(chk, irow, j0, acc[u] + ld4(S_(3), irow, j0)); }
        ZACC();
        mm_nt(S_(9), S_(1), it, jt0, fr, fq, acc);
        mm_nt(S_(10), S_(7), it, jt0, fr, fq, acc);
#pragma unroll
        for (int u = 0; u < 2; ++u) stg4(chk + 4096, irow, (jt0 + u) * 16 + 4 * fq, acc[u]);
        ZACC();
        mm_nt(S_(1), S_(5), it, jt0, fr, fq, acc);
        mm_nt(S_(7), S_(6), it, jt0, fr, fq, acc);
#pragma unroll
        for (int u = 0; u < 2; ++u) { const int j0 = (jt0 + u) * 16 + 4 * fq; const f32x4 pv = *(const LAS f32x4*)(pc + j0); stg4(chk + 8192, irow, j0, acc[u] * pv); }
        ZACC();
        mm_nt(S_(5), S_(2), it, jt0, fr, fq, acc);
        { const float pr = pc[irow];
#pragma unroll
          for (int u = 0; u < 2; ++u) { const int j0 = (jt0 + u) * 16 + 4 * fq; f32x4 v = acc[u];
#pragma unroll
              for (int e = 0; e < 4; ++e) v[e] = (v[e] + ((j0 + e == irow) ? 1.f : 0.f)) * pr;
              stg4(chk + 12288, irow, j0, v); } }
        LBAR();
    }
#undef P3A_LOAD
#undef S_
}

__device__ void p3_sample_step(const Args& a, int blk, int G) {
    const int tid = threadIdx.x;
    unsigned char* ws = a.ws;
    const bf16_t* SCN = (const bf16_t*)(ws + OFF_SCNS) - (size_t)MP * 8 * 384;
    const float* state_wkv = a.in[6]; bf16_t* OS = (bf16_t*)(ws + OFF_OS);
    const int row = tid >> 3, c0 = (tid & 7) * 8;
    constexpr int NI = 4;
    for (int it0 = blk; it0 < MS * NH; it0 += G * NI) {
        u32x4 q[NI][5]; f32x4 sA[NI], sB[NI]; unsigned short vq[NI];
#pragma unroll
        for (int n = 0; n < NI; ++n) { const int itn = (it0 + n * G < MS * NH) ? it0 + n * G : it0; const int s_ = itn >> 3, h = itn & 7, m = MP + s_;
            const bf16_t* sc = SCN + ((size_t)m * 8 + h) * 384; const size_t so = ((size_t)(s_ * 8 + h) * 64 + row) * 64 + c0;
            q[n][0] = *(const u32x4*)(sc + c0); q[n][1] = *(const u32x4*)(sc + 64 + c0); q[n][2] = *(const u32x4*)(sc + 128 + c0); q[n][3] = *(const u32x4*)(sc + 256 + c0); q[n][4] = *(const u32x4*)(sc + 320 + c0);
            vq[n] = sc[192 + row]; sA[n] = *(const f32x4*)(state_wkv + so); sB[n] = *(const f32x4*)(state_wkv + so + 4); }
#pragma unroll
        for (int n = 0; n < NI; ++n) { const int itn = it0 + n * G; if (itn < MS * NH) { const int s_ = itn >> 3, h = itn & 7;
            float r_[8], e_[8], kp[8], kq[8], bb[8];
            unpack8(q[n][0], r_); unpack8(q[n][1], e_); unpack8(q[n][2], kp); unpack8(q[n][3], kq); unpack8(q[n][4], bb);
            const float vv = bf2f(vq[n]);
            const size_t so = ((size_t)(s_ * 8 + h) * 64 + row) * 64 + c0;
            float S[8] = {sA[n][0], sA[n][1], sA[n][2], sA[n][3], sB[n][0], sB[n][1], sB[n][2], sB[n][3]};
            float d = 0.f;
#pragma unroll
            for (int i = 0; i < 8; ++i) d += S[i] * kq[i];
            d += __shfl_xor(d, 1); d += __shfl_xor(d, 2); d += __shfl_xor(d, 4);
            float y = 0.f;
#pragma unroll
            for (int i = 0; i < 8; ++i) { S[i] = S[i] * __expf(-e_[i]) + (-d) * bb[i] + vv * kp[i]; y += S[i] * r_[i]; }
            y += __shfl_xor(y, 1); y += __shfl_xor(y, 2); y += __shfl_xor(y, 4);
            *(f32x4*)(a.out + O_WKVS + so) = (f32x4){S[0], S[1], S[2], S[3]}; *(f32x4*)(a.out + O_WKVS + so + 4) = (f32x4){S[4], S[5], S[6], S[7]};
            if ((tid & 7) == 0) OS[(size_t)s_ * 512 + h * 64 + row] = f2bf(y); } }
    }
}

__device__ void p3b_seq(const Args& a, LAS unsigned char* lds) {
    const int tid = threadIdx.x, G = gridDim.x, blk = blockIdx.x, wave = tid >> 6, lane = tid & 63, fr = lane & 15, fq = lane >> 4;
    unsigned char* ws = a.ws;
    const bf16_t* CHK = (const bf16_t*)(ws + OFF_CHK); bf16_t* SALL = (bf16_t*)(ws + OFF_SALL);
    LAS bf16_t* Shi = (LAS bf16_t*)lds; LAS bf16_t* Slo = Shi + 2 * 16 * 72;
    for (int item = blk; item < 256; item += G) {
        const int xcd_ = item & 7, idx_ = item >> 3;
        const int bh = (G == 256) ? xcd_ * 8 + (idx_ >> 2) : (item >> 2), q = (G == 256) ? (idx_ & 3) : (item & 3), j = wave;
        LBAR();
        for (int i = tid; i < 16 * 72; i += 512) { Shi[i] = 0; Slo[i] = 0; }
        LBAR();
        const bf16_t* chk0 = CHK + (size_t)(bh * 32) * 16384;
        constexpr int PF = 16;
        const size_t goff = 12288 + (size_t)(j * 16 + fr) * 64 + fq * 8, hoff = 8192 + (size_t)(q * 16 + fr) * 64 + j * 16 + 4 * fq;
        for (int c0 = 0; c0 < 32; c0 += PF) {
          bf16x8 G0[PF], G1[PF]; u32x2 HQ[PF];
          if (wave < 4) {
#pragma unroll
            for (int u = 0; u < PF; ++u) { const bf16_t* cn = chk0 + (size_t)(c0 + u) * 16384; G0[u] = *(const bf16x8*)(cn + goff); G1[u] = *(const bf16x8*)(cn + goff + 32); HQ[u] = *(const u32x2*)(cn + hoff); }
          }
#pragma unroll
          for (int u = 0; u < PF; ++u) { const int c = c0 + u;
            if (wave < 4) {
                const bf16x8 cg0 = G0[u], cg1 = G1[u]; const u32x2 chq = HQ[u];
                const LAS bf16_t* sh = Shi + (c & 1) * (16 * 72) + fr * 72 + fq * 8; const LAS bf16_t* sl = Slo + (c & 1) * (16 * 72) + fr * 72 + fq * 8;
                const bf16x8 h0 = *(const LAS bf16x8*)sh, h1 = *(const LAS bf16x8*)(sh + 32), l0 = *(const LAS bf16x8*)sl, l1 = *(const LAS bf16x8*)(sl + 32);
                bf16_t* sg = SALL + (size_t)(bh * 32 + c) * 4096 + (q * 16 + fr) * 64 + fq * 8;
                if (wave == 0) *(bf16x8*)sg = h0;
                if (wave == 1) *(bf16x8*)(sg + 32) = h1;
                f32x4 acc = {0.f, 0.f, 0.f, 0.f};
                acc = __builtin_amdgcn_mfma_f32_16x16x32_bf16(cg0, h0, acc, 0, 0, 0); acc = __builtin_amdgcn_mfma_f32_16x16x32_bf16(cg1, h1, acc, 0, 0, 0);
                acc = __builtin_amdgcn_mfma_f32_16x16x32_bf16(cg0, l0, acc, 0, 0, 0); acc = __builtin_amdgcn_mfma_f32_16x16x32_bf16(cg1, l1, acc, 0, 0, 0);
                float hv[4]; unpack4(chq, hv);
                const float s0 = acc[0] + hv[0], s1 = acc[1] + hv[1], s2 = acc[2] + hv[2], s3 = acc[3] + hv[3];
                const u32x2 ph = pack4(s0, s1, s2, s3); float hf[4]; unpack4(ph, hf);
                const u32x2 pl = pack4(s0 - hf[0], s1 - hf[1], s2 - hf[2], s3 - hf[3]);
                const int wo = ((c + 1) & 1) * (16 * 72) + fr * 72 + j * 16 + 4 * fq;
                *(LAS u32x2*)(Shi + wo) = ph; *(LAS u32x2*)(Slo + wo) = pl;
                if (c == 31) *(f32x4*)(a.out + O_WKVP + ((size_t)bh * 64 + q * 16 + fr) * 64 + j * 16 + 4 * fq) = (f32x4){s0, s1, s2, s3};
            }
            LBAR();
          }
        }
    }
}

__device__ void p3c_out(const Args& a) {
    const int tid = threadIdx.x, G = gridDim.x, blk = blockIdx.x, wave = tid >> 6, lane = tid & 63, fr = lane & 15, fq = lane >> 4;
    unsigned char* ws = a.ws;
    const bf16_t* SCN = (const bf16_t*)(ws + OFF_SCNS) - (size_t)MP * 8 * 384; const bf16_t* CHK = (const bf16_t*)(ws + OFF_CHK); const bf16_t* SALL = (const bf16_t*)(ws + OFF_SALL); bf16_t* YC = (bf16_t*)a.out;
    const bf16_t* Z = (const bf16_t*)(ws + OFF_Z); const float* RK = (const float*)(ws + OFF_RK); const float* mu = a.in[10];
    const float* r_k = a.in[17]; const float* ln_w = a.in[18]; const float* ln_b = a.in[19];
    for (int pi = blk; pi < 1024; pi += G) {
        const int unit = pi * 2 + (wave >> 2), it = wave & 3, bh = unit >> 5, c = unit & 31, b = bh >> 3, h = bh & 7;
        const int m = b * TSEQ + c * 64 + it * 16 + fr;
        const bf16_t* chk = CHK + (size_t)unit * 16384; const bf16_t* sall = SALL + (size_t)unit * 4096;
        bf16x8 xq[2];
#pragma unroll
        for (int ks = 0; ks < 2; ++ks) xq[ks] = *(const bf16x8*)(chk + (it * 16 + fr) * 64 + ks * 32 + fq * 8);
        const bool hasprev = (c * 64 + it * 16 + fr) >= 1;
        const bf16_t* zv = Z + (size_t)m * NZ + ZC_S + 1024 + h * 64 + 4 * fq; const bf16_t* zvp = hasprev ? zv - NZ : zv; const float fpv = hasprev ? 1.f : 0.f;
        const float rk = RK[(size_t)unit * 64 + it * 16 + fr];
        bf16_t* yp = YC + (size_t)m * D + 512 + h * 64 + 4 * fq;
        f32x4 acc[4]; u32x2 qy[4], qv[4], qvp[4], qg[4];
#pragma unroll
        for (int jt = 0; jt < 4; ++jt) { qy[jt] = *(const u32x2*)(chk + 4096 + (it * 16 + fr) * 64 + jt * 16 + 4 * fq);
            qv[jt] = *(const u32x2*)(zv + jt * 16); qvp[jt] = *(const u32x2*)(zvp + jt * 16); qg[jt] = *(const u32x2*)(yp + jt * 16); }
#pragma unroll
        for (int jt = 0; jt < 4; ++jt) { acc[jt] = (f32x4){0.f, 0.f, 0.f, 0.f};
#pragma unroll
            for (int ks = 0; ks < 2; ++ks) acc[jt] = __builtin_amdgcn_mfma_f32_16x16x32_bf16(*(const bf16x8*)(sall + (jt * 16 + fr) * 64 + ks * 32 + fq * 8), xq[ks], acc[jt], 0, 0, 0);
        }
        float o[4][4], vv[4][4]; float sm = 0.f;
#pragma unroll
        for (int jt = 0; jt < 4; ++jt) { float yl[4], vc[4], vp[4]; unpack4(qy[jt], yl); unpack4(qv[jt], vc); unpack4(qvp[jt], vp);
            const f32x4 mv = *(const f32x4*)(mu + 1024 + h * 64 + jt * 16 + 4 * fq);
#pragma unroll
            for (int e = 0; e < 4; ++e) { o[jt][e] = acc[jt][e] + yl[e]; sm += o[jt][e]; vv[jt][e] = vc[e] + (vp[e] * fpv - vc[e]) * mv[e]; } }
        sm += __shfl_xor(sm, 16); sm += __shfl_xor(sm, 32);
        const float mean = sm * (1.0f / 64.0f); float var = 0.f;
#pragma unroll
        for (int jt = 0; jt < 4; ++jt)
#pragma unroll
            for (int e = 0; e < 4; ++e) { o[jt][e] -= mean; var += o[jt][e] * o[jt][e]; }
        var += __shfl_xor(var, 16); var += __shfl_xor(var, 32);
        const float rstd = rsqrtf(var * (1.0f / 64.0f) + 64e-5f);
#pragma unroll
        for (int jt = 0; jt < 4; ++jt) { const int ch = h * 64 + jt * 16 + 4 * fq; const f32x4 lw = *(const f32x4*)(ln_w + ch), lb = *(const f32x4*)(ln_b + ch); float gt[4]; unpack4(qg[jt], gt);
            float y[4];
#pragma unroll
            for (int e = 0; e < 4; ++e) { y[e] = (o[jt][e] * rstd * lw[e] + lb[e] + rk * vv[jt][e]) * gt[e];
            }
            *(u32x2*)(yp + jt * 16) = pack4(y[0], y[1], y[2], y[3]); }
    }
    const bf16_t* OS = (const bf16_t*)(ws + OFF_OS);
    const int c = lane * 8, h = lane >> 3, cc = (lane & 7) * 8;
    for (int s = blk * 8 + wave; s < MS; s += G * 8) {
        const int m = MP + s;
        float o[8], r_[8], kp[8], v_[8], g[8];
        const bf16_t* sc = SCN + ((size_t)m * 8 + h) * 384 + cc;
        unpack8(*(const u32x4*)(OS + (size_t)s * 512 + c), o); unpack8(*(const u32x4*)(sc), r_); unpack8(*(const u32x4*)(sc + 128), kp); unpack8(*(const u32x4*)(sc + 192), v_);
        unpack8(*(const u32x4*)(YC + (size_t)m * D + 512 + c), g);
        float sm = 0.f, rk = 0.f;
#pragma unroll
        for (int i = 0; i < 8; ++i) { sm += o[i]; rk += r_[i] * kp[i] * r_k[h * 64 + cc + i]; }
        sm += __shfl_xor(sm, 1); sm += __shfl_xor(sm, 2); sm += __shfl_xor(sm, 4);
        rk += __shfl_xor(rk, 1); rk += __shfl_xor(rk, 2); rk += __shfl_xor(rk, 4);
        const float mean = sm * (1.0f / 64.0f);
        float var = 0.f;
#pragma unroll
        for (int i = 0; i < 8; ++i) { o[i] -= mean; var += o[i] * o[i]; }
        var += __shfl_xor(var, 1); var += __shfl_xor(var, 2); var += __shfl_xor(var, 4);
        const float rstd = rsqrtf(var * (1.0f / 64.0f) + 64e-5f);
        float y[8];
#pragma unroll
        for (int i = 0; i < 8; ++i) y[i] = (o[i] * rstd * ln_w[c + i] + ln_b[c + i] + rk * v_[i]) * g[i];
        *(u32x4*)(YC + (size_t)m * D + 512 + c) = pack8(y);
    }
}

__device__ void p5_out(const Args& a, LAS unsigned char* lds) {
    const int tid = threadIdx.x, G = gridDim.x, blk = blockIdx.x, wave = tid >> 6, lane = tid & 63, fr = lane & 15, fq = lane >> 4;
    unsigned char* ws = a.ws;
    const bf16_t* YC = (const bf16_t*)a.out; const bf16_t* WoutT = (const bf16_t*)(ws + OFF_WOUT); const bf16_t* PB = (const bf16_t*)(ws + OFF_PB); const bf16_t* WppT = (const bf16_t*)(ws + OFF_WPP);
    bf16_t* H1B = (bf16_t*)(ws + OFF_H1B); bf16_t* PP = (bf16_t*)(ws + OFF_PPB);
    { pg8::Gemm g{YC, WoutT, MP, D, D}; pg8::StaticOrder S; S.init(MP, D, G, blk); EpiH1 E{a.in[0], H1B}; pg8::gemm_phase<EpiH1, pg8::StaticOrder>(lds, g, S, E, nullptr); }
    { pg8::Gemm g{PB, WppT, MP, D, DP}; pg8::StaticOrder S; S.init(MP, D, G, blk); EpiF32 E{PP}; pg8::gemm_phase<EpiF32, pg8::StaticOrder>(lds, g, S, E, nullptr); }
    for (int t2 = blk; t2 < 256; t2 += G) {
        const int tile = t2 * 2 + (wave >> 2), ks = wave & 3, rt = tile & 7, ct = tile >> 3; const int row = MP + rt * 16 + fr; const size_t o = (size_t)row * D + ct * 16 + 4 * fq;
        f32x4 acc = mini_tile_k<8>(YC + (size_t)row * D + ks * 256, WoutT + (size_t)(ct * 16 + fr) * D + ks * 256, fq);
        f32x4 acp = mini_tile_k<2>(PB + (size_t)row * DP + ks * 64, WppT + (size_t)(ct * 16 + fr) * DP + ks * 64, fq);
        acc = splitk_reduce(lds, acc, wave, lane);
        acp = splitk_reduce(lds, acp, wave, lane);
        if (ks == 0) {
            const f32x4 v = *(const f32x4*)(a.in[1] + (size_t)(row - MP) * D + ct * 16 + 4 * fq) + acc;
            *(u32x2*)(H1B + o) = pack4(v[0], v[1], v[2], v[3]);
            *(u32x2*)(PP + o) = pack4(acp[0], acp[1], acp[2], acp[3]);
        }
    }
}

__device__ void p6_gate(const Args& a, LAS unsigned char* lds) {
    const int tid = threadIdx.x, G = gridDim.x, blk = blockIdx.x, wave = tid >> 6, lane = tid & 63, fr = lane & 15, fq = lane >> 4;
    unsigned char* ws = a.ws;
    const bf16_t* WpgT = (const bf16_t*)(ws + OFF_WPG); const bf16_t* H1B = (const bf16_t*)(ws + OFF_H1B); const bf16_t* PP = (const bf16_t*)(ws + OFF_PPB);
    { pg8::Gemm g{H1B, WpgT, MP, D, D}; pg8::StaticOrder S; S.init(MP, D, G, blk); EpiH2 E{H1B, PP, a.out}; pg8::gemm_phase<EpiH2, pg8::StaticOrder>(lds, g, S, E, nullptr); }
    for (int t2 = blk; t2 < 256; t2 += G) {
        const int tile = t2 * 2 + (wave >> 2), ks = wave & 3, rt = tile & 7, ct = tile >> 3; const int row = MP + rt * 16 + fr; const size_t o = (size_t)row * D + ct * 16 + 4 * fq;
        f32x4 g = mini_tile_k<8>(H1B + (size_t)row * D + ks * 256, WpgT + (size_t)(ct * 16 + fr) * D + ks * 256, fq);
        g = splitk_reduce(lds, g, wave, lane);
        if (ks == 0) {
            float h[4], p[4]; unpack4(*(const u32x2*)(H1B + o), h); unpack4(*(const u32x2*)(PP + o), p);
            f32x4 v; v[0] = h[0] + sigmoidf_(g[0]) * p[0]; v[1] = h[1] + sigmoidf_(g[1]) * p[1]; v[2] = h[2] + sigmoidf_(g[2]) * p[2]; v[3] = h[3] + sigmoidf_(g[3]) * p[3];
            *(f32x4*)(a.out + o) = v;
        }
    }
}

__device__ void p7_norm(const Args& a) {
    const int tid = threadIdx.x, G = gridDim.x, blk = blockIdx.x, wave = tid >> 6, lane = tid & 63;
    const float* fg = a.in[23];
    f32x4 gv[4];
#pragma unroll
    for (int i = 0; i < 4; ++i) gv[i] = *(const f32x4*)(fg + i * 256 + lane * 4);
    for (int row0 = (blk * 8 + wave) * 2; row0 < MT; row0 += G * 16) {
        f32x4 v[2][4];
#pragma unroll
        for (int r = 0; r < 2; ++r)
#pragma unroll
            for (int i = 0; i < 4; ++i) v[r][i] = *(const f32x4*)(a.out + (size_t)(row0 + r) * D + lane * 4 + i * 256);
#pragma unroll
        for (int r = 0; r < 2; ++r) { float ss = 0.f;
#pragma unroll
            for (int i = 0; i < 4; ++i) ss += v[r][i][0] * v[r][i][0] + v[r][i][1] * v[r][i][1] + v[r][i][2] * v[r][i][2] + v[r][i][3] * v[r][i][3];
#pragma unroll
            for (int o = 32; o >= 1; o >>= 1) ss += __shfl_xor(ss, o);
            const float rs = rsqrtf(ss * (1.0f / D) + 1e-6f);
#pragma unroll
            for (int i = 0; i < 4; ++i) *(f32x4*)(a.out + (size_t)(row0 + r) * D + lane * 4 + i * 256) = v[r][i] * rs * gv[i]; }
    }
}

#define XB_TMO      128
#define XB_XCNT(j)  (256  + 64 * (j))
#define XB_XSUB(j)  (1280 + 64 * (j))
#define XB_XGEN(j)  (2304 + 64 * (j))
#define XB_TOP      3328
#define XB_TOPGEN   3392
#define XCD_BAR_WORDS 3456
#define XB_SPIN_CAP (1u << 18)

__device__ __forceinline__ unsigned xb_ld(unsigned* p)              { return __hip_atomic_load(p, __ATOMIC_RELAXED, __HIP_MEMORY_SCOPE_AGENT); }
__device__ __forceinline__ unsigned xb_add(unsigned* p, unsigned v) { return __hip_atomic_fetch_add(p, v, __ATOMIC_RELAXED, __HIP_MEMORY_SCOPE_AGENT); }
__device__ __forceinline__ unsigned xb_xcc_id() { return (unsigned)__builtin_amdgcn_s_getreg((3 << 11) | 20) & 0xFu; }
#define XB_SPIN(cond, bar) do { unsigned _sp = 0; while (cond) { __builtin_amdgcn_s_sleep(1); \
    if ((++_sp & 255u) == 0u) { if (xb_ld(&(bar)[XB_TMO])) break; if (_sp > XB_SPIN_CAP) { atomicAdd(&(bar)[XB_TMO], 1u); break; } } } } while (0)

struct XcdBarrier {
    unsigned* bar; unsigned x;
    volatile LAS unsigned* st;
};

__device__ __forceinline__ XcdBarrier xcd_barrier_post(unsigned* bar, volatile LAS unsigned* st) {
    XcdBarrier b; b.bar = bar; b.x = xb_xcc_id(); b.st = st;
    if (threadIdx.x == 0) (void)xb_add(&bar[XB_XCNT(b.x)], 1u);
    return b;
}
__device__ __forceinline__ void xcd_barrier_complete(unsigned* bar, unsigned x, unsigned& nloc, unsigned& nx) {
    const unsigned G = gridDim.x * gridDim.y * gridDim.z;
    unsigned sum, cnt, mine, sp = 0u;
    for (;;) {
        sum = 0u; cnt = 0u; mine = 0u;
#pragma unroll
        for (unsigned j = 0; j < 16; ++j) { const unsigned c = xb_ld(&bar[XB_XCNT(j)]); sum += c; cnt += (c > 0u) ? 1u : 0u; mine = (j == x) ? c : mine; }
        if (sum == G) break;
        __builtin_amdgcn_s_sleep(1);
        if ((++sp & 255u) == 0u) { if (xb_ld(&bar[XB_TMO])) break; if (sp > XB_SPIN_CAP) { atomicAdd(&bar[XB_TMO], 1u); break; } }
    }
    nloc = mine > 0u ? mine : 1u; nx = cnt > 0u ? cnt : 1u;
}

__device__ __forceinline__ void xcd_barrier(const XcdBarrier& b) {
    asm volatile("s_waitcnt vmcnt(0)" ::: "memory");
    __syncthreads();
    if (threadIdx.x == 0) {
        unsigned* bar = b.bar;
        __builtin_amdgcn_s_waitcnt(0);
        unsigned nloc = b.st[0], nx = b.st[1];
        if (nloc == 0u) { xcd_barrier_complete(bar, b.x, nloc, nx); b.st[0] = nloc; b.st[1] = nx; }
        const unsigned old = xb_add(&bar[XB_XSUB(b.x)], 1u);
        const unsigned gen = old / nloc;
        if (old + 1u == (gen + 1u) * nloc) {
            __builtin_amdgcn_fence(__ATOMIC_RELEASE, "agent");
            asm volatile("s_waitcnt vmcnt(0)" ::: "memory");
            const unsigned og = xb_add(&bar[XB_TOP], 1u);
            const unsigned tg = og / nx;
            if (og + 1u == (tg + 1u) * nx) xb_add(&bar[XB_TOPGEN], 1u);
            else XB_SPIN(xb_ld(&bar[XB_TOPGEN]) == tg, bar);
            __builtin_amdgcn_fence(__ATOMIC_ACQUIRE, "agent");
            xb_add(&bar[XB_XGEN(b.x)], 1u);
            asm volatile("s_waitcnt vmcnt(0)" ::: "memory");
        } else {
            XB_SPIN(xb_ld(&bar[XB_XGEN(b.x)]) == gen, bar);
            __builtin_amdgcn_fence(__ATOMIC_ACQUIRE, "agent");
            asm volatile("s_waitcnt vmcnt(0)" ::: "memory");
        }
    }
    __syncthreads();
}

__global__ void __launch_bounds__(512, 2) fwd(Args a) {
    extern __shared__ __attribute__((aligned(16))) unsigned char lds_raw[];
    LAS unsigned char* lds = (LAS unsigned char*)lds_raw;
    cg::grid_group grid = cg::this_grid();
    volatile LAS unsigned* xst = (volatile LAS unsigned*)(lds + LDS_BYTES - 16);
    if (threadIdx.x == 0) { xst[0] = 0u; xst[1] = 0u; }
    __syncthreads();
    const XcdBarrier xb = xcd_barrier_post((unsigned*)(a.ws + OFF_BAR), xst);
    if (a.ph_hi > 1000) grid.sync();
#define IN(k) (a.ph_lo <= (k) && (k) < a.ph_hi)
#define GSYNC() xcd_barrier(xb)
#define SEAM(k) do { if (IN(k) && IN((k) + 1)) GSYNC(); } while (0)
#ifndef REP_PHASE
#define REP_PHASE -1
#endif
#define REPS(k) ((REP_PHASE == (k)) ? 2 : 1)
    if (IN(0)) for (int r = 0; r < REPS(0); ++r) { if (r) GSYNC(); p0_prep(a, lds); }
    SEAM(0);
    if (IN(1)) for (int r = 0; r < REPS(1); ++r) { if (r) GSYNC(); p1_gemm_in(a, lds); }
    SEAM(1);
    if (IN(2)) for (int r = 0; r < REPS(2); ++r) { if (r) GSYNC(); p2_all(a, lds); }
    if (IN(2) && !IN(3)) {}
    else if (!IN(2) && IN(3)) {}
    if (IN(3)) for (int r = 0; r < REPS(3); ++r) { if (r) GSYNC(); __syncthreads(); p3a_chunks(a, lds); }
    SEAM(3);
    if (IN(4)) for (int r = 0; r < REPS(4); ++r) { if (r) GSYNC(); p3b_seq(a, lds); if (r == 0) p3_sample_step(a, (int)blockIdx.x, (int)gridDim.x); }
    SEAM(4);
    if (IN(5)) p3c_out(a);
    SEAM(5);
    if (IN(6)) p5_out(a, lds);
    SEAM(6);
    if (IN(7)) p6_gate(a, lds);
    SEAM(7);
#if REP_PHASE == 99
    GSYNC(); GSYNC(); GSYNC(); GSYNC();
#endif
    if (IN(8)) p7_norm(a);
}

#ifndef N_LAUNCH_MODE
#define N_LAUNCH_MODE 1
#endif
extern "C" void kernel_launch(void* const* d_in, const int* in_sizes, int n_in, void* d_out, int out_size, void* d_ws, size_t ws_size, hipStream_t stream) {
    static int grid = 0;
    if (grid == 0) {
        if (n_in != 24 || ws_size < WS_END) { fprintf(stderr, "kernel_launch: unexpected n_in %d / ws_size %zu (need %zu)\n", n_in, ws_size, (size_t)WS_END); grid = -1; return; }
        int dev = 0, cus = 0, per_cu = 0;
        (void)hipGetDevice(&dev); (void)hipDeviceGetAttribute(&cus, hipDeviceAttributeMultiprocessorCount, dev);
        if (hipFuncSetAttribute((const void*)fwd, hipFuncAttributeMaxDynamicSharedMemorySize, LDS_BYTES) != hipSuccess) { fprintf(stderr, "kernel_launch: hipFuncSetAttribute failed\n"); grid = -1; return; }
        if (hipOccupancyMaxActiveBlocksPerMultiprocessor(&per_cu, (const void*)fwd, 512, LDS_BYTES) != hipSuccess || per_cu < 1) { fprintf(stderr, "kernel_launch: occupancy query gives %d\n", per_cu); per_cu = 1; }
        (void)hipGetLastError();
        grid = cus;
    }
    if (grid < 0) return;
    Args a{};
    for (int i = 0; i < 24; ++i) a.in[i] = (const float*)d_in[i];
    a.out = (float*)d_out; a.ws = (unsigned char*)d_ws;
    (void)hipMemsetAsync((unsigned char*)d_ws + OFF_BAR, 0, XCD_BAR_WORDS * 4, stream);
    if (N_LAUNCH_MODE == 1) {
        a.ph_lo = 0; a.ph_hi = 9;
        void* args[] = {&a};
        hipError_t e = hipLaunchCooperativeKernel((const void*)fwd, dim3(grid), dim3(512), args, LDS_BYTES, stream);
        if (e != hipSuccess) fprintf(stderr, "kernel_launch: cooperative launch failed: %s (grid %d)\n", hipGetErrorString(e), grid);
    } else {
        for (int ph = 0; ph < 9; ++ph) { a.ph_lo = ph; a.ph_hi = ph + 1; hipLaunchKernelGGL(fwd, dim3(grid), dim3(512), LDS_BYTES, stream, a); }
    }
}
```

```cpp
#include <hip/hip_runtime.h>
#include <hip/hip_cooperative_groups.h>
#include <cstdio>
namespace pg8 {
#define PG8_LAS __attribute__((address_space(3)))
typedef unsigned short bf16_t;
typedef short bf16x8 __attribute__((ext_vector_type(8)));
typedef float f32x4 __attribute__((ext_vector_type(4)));
typedef unsigned u32x4 __attribute__((ext_vector_type(4)));
constexpr int BM = 256, BK = 64, HALF = 128, HTB = HALF * BK * 2  , STAGE_BYTES = 8 * HTB, NXCD = 8, WGM = 8;

__host__ __device__ __forceinline__ int lds_byte(int r, int c) { const int st = (r >> 4) * 2 + (c >> 5), rr = r & 15, cc = c & 31, ob = rr * 64 + cc * 2; return st * 1024 + (ob ^ (((ob >> 9) & 1) << 5)); }
__host__ __device__ __forceinline__ void stage_rc(int b, int& R, int& C) { const int st = b / 1024, sb = b % 1024, swz = sb ^ (((sb >> 9) & 1) << 5); R = (st >> 1) * 16 + swz / 64; C = (st & 1) * 32 + (swz % 64) / 2; }
__host__ __device__ __forceinline__ int perm32(int rho) { const int n = rho >> 4, i = rho & 15; return 8 * (i >> 2) + 4 * n + (i & 3); }

struct Unit { int pm, pn; };
struct Gemm { const bf16_t* A; const bf16_t* Bt; int M, N, K; };

struct StaticOrder {
    int nM, nN, nwg, G, c;
    __host__ __device__ void init(int M, int N, int G_, int c_) { nM = M / BM; nN = N / BM; nwg = nM * nN; G = G_; c = c_; }
    __host__ __device__ bool next(int i, Unit& u) const {
        const long L = (long)i * G + c; if (L >= nwg) return false;
        int wgid = (int)L; { const int q = nwg / NXCD, r = nwg % NXCD, xcd = wgid % NXCD, off = wgid / NXCD; wgid = (xcd < r ? xcd * (q + 1) : r * (q + 1) + (xcd - r) * q) + off; }
        const int nig = WGM * nN, gid = wgid / nig, fm = gid * WGM, gsz = (nM - fm) < WGM ? (nM - fm) : WGM;
        u.pm = fm + ((wgid % nig) % gsz); u.pn = (wgid % nig) / gsz; return true;
    }
    __device__ __forceinline__ void a_ready(const Unit&) const {}
    __device__ __forceinline__ void done(const Unit&) const {}
};
typedef __bf16 bf16v2_t __attribute__((ext_vector_type(2)));
typedef float f32v2_t __attribute__((ext_vector_type(2)));
__device__ __forceinline__ unsigned cvt_pk_bf16(float lo, float hi) { const bf16v2_t r = __builtin_convertvector((f32v2_t){lo, hi}, bf16v2_t); return __builtin_bit_cast(unsigned, r); }
template <class Epi, class Sched, bool STAMP = false>
__device__ __forceinline__ void gemm_phase(PG8_LAS unsigned char* lds, const Gemm g, const Sched& S, const Epi& E, unsigned long long* stamps) {
    const int tid = threadIdx.x, wid = __builtin_amdgcn_readfirstlane(tid >> 6), lane = tid & 63, wr = wid >> 2, wc = wid & 3, fr = lane & 15, fq = lane >> 4;
    const int K = g.K, nt = K / BK;
    int ts_lo = 0, ts_hi = 0, nts = 0; const unsigned long long rt_entry = STAMP ? (unsigned long long)wall_clock64() : 0ull;
#define PG8_STAMP() do { if (STAMP && wid == 0 && nts < 64) { const unsigned long long _c = (unsigned long long)clock64(); \
        ts_lo = (lane == nts) ? (int)(unsigned)_c : ts_lo; ts_hi = (lane == nts) ? (int)(unsigned)(_c >> 32) : ts_hi; ++nts; } } while (0)
    PG8_STAMP();
    unsigned voffA[2], voffB[2];
#pragma unroll
    for (int i = 0; i < 2; ++i) { int R, C; stage_rc(tid * 16 + i * 8192, R, C); const int Rb = Epi::PERM ? ((R & ~31) + perm32(R & 31)) : R;
        voffA[i] = (unsigned)(R * K + C) * 2u; voffB[i] = (unsigned)(Rb * K + C) * 2u; }
    const size_t kstep = (size_t)(BK * 2);
    const size_t hstep = (size_t)HALF * K * 2;
    const size_t tstep = 2 * hstep;
    const unsigned ldsw = (unsigned)wid * 1024u;
    const int aoff = lds_byte(wr * 64 + fr, fq * 8), boff = lds_byte(wc * 32 + fr, fq * 8);
#define PG8_SA(b, h) (((b) * 2 + (h)) * HTB)
#define PG8_SB(b, h) ((4 + (b) * 2 + (h)) * HTB)
#define PG8_STAGE(bufoff, gbase, voff) do { _Pragma("unroll") for (int _i = 0; _i < 2; ++_i) \
        __builtin_amdgcn_global_load_lds((const unsigned*)((const char*)(gbase) + (voff)[_i]), (PG8_LAS unsigned*)(lds + (bufoff) + ldsw + _i * 8192), 16, 0, 0); } while (0)
#define PG8_LDA(dst, b, h) do { _Pragma("unroll") for (int m = 0; m < 4; ++m) _Pragma("unroll") for (int k = 0; k < 2; ++k) dst[m][k] = *(const PG8_LAS bf16x8*)(lds + PG8_SA(b, h) + aoff + m * 2048 + k * 1024); } while (0)
#define PG8_LDB(dst, b, h) do { _Pragma("unroll") for (int n = 0; n < 2; ++n) _Pragma("unroll") for (int k = 0; k < 2; ++k) dst[n][k] = *(const PG8_LAS bf16x8*)(lds + PG8_SB(b, h) + boff + n * 2048 + k * 1024); } while (0)
#define PG8_MMA(ai, bj, At, Bt) do { __builtin_amdgcn_s_setprio(1); _Pragma("unroll") for (int m = 0; m < 4; ++m) _Pragma("unroll") for (int n = 0; n < 2; ++n) _Pragma("unroll") for (int k = 0; k < 2; ++k) \
        acc[ai][bj][m][n] = __builtin_amdgcn_mfma_f32_16x16x32_bf16(Bt[n][k], At[m][k], acc[ai][bj][m][n], 0, 0, 0); __builtin_amdgcn_s_setprio(0); } while (0)
#define PG8_WAIT_V(n) asm volatile("s_waitcnt vmcnt(" #n ")" ::: "memory")
#define PG8_WAIT_L(n) asm volatile("s_waitcnt lgkmcnt(" #n ")" ::: "memory")
#define PG8_BAR __builtin_amdgcn_s_barrier()
#define PG8_SCHED __builtin_amdgcn_sched_barrier(0)
    Unit cur, nxt; int ui = 0;
    if (!S.next(0, cur)) return;
    f32x4 acc[2][2][4][2];
#pragma unroll
    for (int a = 0; a < 2; ++a)
#pragma unroll
        for (int b = 0; b < 2; ++b)
#pragma unroll
            for (int m = 0; m < 4; ++m)
#pragma unroll
                for (int n = 0; n < 2; ++n) acc[a][b][m][n] = (f32x4){0.f, 0.f, 0.f, 0.f};
    bf16x8 At[4][2], B0[2][2], B1[2][2];
    const char* cA = (const char*)g.A + (size_t)cur.pm * tstep; const char* cB = (const char*)g.Bt + (size_t)cur.pn * tstep;
    S.a_ready(cur);
    PG8_STAGE(PG8_SB(0, 0), cB, voffB); PG8_STAGE(PG8_SA(0, 0), cA, voffA); PG8_STAGE(PG8_SB(0, 1), cB + hstep, voffB); PG8_STAGE(PG8_SA(0, 1), cA + hstep, voffA);
    if (wr == 1) PG8_BAR;
    PG8_WAIT_V(4); PG8_BAR;
    PG8_STAGE(PG8_SB(1, 0), cB + kstep, voffB); PG8_STAGE(PG8_SA(1, 0), cA + kstep, voffA); PG8_STAGE(PG8_SB(1, 1), cB + hstep + kstep, voffB);
    PG8_WAIT_V(6); PG8_BAR;
    PG8_STAMP();
    for (;;) {
        const bool has_next = S.next(ui + 1, nxt);
        const char* nA = has_next ? (const char*)g.A + (size_t)nxt.pm * tstep : cA; const char* nB = has_next ? (const char*)g.Bt + (size_t)nxt.pn * tstep : cB;
        for (int t = 0; t < nt; t += 2) {
            const bool last = (t == nt - 2);
            const char* a1 = cA + (size_t)(t + 1) * kstep;
            const char* a2 = last ? nA : cA + (size_t)(t + 2) * kstep; const char* b2 = last ? nB : cB + (size_t)(t + 2) * kstep;
            const char* a3 = a2 + kstep; const char* b3 = b2 + kstep;
            if (last && has_next) S.a_ready(nxt);
            PG8_LDB(B0, 0, 0); PG8_SCHED; PG8_LDA(At, 0, 0); PG8_STAGE(PG8_SA(1, 1), a1 + hstep, voffA);
            PG8_WAIT_L(8); PG8_BAR; PG8_WAIT_L(0); PG8_MMA(0, 0, At, B0); PG8_BAR; PG8_SCHED;
            PG8_LDB(B1, 0, 1); PG8_STAGE(PG8_SB(0, 0), b2, voffB);
            PG8_BAR; PG8_WAIT_L(0); PG8_MMA(0, 1, At, B1); PG8_BAR;
            PG8_LDA(At, 0, 1); PG8_STAGE(PG8_SA(0, 0), a2, voffA);
            PG8_BAR; PG8_WAIT_L(0); PG8_MMA(1, 0, At, B0); PG8_BAR; PG8_SCHED;
            PG8_STAGE(PG8_SB(0, 1), b2 + hstep, voffB);
            PG8_WAIT_V(6); PG8_BAR; PG8_MMA(1, 1, At, B1); PG8_BAR;
            PG8_LDB(B0, 1, 0); PG8_SCHED; PG8_LDA(At, 1, 0); PG8_STAGE(PG8_SA(0, 1), a2 + hstep, voffA);
            PG8_WAIT_L(8); PG8_BAR; PG8_WAIT_L(0); PG8_MMA(0, 0, At, B0); PG8_BAR; PG8_SCHED;
            PG8_LDB(B1, 1, 1); PG8_STAGE(PG8_SB(1, 0), b3, voffB);
            PG8_BAR; PG8_WAIT_L(0); PG8_MMA(0, 1, At, B1); PG8_BAR;
            PG8_LDA(At, 1, 1); PG8_STAGE(PG8_SA(1, 0), a3, voffA);
            PG8_BAR; PG8_WAIT_L(0); PG8_MMA(1, 0, At, B0); PG8_BAR; PG8_SCHED;
            PG8_STAGE(PG8_SB(1, 1), b3 + hstep, voffB);
            PG8_WAIT_V(6); PG8_BAR; PG8_MMA(1, 1, At, B1); PG8_BAR;
        }
        PG8_STAMP();
        if constexpr (!Epi::AFTER_DRAIN) { E(acc, cur, wr, wc, fr, fq); S.done(cur); }
        PG8_STAMP();
        if (!has_next) break;
#pragma unroll
        for (int a = 0; a < 2; ++a)
#pragma unroll
            for (int b = 0; b < 2; ++b)
#pragma unroll
                for (int m = 0; m < 4; ++m)
#pragma unroll
                    for (int n = 0; n < 2; ++n) acc[a][b][m][n] = (f32x4){0.f, 0.f, 0.f, 0.f};
        cur = nxt; cA = nA; cB = nB; ++ui;
    }
    PG8_WAIT_V(0);
    if (wr == 0) PG8_BAR;
    PG8_BAR;
    if constexpr (Epi::AFTER_DRAIN) { E.fused(acc, cur, wr, wc, fr, fq, lds, wid, lane); S.done(cur); }
    PG8_STAMP();
    if (STAMP && wid == 0) { stamps[lane] = lane < nts ? (((unsigned long long)(unsigned)ts_hi << 32) | (unsigned)ts_lo) : 0ull;
        if (lane == 62) stamps[62] = rt_entry; if (lane == 63) stamps[63] = (unsigned long long)wall_clock64(); }
#undef PG8_STAMP
#undef PG8_SA
#undef PG8_SB
#undef PG8_STAGE
#undef PG8_LDA
#undef PG8_LDB
#undef PG8_MMA
#undef PG8_WAIT_V
#undef PG8_WAIT_L
#undef PG8_BAR
#undef PG8_SCHED
}
}

namespace cg = cooperative_groups;
using pg8::bf16_t; using pg8::bf16x8; using pg8::f32x4; using pg8::u32x4; using pg8::Unit; using pg8::cvt_pk_bf16;
typedef unsigned u32x2 __attribute__((ext_vector_type(2)));
#define LAS __attribute__((address_space(3)))
#define LBAR() do { asm volatile("s_waitcnt lgkmcnt(0)" ::: "memory"); __builtin_amdgcn_s_barrier(); asm volatile("" ::: "memory"); } while (0)

constexpr int D = 1024, TSEQ = 2048, NB = 8, MP = NB * TSEQ, MS = 128, MT = MP + MS;
constexpr int RW = 512, NH = 8, SW = 1664, NZ = 4224, NZP = 4352, DP = 256;
constexpr int ZC_S = 2048, ZC_GR = 3712;
constexpr int LDS_BYTES = 159744;

constexpr size_t OFF_WIN = 0;
constexpr size_t OFF_WOUT = OFF_WIN + (size_t)NZP * D * 2;
constexpr size_t OFF_WPG = OFF_WOUT + (size_t)D * D * 2;
constexpr size_t OFF_WPP = OFF_WPG + (size_t)D * D * 2;
constexpr size_t OFF_WUP = OFF_WPP + (size_t)D * DP * 2;
constexpr size_t OFF_AUP = OFF_WUP + (size_t)RW * 64 * 2;
constexpr size_t OFF_RS = OFF_AUP + (size_t)RW * 64 * 2;
constexpr size_t OFF_PB = OFF_RS + (size_t)16640 * 4;
constexpr size_t OFF_Z = OFF_PB + (size_t)MT * DP * 2;
constexpr size_t OFF_SCN = OFF_Z + (size_t)MT * NZ * 2;
constexpr size_t OFF_BAR = OFF_SCN + (size_t)MT * NH * 384 * 2;
constexpr size_t WS_END = OFF_BAR + 16384;
constexpr size_t OFF_H1B = OFF_Z;
constexpr size_t OFF_PPB = OFF_H1B + (size_t)MT * D * 2;
static_assert(OFF_PPB + (size_t)MT * D * 2 <= OFF_SCN, "overlay");
constexpr size_t OFF_CHK = OFF_SCN;
constexpr size_t OFF_SALL = OFF_CHK + (size_t)2048 * 16384 * 2;
constexpr size_t OFF_OS = OFF_SALL + (size_t)2048 * 4096 * 2;
constexpr size_t OFF_SCNS = OFF_OS + (size_t)128 * 512 * 2;
constexpr size_t OFF_RK = OFF_SCNS + (size_t)MS * NH * 384 * 2;
static_assert(OFF_RK + (size_t)2048 * 64 * 4 <= OFF_BAR, "overlay");
constexpr size_t O_Y = 0, O_CONVP = (size_t)MT * D, O_SHIFTP = O_CONVP + 8 * 2 * 512, O_WKVP = O_SHIFTP + 8 * SW,
                 O_CONVS = O_WKVP + 8 * 8 * 64 * 64, O_SHIFTS = O_CONVS + 128 * 2 * 512, O_WKVS = O_SHIFTS + 128 * SW;

struct Args { const float* in[24]; float* out; unsigned char* ws; int ph_lo, ph_hi; };

__device__ __forceinline__ float bf2f(unsigned short b) { return __uint_as_float(((unsigned)b) << 16); }
__device__ __forceinline__ float bflo(unsigned w) { return __uint_as_float(w << 16); }
__device__ __forceinline__ float bfhi(unsigned w) { return __uint_as_float(w & 0xffff0000u); }
__device__ __forceinline__ unsigned short f2bf(float f) { return (unsigned short)(cvt_pk_bf16(f, 0.f) & 0xffffu); }
__device__ __forceinline__ void unpack8(const u32x4 q, float (&f)[8]) {
    f[0] = bflo(q.x); f[1] = bfhi(q.x); f[2] = bflo(q.y); f[3] = bfhi(q.y); f[4] = bflo(q.z); f[5] = bfhi(q.z); f[6] = bflo(q.w); f[7] = bfhi(q.w); }
__device__ __forceinline__ void unpack4(const u32x2 q, float (&f)[4]) { f[0] = bflo(q.x); f[1] = bfhi(q.x); f[2] = bflo(q.y); f[3] = bfhi(q.y); }
__device__ __forceinline__ u32x4 pack8(const float (&f)[8]) { u32x4 q; q.x = cvt_pk_bf16(f[0], f[1]); q.y = cvt_pk_bf16(f[2], f[3]); q.z = cvt_pk_bf16(f[4], f[5]); q.w = cvt_pk_bf16(f[6], f[7]); return q; }
__device__ __forceinline__ u32x2 pack4(float a, float b, float c, float d) { u32x2 q; q.x = cvt_pk_bf16(a, b); q.y = cvt_pk_bf16(c, d); return q; }
__device__ __forceinline__ float sigmoidf_(float x) { return __builtin_amdgcn_rcpf(1.0f + __expf(-x)); }
__device__ __forceinline__ float siluf_(float x) { return x * __builtin_amdgcn_rcpf(1.0f + __expf(-x)); }
template <int CTRL> __device__ __forceinline__ float dppf(float x) { return __int_as_float(__builtin_amdgcn_update_dpp(0, __float_as_int(x), CTRL, 0xf, 0xf, false)); }
__device__ __forceinline__ float rowsum16(float x) { x += dppf<0x128>(x); x += dppf<0x124>(x); x += dppf<0x122>(x); x += dppf<0x121>(x); return x; }

__device__ __forceinline__ f32x4 mini_tile(const bf16_t* arow, const bf16_t* brow, int K, int fq) {
    f32x4 acc = {0.f, 0.f, 0.f, 0.f};
    const bf16_t* ap = arow + fq * 8; const bf16_t* bp = brow + fq * 8;
    for (int k0 = 0; k0 < K; k0 += 256) {
        bf16x8 av[8], bv[8];
#pragma unroll
        for (int j = 0; j < 8; ++j) { av[j] = *(const bf16x8*)(ap + k0 + j * 32); bv[j] = *(const bf16x8*)(bp + k0 + j * 32); }
#pragma unroll
        for (int j = 0; j < 8; ++j) acc = __builtin_amdgcn_mfma_f32_16x16x32_bf16(bv[j], av[j], acc, 0, 0, 0);
    }
    return acc;
}

template <int NSTEP> __device__ __forceinline__ f32x4 mini_tile_k(const bf16_t* arow, const bf16_t* brow, int fq) {
    f32x4 acc = {0.f, 0.f, 0.f, 0.f};
    bf16x8 av[NSTEP], bv[NSTEP];
#pragma unroll
    for (int j = 0; j < NSTEP; ++j) { av[j] = *(const bf16x8*)(arow + fq * 8 + j * 32); bv[j] = *(const bf16x8*)(brow + fq * 8 + j * 32); }
#pragma unroll
    for (int j = 0; j < NSTEP; ++j) acc = __builtin_amdgcn_mfma_f32_16x16x32_bf16(bv[j], av[j], acc, 0, 0, 0);
    return acc;
}
__device__ __forceinline__ f32x4 splitk_reduce(LAS unsigned char* lds, f32x4 acc, int wave, int lane) {
    LAS f32x4* red = (LAS f32x4*)lds;
    __syncthreads();
    red[wave * 64 + lane] = acc;
    __syncthreads();
    if ((wave & 3) == 0) acc = (acc + red[(wave + 1) * 64 + lane]) + (red[(wave + 2) * 64 + lane] + red[(wave + 3) * 64 + lane]);
    return acc;
}

struct EpiZ {
    static constexpr bool PERM = true, AFTER_DRAIN = false;
    bf16_t* Z; const float* rs;
    __device__ __forceinline__ void operator()(const f32x4 (&acc)[2][2][4][2], const Unit& u, int wr, int wc, int fr, int fq) const {
        const int row0 = u.pm * 256 + wr * 64 + fr, col0 = u.pn * 256 + wc * 32 + 8 * fq;
        float sc[2][4];
#pragma unroll
        for (int ai = 0; ai < 2; ++ai)
#pragma unroll
            for (int m = 0; m < 4; ++m) sc[ai][m] = rs[row0 + ai * 128 + m * 16];
#pragma unroll
        for (int ai = 0; ai < 2; ++ai)
#pragma unroll
            for (int m = 0; m < 4; ++m) { const int row = row0 + ai * 128 + m * 16; const float s = sc[ai][m]; bf16_t* rp = Z + (size_t)row * NZ + col0;
#pragma unroll
                for (int bj = 0; bj < 2; ++bj) { if (col0 + bj * 128 < NZ && row < MT) { const f32x4 v0 = acc[ai][bj][m][0] * s, v1 = acc[ai][bj][m][1] * s; u32x4 w;
                    w.x = cvt_pk_bf16(v0[0], v0[1]); w.y = cvt_pk_bf16(v0[2], v0[3]); w.z = cvt_pk_bf16(v1[0], v1[1]); w.w = cvt_pk_bf16(v1[2], v1[3]); *(u32x4*)(rp + bj * 128) = w; } } }
    }
};
struct EpiH1 {
    static constexpr bool PERM = true, AFTER_DRAIN = false;
    const float* x; bf16_t* H1B;
    __device__ __forceinline__ void operator()(const f32x4 (&acc)[2][2][4][2], const Unit& u, int wr, int wc, int fr, int fq) const {
        const int row0 = u.pm * 256 + wr * 64 + fr, col0 = u.pn * 256 + wc * 32 + 8 * fq;
#pragma unroll
        for (int ai = 0; ai < 2; ++ai)
#pragma unroll
            for (int mp = 0; mp < 2; ++mp) {
                f32x4 xv[2][2][2];
#pragma unroll
                for (int mm = 0; mm < 2; ++mm)
#pragma unroll
                    for (int bj = 0; bj < 2; ++bj) { const size_t o = (size_t)(row0 + ai * 128 + (mp * 2 + mm) * 16) * D + col0 + bj * 128; xv[mm][bj][0] = *(const f32x4*)(x + o); xv[mm][bj][1] = *(const f32x4*)(x + o + 4); }
#pragma unroll
                for (int mm = 0; mm < 2; ++mm)
#pragma unroll
                    for (int bj = 0; bj < 2; ++bj) { const int m = mp * 2 + mm; const size_t o = (size_t)(row0 + ai * 128 + m * 16) * D + col0 + bj * 128;
                        const f32x4 v0 = xv[mm][bj][0] + acc[ai][bj][m][0], v1 = xv[mm][bj][1] + acc[ai][bj][m][1]; u32x4 w;
                        w.x = cvt_pk_bf16(v0[0], v0[1]); w.y = cvt_pk_bf16(v0[2], v0[3]); w.z = cvt_pk_bf16(v1[0], v1[1]); w.w = cvt_pk_bf16(v1[2], v1[3]); *(u32x4*)(H1B + o) = w; }
                asm volatile("" ::: "memory"); }
    }
};
struct EpiF32 {
    static constexpr bool PERM = true, AFTER_DRAIN = false;
    bf16_t* C;
    __device__ __forceinline__ void operator()(const f32x4 (&acc)[2][2][4][2], const Unit& u, int wr, int wc, int fr, int fq) const {
        const int row0 = u.pm * 256 + wr * 64 + fr, col0 = u.pn * 256 + wc * 32 + 8 * fq;
#pragma unroll
        for (int ai = 0; ai < 2; ++ai)
#pragma unroll
            for (int m = 0; m < 4; ++m) { const size_t off = (size_t)(row0 + ai * 128 + m * 16) * D + col0;
#pragma unroll
                for (int bj = 0; bj < 2; ++bj) { const f32x4 v0 = acc[ai][bj][m][0], v1 = acc[ai][bj][m][1]; u32x4 w;
                    w.x = cvt_pk_bf16(v0[0], v0[1]); w.y = cvt_pk_bf16(v0[2], v0[3]); w.z = cvt_pk_bf16(v1[0], v1[1]); w.w = cvt_pk_bf16(v1[2], v1[3]); *(u32x4*)(C + off + bj * 128) = w; } }
    }
};
struct EpiH2 {
    static constexpr bool PERM = true, AFTER_DRAIN = false;
    const bf16_t* H1; const bf16_t* PP; float* out;
    __device__ __forceinline__ void operator()(const f32x4 (&acc)[2][2][4][2], const Unit& u, int wr, int wc, int fr, int fq) const {
        const int row0 = u.pm * 256 + wr * 64 + fr, col0 = u.pn * 256 + wc * 32 + 8 * fq;
#pragma unroll
        for (int ai = 0; ai < 2; ++ai)
#pragma unroll
            for (int mp = 0; mp < 2; ++mp) {
                u32x4 qh[2][2], qp[2][2];
#pragma unroll
                for (int mm = 0; mm < 2; ++mm)
#pragma unroll
                    for (int bj = 0; bj < 2; ++bj) { const size_t o = (size_t)(row0 + ai * 128 + (mp * 2 + mm) * 16) * D + col0 + bj * 128; qh[mm][bj] = *(const u32x4*)(H1 + o); qp[mm][bj] = *(const u32x4*)(PP + o); }
#pragma unroll
                for (int mm = 0; mm < 2; ++mm)
#pragma unroll
                    for (int bj = 0; bj < 2; ++bj) { const int m = mp * 2 + mm; const size_t o = (size_t)(row0 + ai * 128 + m * 16) * D + col0 + bj * 128; float h[8], p[8]; unpack8(qh[mm][bj], h); unpack8(qp[mm][bj], p);
                        const f32x4 g0 = acc[ai][bj][m][0], g1 = acc[ai][bj][m][1]; f32x4 v0, v1;
#pragma unroll
                        for (int e = 0; e < 4; ++e) { v0[e] = h[e] + sigmoidf_(g0[e]) * p[e]; v1[e] = h[4 + e] + sigmoidf_(g1[e]) * p[4 + e]; }
                        *(f32x4*)(out + o) = v0; *(f32x4*)(out + o + 4) = v1; }
                asm volatile("" ::: "memory"); }
    }
};

struct P0Job { const float* src; bf16_t* dst; const float* gsc; int K, N, k0, n0; };
__device__ __forceinline__ P0Job p0_decode(const Args& a, int job) {
    constexpr int NJ_IN = 16 * 68, NJ_SQ = 256, NJ_PP = 64, NJ_LO = 8;
    unsigned char* ws = a.ws; P0Job J; J.gsc = nullptr; int kt, nt; int j = job;
    if (j < NJ_IN) { J.src = a.in[8]; J.dst = (bf16_t*)(ws + OFF_WIN); J.gsc = a.in[7]; J.K = 1024; J.N = NZ; kt = j & 15; nt = j >> 4; }
    else if ((j -= NJ_IN) < NJ_SQ) { J.src = a.in[20]; J.dst = (bf16_t*)(ws + OFF_WOUT); J.K = 1024; J.N = 1024; kt = j & 15; nt = j >> 4; }
    else if ((j -= NJ_SQ) < NJ_SQ) { J.src = a.in[21]; J.dst = (bf16_t*)(ws + OFF_WPG); J.K = 1024; J.N = 1024; kt = j & 15; nt = j >> 4; }
    else if ((j -= NJ_SQ) < NJ_PP) { J.src = a.in[22]; J.dst = (bf16_t*)(ws + OFF_WPP); J.K = 256; J.N = 1024; kt = j & 3; nt = j >> 2; }
    else if ((j -= NJ_PP) < NJ_LO) { J.src = a.in[12]; J.dst = (bf16_t*)(ws + OFF_WUP); J.K = 64; J.N = 512; kt = 0; nt = j; }
    else { j -= NJ_LO; J.src = a.in[14]; J.dst = (bf16_t*)(ws + OFF_AUP); J.K = 64; J.N = 512; kt = 0; nt = j; }
    J.k0 = kt * 64; J.n0 = nt * 64; return J;
}
__device__ void p0_prep(const Args& a, LAS unsigned char* lds) {
    const int tid = threadIdx.x, G = gridDim.x, blk = blockIdx.x, wave = tid >> 6, lane = tid & 63;
    LAS float* tile = (LAS float*)lds;
    unsigned char* ws = a.ws;
    constexpr int NJOBS = 16 * 68 + 2 * 256 + 64 + 2 * 8, MAXJ = 7;
    const int li = tid >> 4, lj = (tid & 15) * 4;
    for (int base = blk; base < NJOBS; base += G * MAXJ) {
        f32x4 v[MAXJ][2];
#pragma unroll
        for (int sl = 0; sl < MAXJ; ++sl) { const int job = base + sl * G;
            if (job < NJOBS) { const P0Job J = p0_decode(a, job);
#pragma unroll
                for (int q = 0; q < 2; ++q) { const int i = li + 32 * q; f32x4 x = {0.f, 0.f, 0.f, 0.f};
                    if (J.n0 + lj < J.N) { x = *(const f32x4*)(J.src + (size_t)(J.k0 + i) * J.N + J.n0 + lj); if (J.gsc) x = x * J.gsc[J.k0 + i]; }
                    v[sl][q] = x; } } }
#pragma unroll
        for (int sl = 0; sl < MAXJ; ++sl) { const int job = base + sl * G;
            if (job < NJOBS) { const P0Job J = p0_decode(a, job);
#pragma unroll
                for (int q = 0; q < 2; ++q) { const int i = li + 32 * q;
#pragma unroll
                    for (int e = 0; e < 4; ++e) tile[i * 65 + lj + e] = v[sl][q][e]; }
                LBAR();
#pragma unroll
                for (int it = 0; it < 4; ++it) { const int item = it * 512 + tid, jj = item >> 5, i2 = item & 31;
                    *(unsigned*)(J.dst + (size_t)(J.n0 + jj) * J.K + J.k0 + 2 * i2) = cvt_pk_bf16(tile[(2 * i2) * 65 + jj], tile[(2 * i2 + 1) * 65 + jj]); }
                LBAR(); } }
    }
    bf16_t* XB = (bf16_t*)a.out; float* RS = (float*)(ws + OFF_RS);
    for (int row0 = (blk * 8 + wave) * 2; row0 < MT; row0 += G * 16) {
        f32x4 v[2][4];
#pragma unroll
        for (int r = 0; r < 2; ++r) { const int row = row0 + r; const float* src = row < MP ? a.in[0] + (size_t)row * D : a.in[1] + (size_t)(row - MP) * D;
#pragma unroll
            for (int i = 0; i < 4; ++i) v[r][i] = *(const f32x4*)(src + i * 256 + lane * 4); }
#pragma unroll
        for (int r = 0; r < 2; ++r) { const int row = row0 + r; float ss = 0.f;
#pragma unroll
            for (int i = 0; i < 4; ++i) { const f32x4 x = v[r][i]; ss += x[0] * x[0] + x[1] * x[1] + x[2] * x[2] + x[3] * x[3];
                *(u32x2*)(XB + (size_t)row * D + i * 256 + lane * 4) = pack4(x[0], x[1], x[2], x[3]); }
#pragma unroll
            for (int o = 32; o >= 1; o >>= 1) ss += __shfl_xor(ss, o);
            if (lane == 0) RS[row] = rsqrtf(ss * (1.0f / D) + 1e-6f); }
    }
    bf16_t* PB = (bf16_t*)(ws + OFF_PB);
    constexpr size_t NP4 = (size_t)MT * DP / 4;
    for (size_t i0 = (size_t)blk * 512 + tid; i0 < NP4; i0 += (size_t)G * 512 * 4) {
        f32x4 v[4];
#pragma unroll
        for (int u = 0; u < 4; ++u) { const size_t i = i0 + (size_t)u * G * 512; const size_t e = i * 4;
            if (i < NP4) v[u] = e < (size_t)MP * DP ? *(const f32x4*)(a.in[2] + e) : *(const f32x4*)(a.in[3] + (e - (size_t)MP * DP)); }
#pragma unroll
        for (int u = 0; u < 4; ++u) { const size_t i = i0 + (size_t)u * G * 512; if (i < NP4) *(u32x2*)(PB + i * 4) = pack4(v[u][0], v[u][1], v[u][2], v[u][3]); }
    }
}

__device__ void p1_gemm_in(const Args& a, LAS unsigned char* lds) {
    const int tid = threadIdx.x, G = gridDim.x, blk = blockIdx.x, wave = tid >> 6, lane = tid & 63, fr = lane & 15, fq = lane >> 4;
    unsigned char* ws = a.ws;
    const bf16_t* XB = (const bf16_t*)a.out; const bf16_t* WinT = (const bf16_t*)(ws + OFF_WIN); const float* RS = (const float*)(ws + OFF_RS); bf16_t* Z = (bf16_t*)(ws + OFF_Z);
    {
        pg8::Gemm g{XB, WinT, MP + 256, NZP, D}; pg8::StaticOrder S; S.init(MP + 256, NZP, G, blk); EpiZ E{Z, RS};
        pg8::gemm_phase<EpiZ, pg8::StaticOrder>(lds, g, S, E, nullptr);
    }
}

template <bool smp> __device__ void p2_tile(const Args& a, LAS unsigned char* lds, int tile) {
    const int tid = threadIdx.x, wave = tid >> 6, lane = tid & 63, fr = lane & 15, fq = lane >> 4;
    unsigned char* ws = a.ws;
    const int ntok = smp ? 8 : 64;
    const int m0 = smp ? MP + (tile - 256) * 8 : tile * 64;
    const int t0 = smp ? 0 : (tile & 31) * 64;
    const int bidx = tile >> 5;
    const bf16_t* __restrict__ Z = (const bf16_t*)(ws + OFF_Z); bf16_t* __restrict__ YC = (bf16_t*)a.out; bf16_t* __restrict__ SCN = (bf16_t*)(ws + OFF_SCNS) - (size_t)MP * 8 * 384;
    const float* state_conv = a.in[4]; const float* state_shift = a.in[5]; const float* conv_w = a.in[9]; const float* mu = a.in[10];
    {
        const int c0 = (tid & 63) * 8;
        float cw0[8], cw1[8], cw2[8];
#pragma unroll
        for (int i = 0; i < 8; ++i) { cw0[i] = conv_w[c0 + i]; cw1[i] = conv_w[512 + c0 + i]; cw2[i] = conv_w[1024 + c0 + i]; }
#pragma unroll 2
        for (int tok = tid >> 6; tok < ntok; tok += 8) {
            const int m = m0 + tok, t = t0 + tok;
            const bf16_t* zr = Z + (size_t)m * NZ;
            float fB[8], fC[8], fH[8], fG[8], u0[8], u1[8], u2[8];
            const u32x4 qB = *(const u32x4*)(zr + c0), qC = *(const u32x4*)(zr + 512 + c0), qH = *(const u32x4*)(zr + 1024 + c0), qG = *(const u32x4*)(zr + 1536 + c0);
            if (smp) {
                const float* sc = state_conv + (size_t)(m - MP) * 1024 + c0;
                const f32x4 x0 = *(const f32x4*)(sc), x1 = *(const f32x4*)(sc + 4), y0 = *(const f32x4*)(sc + 512), y1 = *(const f32x4*)(sc + 516);
#pragma unroll
                for (int i = 0; i < 4; ++i) { u2[i] = x0[i]; u2[4 + i] = x1[i]; u1[i] = y0[i]; u1[4 + i] = y1[i]; }
            } else {
                const bf16_t* z1 = t >= 1 ? zr - NZ : zr; const bf16_t* z2 = t >= 2 ? zr - 2 * NZ : zr;
                const u32x4 qC1 = *(const u32x4*)(z1 + 512 + c0), qH1 = *(const u32x4*)(z1 + 1024 + c0), qC2 = *(const u32x4*)(z2 + 512 + c0), qH2 = *(const u32x4*)(z2 + 1024 + c0);
                float c1[8], h1[8], c2[8], h2[8]; unpack8(qC1, c1); unpack8(qH1, h1); unpack8(qC2, c2); unpack8(qH2, h2);
                const float f1 = t >= 1 ? 1.f : 0.f, f2 = t >= 2 ? 1.f : 0.f;
#pragma unroll
                for (int i = 0; i < 8; ++i) { u1[i] = c1[i] * h1[i] * f1; u2[i] = c2[i] * h2[i] * f2; }
            }
            unpack8(qB, fB); unpack8(qC, fC); unpack8(qH, fH); unpack8(qG, fG);
            float y[8];
#pragma unroll
            for (int i = 0; i < 8; ++i) { u0[i] = fC[i] * fH[i]; const float cv = cw0[i] * u2[i] + cw1[i] * u1[i] + cw2[i] * u0[i]; y[i] = fB[i] * cv * siluf_(fG[i]); }
            *(u32x4*)(YC + (size_t)m * D + c0) = pack8(y);
            { float gr[8]; unpack8(*(const u32x4*)(zr + ZC_GR + c0), gr);
#pragma unroll
              for (int i = 0; i < 8; ++i) gr[i] = siluf_(gr[i]);
              *(u32x4*)(YC + (size_t)m * D + 512 + c0) = pack8(gr); }
            float* co = nullptr;
            if (smp) co = a.out + O_CONVS + (size_t)(m - MP) * 1024 + c0; else if (t == TSEQ - 1) co = a.out + O_CONVP + (size_t)bidx * 1024 + c0;
            if (co) {
                *(f32x4*)(co) = (f32x4){u1[0], u1[1], u1[2], u1[3]}; *(f32x4*)(co + 4) = (f32x4){u1[4], u1[5], u1[6], u1[7]};
                *(f32x4*)(co + 512) = (f32x4){u0[0], u0[1], u0[2], u0[3]}; *(f32x4*)(co + 516) = (f32x4){u0[4], u0[5], u0[6], u0[7]}; }
        }
    }
    LAS bf16_t* Awd = (LAS bf16_t*)lds; LAS bf16_t* Aad = Awd + 64 * 72;
    if (smp) {
        const int j0 = (tid & 15) * 8;
        f32x4 m0v = *(const f32x4*)(mu + 1536 + j0), m1v = *(const f32x4*)(mu + 1536 + j0 + 4);
#pragma unroll 2
        for (int tok = tid >> 4; tok < ntok; tok += 32) {
            const int m = m0 + tok;
            const bf16_t* zr = Z + (size_t)m * NZ + ZC_S + 1536 + j0;
            float cur[8], prev[8], zm[8];
            unpack8(*(const u32x4*)zr, cur);
            if (smp) { const float* sp = state_shift + (size_t)(m - MP) * SW + 1536 + j0; const f32x4 x0 = *(const f32x4*)sp, x1 = *(const f32x4*)(sp + 4);
#pragma unroll
                for (int i = 0; i < 4; ++i) { prev[i] = x0[i]; prev[4 + i] = x1[i]; } }
            else { const bool hp = (t0 + tok) >= 1; unpack8(*(const u32x4*)(hp ? zr - NZ : zr), prev);
                if (!hp) {
#pragma unroll
                    for (int i = 0; i < 8; ++i) prev[i] = 0.f; } }
#pragma unroll
            for (int i = 0; i < 8; ++i) { const float mm = i < 4 ? m0v[i] : m1v[i - 4]; zm[i] = cur[i] + (prev[i] - cur[i]) * mm; }
            if (j0 < 64) {
#pragma unroll
                for (int i = 0; i < 8; ++i) { const float e2 = __expf(2.0f * zm[i]); zm[i] = 1.0f - 2.0f * __builtin_amdgcn_rcpf(e2 + 1.0f); }
                *(LAS u32x4*)(Awd + tok * 72 + j0) = pack8(zm);
            } else *(LAS u32x4*)(Aad + tok * 72 + (j0 - 64)) = pack8(zm);
        }
    }
    __syncthreads();
    if (smp) {
        const int h = wave;
        const bf16_t* WupT = (const bf16_t*)(ws + OFF_WUP); const bf16_t* AupT = (const bf16_t*)(ws + OFF_AUP);
        const float* __restrict__ w0 = a.in[11]; const float* __restrict__ a0p = a.in[13]; const float* __restrict__ k_k = a.in[15]; const float* __restrict__ k_a = a.in[16];
        const int nmt = (ntok + 15) >> 4;
#pragma unroll 1
        for (int mt = 0; mt < nmt; ++mt) {
            u32x2 zc[4][3], zq[4][3];
            {   const int tok_ = (mt * 16 + fr) < ntok ? (mt * 16 + fr) : 0; const bf16_t* zr_ = Z + (size_t)(m0 + tok_) * NZ + ZC_S; const bf16_t* zp_ = ((!smp) && (t0 + tok_ >= 1)) ? zr_ - NZ : zr_;
#pragma unroll
                for (int nt = 0; nt < 4; ++nt) { const int c = h * 64 + nt * 16 + 4 * fq;
                    zc[nt][0] = *(const u32x2*)(zr_ + c); zc[nt][1] = *(const u32x2*)(zr_ + 512 + c); zc[nt][2] = *(const u32x2*)(zr_ + 1024 + c);
                    if (!smp) { zq[nt][0] = *(const u32x2*)(zp_ + c); zq[nt][1] = *(const u32x2*)(zp_ + 512 + c); zq[nt][2] = *(const u32x2*)(zp_ + 1024 + c); } } }
            bf16x8 aw[2], aa[2];
#pragma unroll
            for (int ks = 0; ks < 2; ++ks) { aw[ks] = *(const LAS bf16x8*)(Awd + (mt * 16 + fr) * 72 + ks * 32 + fq * 8); aa[ks] = *(const LAS bf16x8*)(Aad + (mt * 16 + fr) * 72 + ks * 32 + fq * 8); }
            f32x4 accw[4], acca[4];
#pragma unroll
            for (int nt = 0; nt < 4; ++nt) { accw[nt] = (f32x4){0.f, 0.f, 0.f, 0.f}; acca[nt] = (f32x4){0.f, 0.f, 0.f, 0.f};
#pragma unroll
                for (int ks = 0; ks < 2; ++ks) { const size_t bo = (size_t)(h * 64 + nt * 16 + fr) * 64 + ks * 32 + fq * 8;
                    accw[nt] = __builtin_amdgcn_mfma_f32_16x16x32_bf16(*(const bf16x8*)(WupT + bo), aw[ks], accw[nt], 0, 0, 0);
                    acca[nt] = __builtin_amdgcn_mfma_f32_16x16x32_bf16(*(const bf16x8*)(AupT + bo), aa[ks], acca[nt], 0, 0, 0); } }
            const bool valid = (mt * 16 + fr) < ntok;
            const int tok = valid ? (mt * 16 + fr) : 0, m = m0 + tok, t = t0 + tok;
            const bf16_t* zr = Z + (size_t)m * NZ + ZC_S;
            const bool hasprev = (!smp) && (t >= 1);
            const bf16_t* zp = hasprev ? zr - NZ : zr;
            const float fp = hasprev ? 1.f : 0.f;
            bf16_t* so = SCN + ((size_t)m * 8 + h) * 384 + 4 * fq;
            float kk[4][4], av[4][4]; float ss = 0.f;
#pragma unroll
            for (int nt = 0; nt < 4; ++nt) {
                const int c = h * 64 + nt * 16 + 4 * fq;
                float cr[4], ck[4], cv[4], pr[4], pk[4], pv[4];
                unpack4(zc[nt][0], cr); unpack4(zc[nt][1], ck); unpack4(zc[nt][2], cv);
                if (smp) { const float* sp = state_shift + (size_t)(m - MP) * SW + c; const f32x4 x0 = *(const f32x4*)sp, x1 = *(const f32x4*)(sp + 512), x2 = *(const f32x4*)(sp + 1024);
#pragma unroll
                    for (int i = 0; i < 4; ++i) { pr[i] = x0[i]; pk[i] = x1[i]; pv[i] = x2[i]; } }
                else { unpack4(zq[nt][0], pr); unpack4(zq[nt][1], pk); unpack4(zq[nt][2], pv);
#pragma unroll
                    for (int i = 0; i < 4; ++i) { pr[i] *= fp; pk[i] *= fp; pv[i] *= fp; } }
                const f32x4 mr = *(const f32x4*)(mu + c), mk = *(const f32x4*)(mu + 512 + c), mv = *(const f32x4*)(mu + 1024 + c);
                const f32x4 w0v = *(const f32x4*)(w0 + c), a0v = *(const f32x4*)(a0p + c), kkv = *(const f32x4*)(k_k + c), kav = *(const f32x4*)(k_a + c);
                float r_[4], e_[4], kp[4], v_[4];
#pragma unroll
                for (int i = 0; i < 4; ++i) {
                    r_[i] = cr[i] + (pr[i] - cr[i]) * mr[i]; const float k = ck[i] + (pk[i] - ck[i]) * mk[i]; v_[i] = cv[i] + (pv[i] - cv[i]) * mv[i];
                    e_[i] = 0.60653065971f * sigmoidf_(w0v[i] + accw[nt][i]);
                    const float al = sigmoidf_(a0v[i] + acca[nt][i]); av[nt][i] = al;
                    const float kq = k * kkv[i]; kk[nt][i] = kq; ss += kq * kq;
                    kp[i] = k * (1.0f + (al - 1.0f) * kav[i]);
                }
                if (valid) {
                *(u32x2*)(so + 0 * 64 + nt * 16) = pack4(r_[0], r_[1], r_[2], r_[3]);
                *(u32x2*)(so + 1 * 64 + nt * 16) = pack4(e_[0], e_[1], e_[2], e_[3]);
                *(u32x2*)(so + 2 * 64 + nt * 16) = pack4(kp[0], kp[1], kp[2], kp[3]);
                *(u32x2*)(so + 3 * 64 + nt * 16) = pack4(v_[0], v_[1], v_[2], v_[3]); }
            }
            ss += __shfl_xor(ss, 16); ss += __shfl_xor(ss, 32);
            const float inv = 1.0f / fmaxf(sqrtf(ss), 1e-12f);
#pragma unroll
            for (int nt = 0; nt < 4; ++nt) {
                float q[4], b[4];
#pragma unroll
                for (int i = 0; i < 4; ++i) { q[i] = kk[nt][i] * inv; b[i] = q[i] * av[nt][i]; }
                if (valid) {
                *(u32x2*)(so + 4 * 64 + nt * 16) = pack4(q[0], q[1], q[2], q[3]);
                *(u32x2*)(so + 5 * 64 + nt * 16) = pack4(b[0], b[1], b[2], b[3]); }
            }
        }
    }
    if (!smp && (tile & 31) == 31) { for (int j = tid; j < SW; j += 512) a.out[O_SHIFTP + (size_t)bidx * SW + j] = bf2f(Z[(size_t)(m0 + 63) * NZ + ZC_S + j]); }
    __syncthreads();
}
__device__ void p2_all(const Args& a, LAS unsigned char* lds) {
    const int tid = threadIdx.x, G = gridDim.x, blk = blockIdx.x;
    for (int t = blk; t < 272; t += G) { if (t < 256) p2_tile<false>(a, lds, t); else p2_tile<true>(a, lds, t); }
    const bf16_t* Z = (const bf16_t*)(a.ws + OFF_Z);
    for (int idx = blk * 512 + tid; idx < MS * SW; idx += G * 512) { const int sidx = idx / SW, j = idx - sidx * SW; a.out[O_SHIFTS + idx] = bf2f(Z[(size_t)(MP + sidx) * NZ + ZC_S + j]); }
}

constexpr int SLOT = 64 * 72;
__device__ __forceinline__ void mm_nt(const LAS bf16_t* X, const LAS bf16_t* Y, int it, int jt0, int fr, int fq, f32x4 (&acc)[2]) {
    bf16x8 xa[2];
#pragma unroll
    for (int ks = 0; ks < 2; ++ks) xa[ks] = *(const LAS bf16x8*)(X + (it * 16 + fr) * 72 + ks * 32 + fq * 8);
#pragma unroll
    for (int u = 0; u < 2; ++u)
#pragma unroll
        for (int ks = 0; ks < 2; ++ks) acc[u] = __builtin_amdgcn_mfma_f32_16x16x32_bf16(*(const LAS bf16x8*)(Y + ((jt0 + u) * 16 + fr) * 72 + ks * 32 + fq * 8), xa[ks], acc[u], 0, 0, 0);
}
template <int MASK> __device__ __forceinline__ f32x4 mask4(f32x4 v, int i, int j0) {
#pragma unroll
    for (int e = 0; e < 4; ++e) { const int j = j0 + e; const bool keep = MASK == 0 ? true : MASK == 1 ? (j < i) : MASK == 2 ? (j > i) : (j <= i); v[e] = keep ? v[e] : 0.f; }
    return v;
}
__device__ __forceinline__ void st4(LAS bf16_t* dst, int i, int j0, f32x4 v) { *(LAS u32x2*)(dst + i * 72 + j0) = pack4(v[0], v[1], v[2], v[3]); }
__device__ __forceinline__ f32x4 ld4(const LAS bf16_t* src, int i, int j0) { float f[4]; unpack4(*(const LAS u32x2*)(src + i * 72 + j0), f); return (f32x4){f[0], f[1], f[2], f[3]}; }
__device__ __forceinline__ void st4t(LAS bf16_t* dst, int i, int j0, f32x4 v) {
    const unsigned lo = cvt_pk_bf16(v[0], v[1]), hi = cvt_pk_bf16(v[2], v[3]);
    dst[(j0 + 0) * 72 + i] = (bf16_t)(lo & 0xffffu); dst[(j0 + 1) * 72 + i] = (bf16_t)(lo >> 16); dst[(j0 + 2) * 72 + i] = (bf16_t)(hi & 0xffffu); dst[(j0 + 3) * 72 + i] = (bf16_t)(hi >> 16); }
__device__ __forceinline__ void stg4(bf16_t* dst, int i, int j0, f32x4 v) { *(u32x2*)(dst + i * 64 + j0) = pack4(v[0], v[1], v[2], v[3]); }
#define ZACC() do { acc[0] = (f32x4){0.f, 0.f, 0.f, 0.f}; acc[1] = (f32x4){0.f, 0.f, 0.f, 0.f}; } while (0)

__device__ void p3a_chunks(const Args& a, LAS unsigned char* lds) {
    const int tid = threadIdx.x, G = gridDim.x, blk = blockIdx.x, wave = tid >> 6, lane = tid & 63, fr = lane & 15, fq = lane >> 4;
    unsigned char* ws = a.ws;
    const bf16_t* SCN = (const bf16_t*)(ws + OFF_SCNS) - (size_t)MP * 8 * 384;
    bf16_t* CHK = (bf16_t*)(ws + OFF_CHK); const bf16_t* Z = (const bf16_t*)(ws + OFF_Z); float* RK = (float*)(ws + OFF_RK);
    const bf16_t* WupT = (const bf16_t*)(ws + OFF_WUP); const bf16_t* AupT = (const bf16_t*)(ws + OFF_AUP);
    LAS bf16_t* SL = (LAS bf16_t*)lds;
#define S_(n) (SL + (n) * SLOT)
    LAS bf16_t* zraw = S_(8);
    LAS float* tot = (LAS float*)(lds + 17 * SLOT * 2);
    LAS float* pc = tot + 512;
    LAS float* LWf = (LAS float*)(lds + 2 * SLOT * 2);
    LAS float* LAf = (LAS float*)(lds + 4 * SLOT * 2);
    const int it = wave >> 1, jt0 = (wave & 1) * 2, irow = it * 16 + fr;
    u32x4 rg[6];
#define P3A_LOAD(unit_) do { const int bh_ = (unit_) >> 5, c_ = (unit_) & 31; const int mm0 = (bh_ >> 3) * TSEQ + c_ * 64; const int hh = bh_ & 7; \
        _Pragma("unroll") for (int i = 0; i < 6; ++i) { const int p = tid + 512 * i; if (p < 65 * 40) { const int rr = p / 40, sg = p - rr * 40, seg = sg >> 3, o8 = sg & 7; \
            const int col = seg < 3 ? (ZC_S + seg * 512 + hh * 64) : (ZC_S + 1536 + (seg - 3) * 64); const int mrow = (rr == 0 && c_ == 0) ? mm0 : (mm0 - 1 + rr); \
            rg[i] = *(const u32x4*)(Z + (size_t)mrow * NZ + col + o8 * 8); } } } while (0)
    if (blk < 2048) P3A_LOAD(blk);
    int hcur = -1;
    float mur = 0.f, muk = 0.f, muv = 0.f, muwd = 0.f, muad = 0.f, w0k = 0.f, a0k = 0.f, kkk = 0.f, kak = 0.f, rkk = 0.f;
    for (int unit = blk; unit < 2048; unit += G) {
        const int h = (unit >> 5) & 7, c = unit & 31, k = tid & 63, g = tid >> 6;
        if (h != hcur) {
            const float* mu = a.in[10];
            mur = mu[h * 64 + k]; muk = mu[512 + h * 64 + k]; muv = mu[1024 + h * 64 + k]; muwd = mu[1536 + k]; muad = mu[1600 + k];
            w0k = a.in[11][h * 64 + k]; a0k = a.in[13][h * 64 + k]; kkk = a.in[15][h * 64 + k]; kak = a.in[16][h * 64 + k]; rkk = a.in[17][h * 64 + k];
            const int row = tid >> 3, o8 = tid & 7;
            *(LAS u32x4*)(S_(15) + row * 72 + o8 * 8) = *(const u32x4*)(WupT + (size_t)(h * 64 + row) * 64 + o8 * 8);
            *(LAS u32x4*)(S_(16) + row * 72 + o8 * 8) = *(const u32x4*)(AupT + (size_t)(h * 64 + row) * 64 + o8 * 8);
            hcur = h; }
#pragma unroll
        for (int i = 0; i < 6; ++i) { const int p = tid + 512 * i; if (p < 65 * 40) { const int rr = p / 40, sg = p - rr * 40, seg = sg >> 3, o8 = sg & 7; *(LAS u32x4*)(zraw + rr * 320 + seg * 64 + o8 * 8) = rg[i]; } }
        LBAR();
        float r_[8], kx[8], v_[8];
        {
            const float fp0 = (c != 0) ? 1.f : 0.f;
            float zz[9][5];
#pragma unroll
            for (int rr = 0; rr < 9; ++rr) { const LAS bf16_t* zp_ = zraw + (g * 8 + rr) * 320 + k;
#pragma unroll
                for (int sg = 0; sg < 5; ++sg) zz[rr][sg] = bf2f(zp_[sg * 64]); }
            if (g == 0) {
#pragma unroll
                for (int sg = 0; sg < 5; ++sg) zz[0][sg] *= fp0; }
#pragma unroll
            for (int j = 0; j < 8; ++j) { const int t = g * 8 + j;
                const float c0 = zz[j + 1][0], c1 = zz[j + 1][1], c2 = zz[j + 1][2], c3 = zz[j + 1][3], c4 = zz[j + 1][4];
                const float p0 = zz[j][0], p1 = zz[j][1], p2 = zz[j][2], p3 = zz[j][3], p4 = zz[j][4];
                r_[j] = c0 + (p0 - c0) * mur; kx[j] = c1 + (p1 - c1) * muk; v_[j] = c2 + (p2 - c2) * muv;
                const float wd = c3 + (p3 - c3) * muwd, ad = c4 + (p4 - c4) * muad;
                const float e2 = __expf(2.0f * wd);
                S_(0)[t * 72 + k] = f2bf(1.0f - 2.0f * __builtin_amdgcn_rcpf(e2 + 1.0f)); S_(1)[t * 72 + k] = f2bf(ad); }
        }
        LBAR();
        f32x4 acc[2];
        ZACC(); mm_nt(S_(0), S_(15), it, jt0, fr, fq, acc);
#pragma unroll
        for (int u = 0; u < 2; ++u) *(LAS f32x4*)(LWf + irow * 64 + (jt0 + u) * 16 + 4 * fq) = acc[u];
        ZACC(); mm_nt(S_(1), S_(16), it, jt0, fr, fq, acc);
#pragma unroll
        for (int u = 0; u < 2; ++u) *(LAS f32x4*)(LAf + irow * 64 + (jt0 + u) * 16 + 4 * fq) = acc[u];
        LBAR();
        {
            float ev[8], cs[8], qn[8], bbv[8], kpv[8]; float run = 0.f;
#pragma unroll
            for (int j = 0; j < 8; ++j) { const int t = g * 8 + j;
                const float e = 0.60653065971f * sigmoidf_(w0k + LWf[t * 64 + k]); const float al = sigmoidf_(a0k + LAf[t * 64 + k]);
                const float kq = kx[j] * kkk, kp = kx[j] * (1.0f + (al - 1.0f) * kak);
                float ss = kq * kq, rs_ = r_[j] * kp * rkk;
                ss = rowsum16(ss); rs_ = rowsum16(rs_);
                ss += __shfl_xor(ss, 16); rs_ += __shfl_xor(rs_, 16); ss += __shfl_xor(ss, 32); rs_ += __shfl_xor(rs_, 32);
                const float inv = __builtin_amdgcn_rsqf(fmaxf(ss, 1e-24f));
                qn[j] = kq * inv; bbv[j] = qn[j] * al; kpv[j] = kp;
                if (lane == 0) RK[(size_t)unit * 64 + t] = rs_;
                ev[j] = e; run += e; cs[j] = run; }
            tot[g * 64 + k] = run;
            LBAR();
            float off = 0.f;
#pragma unroll
            for (int gg = 0; gg < 7; ++gg) { const float tv = tot[gg * 64 + k]; off += gg < g ? tv : 0.f; }
            float ak[8], bk[8], kk_[8];
#pragma unroll
            for (int j = 0; j < 8; ++j) { const int t = g * 8 + j; const float cum = off + cs[j];
                const float P = __expf(-cum), Pm1 = __expf(ev[j] - cum), iP = __builtin_amdgcn_rcpf(P);
                const float at = -qn[j] * Pm1, bt = bbv[j] * iP, kt = kpv[j] * iP, rt = r_[j] * P;
                S_(0)[t * 72 + k] = f2bf(at); S_(1)[t * 72 + k] = f2bf(bt); S_(2)[t * 72 + k] = f2bf(kt); S_(3)[t * 72 + k] = f2bf(rt);
                ak[j] = at; bk[j] = bt; kk_[j] = kt;
                if (j == 7 && g == 7) pc[k] = P; }
            *(LAS u32x4*)(S_(4) + k * 72 + g * 8) = pack8(ak); *(LAS u32x4*)(S_(5) + k * 72 + g * 8) = pack8(bk);
            *(LAS u32x4*)(S_(6) + k * 72 + g * 8) = pack8(kk_); *(LAS u32x4*)(S_(7) + k * 72 + g * 8) = pack8(v_);
        }
        LBAR();
        { const int nxt = (unit + G < 2048) ? unit + G : unit; P3A_LOAD(nxt); }
        ZACC(); mm_nt(S_(0), S_(1), it, jt0, fr, fq, acc);
#pragma unroll
        for (int u = 0; u < 2; ++u) { const int j0 = (jt0 + u) * 16 + 4 * fq; f32x4 v = mask4<1>(acc[u], irow, j0); st4(S_(11), irow, j0, v); st4t(S_(12), irow, j0, v);
#pragma unroll
            for (int e = 0; e < 4; ++e) v[e] += (j0 + e == irow) ? 1.f : 0.f;
            st4(S_(13), irow, j0, v); }
        ZACC(); mm_nt(S_(0), S_(2), it, jt0, fr, fq, acc);
#pragma unroll
        for (int u = 0; u < 2; ++u) { const int j0 = (jt0 + u) * 16 + 4 * fq; st4(S_(8), irow, j0, mask4<1>(acc[u], irow, j0)); }
        ZACC(); mm_nt(S_(3), S_(1), it, jt0, fr, fq, acc);
#pragma unroll
        for (int u = 0; u < 2; ++u) { const int j0 = (jt0 + u) * 16 + 4 * fq; st4(S_(9), irow, j0, mask4<3>(acc[u], irow, j0)); }
        ZACC(); mm_nt(S_(3), S_(2), it, jt0, fr, fq, acc);
#pragma unroll
        for (int u = 0; u < 2; ++u) { const int j0 = (jt0 + u) * 16 + 4 * fq; st4(S_(10), irow, j0, mask4<3>(acc[u], irow, j0)); }
        LBAR();
        ZACC(); mm_nt(S_(11), S_(12), it, jt0, fr, fq, acc);
#pragma unroll
        for (int u = 0; u < 2; ++u) { st4(S_(1), irow, (jt0 + u) * 16 + 4 * fq, acc[u]); st4t(S_(2), irow, (jt0 + u) * 16 + 4 * fq, acc[u]); }
        ZACC(); mm_nt(S_(7), S_(8), it, jt0, fr, fq, acc);
#pragma unroll
        for (int u = 0; u < 2; ++u) st4(S_(0), irow, (jt0 + u) * 16 + 4 * fq, acc[u]);
        LBAR();
#pragma unroll
        for (int sgi = 0; sgi < 4; ++sgi) {
            const int pa = (sgi & 1) ? 11 : 1, pta = (sgi & 1) ? 12 : 2, pb = (sgi & 1) ? 1 : 11, ptb = (sgi & 1) ? 2 : 12, tla = (sgi & 1) ? 14 : 13, tlb = (sgi & 1) ? 13 : 14;
            ZACC(); mm_nt(S_(tla), S_(pta), it, jt0, fr, fq, acc);
#pragma unroll
            for (int u = 0; u < 2; ++u) { const int j0 = (jt0 + u) * 16 + 4 * fq; st4(S_(tlb), irow, j0, acc[u] + ld4(S_(tla), irow, j0)); }
            ZACC(); mm_nt(S_(pa), S_(pta), it, jt0, fr, fq, acc);
#pragma unroll
            for (int u = 0; u < 2; ++u) { if (sgi < 3) st4(S_(pb), irow, (jt0 + u) * 16 + 4 * fq, acc[u]); st4t(S_(ptb), irow, (jt0 + u) * 16 + 4 * fq, acc[u]); }
            LBAR();
        }
        ZACC(); mm_nt(S_(13), S_(2), it, jt0, fr, fq, acc);
#pragma unroll
        for (int u = 0; u < 2; ++u) { const int j0 = (jt0 + u) * 16 + 4 * fq; st4(S_(14), irow, j0, acc[u] + ld4(S_(13), irow, j0)); }
        LBAR();
        ZACC(); mm_nt(S_(0), S_(14), it, jt0, fr, fq, acc);
#pragma unroll
        for (int u = 0; u < 2; ++u) st4(S_(1), irow, (jt0 + u) * 16 + 4 * fq, acc[u]);
        ZACC(); mm_nt(S_(4), S_(14), it, jt0, fr, fq, acc);
#pragma unroll
        for (int u = 0; u < 2; ++u) st4(S_(2), irow, (jt0 + u) * 16 + 4 * fq, acc[u]);
        LBAR();
        bf16_t* chk = CHK + (size_t)unit * 16384;
        ZACC();
        mm_nt(S_(9), S_(2), it, jt0, fr, fq, acc);
#pragma unroll
        for (int u = 0; u < 2; ++u) { const int j0 = (jt0 + u) * 16 + 4 * fq; stg4(chk, irow, j0, acc[u] + ld4(S_(3), irow, j0)); }
        ZACC();
        mm_nt(S_(9), S_(1), it, jt0, fr, fq, acc);
        mm_nt(S_(10), S_(7), it, jt0, fr, fq, acc);
#pragma unroll
        for (int u = 0; u < 2; ++u) stg4(chk + 4096, irow, (jt0 + u) * 16 + 4 * fq, acc[u]);
        ZACC();
        mm_nt(S_(1), S_(5), it, jt0, fr, fq, acc);
        mm_nt(S_(7), S_(6), it, jt0, fr, fq, acc);
#pragma unroll
        for (int u = 0; u < 2; ++u) { const int j0 = (jt0 + u) * 16 + 4 * fq; const f32x4 pv = *(const LAS f32x4*)(pc + j0); stg4(chk + 8192, irow, j0, acc[u] * pv); }
        ZACC();
        mm_nt(S_(5), S_(2), it, jt0, fr, fq, acc);
        { const float pr = pc[irow];
#pragma unroll
          for (int u = 0; u < 2; ++u) { const int j0 = (jt0 + u) * 16 + 4 * fq; f32x4 v = acc[u];
#pragma unroll
              for (int e = 0; e < 4; ++e) v[e] = (v[e] + ((j0 + e == irow) ? 1.f : 0.f)) * pr;
              stg4(chk + 12288, irow, j0, v); } }
        LBAR();
    }
#undef P3A_LOAD
#undef S_
}

__device__ void p3_sample_step(const Args& a, int blk, int G) {
    const int tid = threadIdx.x;
    unsigned char* ws = a.ws;
    const bf16_t* SCN = (const bf16_t*)(ws + OFF_SCNS) - (size_t)MP * 8 * 384;
    const float* state_wkv = a.in[6]; bf16_t* OS = (bf16_t*)(ws + OFF_OS);
    const int row = tid >> 3, c0 = (tid & 7) * 8;
    constexpr int NI = 4;
    for (int it0 = blk; it0 < MS * NH; it0 += G * NI) {
        u32x4 q[NI][5]; f32x4 sA[NI], sB[NI]; unsigned short vq[NI];
#pragma unroll
        for (int n = 0; n < NI; ++n) { const int itn = (it0 + n * G < MS * NH) ? it0 + n * G : it0; const int s_ = itn >> 3, h = itn & 7, m = MP + s_;
            const bf16_t* sc = SCN + ((size_t)m * 8 + h) * 384; const size_t so = ((size_t)(s_ * 8 + h) * 64 + row) * 64 + c0;
            q[n][0] = *(const u32x4*)(sc + c0); q[n][1] = *(const u32x4*)(sc + 64 + c0); q[n][2] = *(const u32x4*)(sc + 128 + c0); q[n][3] = *(const u32x4*)(sc + 256 + c0); q[n][4] = *(const u32x4*)(sc + 320 + c0);
            vq[n] = sc[192 + row]; sA[n] = *(const f32x4*)(state_wkv + so); sB[n] = *(const f32x4*)(state_wkv + so + 4); }
#pragma unroll
        for (int n = 0; n < NI; ++n) { const int itn = it0 + n * G; if (itn < MS * NH) { const int s_ = itn >> 3, h = itn & 7;
            float r_[8], e_[8], kp[8], kq[8], bb[8];
            unpack8(q[n][0], r_); unpack8(q[n][1], e_); unpack8(q[n][2], kp); unpack8(q[n][3], kq); unpack8(q[n][4], bb);
            const float vv = bf2f(vq[n]);
            const size_t so = ((size_t)(s_ * 8 + h) * 64 + row) * 64 + c0;
            float S[8] = {sA[n][0], sA[n][1], sA[n][2], sA[n][3], sB[n][0], sB[n][1], sB[n][2], sB[n][3]};
            float d = 0.f;
#pragma unroll
            for (int i = 0; i < 8; ++i) d += S[i] * kq[i];
            d += __shfl_xor(d, 1); d += __shfl_xor(d, 2); d += __shfl_xor(d, 4);
            float y = 0.f;
#pragma unroll
            for (int i = 0; i < 8; ++i) { S[i] = S[i] * __expf(-e_[i]) + (-d) * bb[i] + vv * kp[i]; y += S[i] * r_[i]; }
            y += __shfl_xor(y, 1); y += __shfl_xor(y, 2); y += __shfl_xor(y, 4);
            *(f32x4*)(a.out + O_WKVS + so) = (f32x4){S[0], S[1], S[2], S[3]}; *(f32x4*)(a.out + O_WKVS + so + 4) = (f32x4){S[4], S[5], S[6], S[7]};
            if ((tid & 7) == 0) OS[(size_t)s_ * 512 + h * 64 + row] = f2bf(y); } }
    }
}

__device__ void p3b_seq(const Args& a, LAS unsigned char* lds) {
    const int tid = threadIdx.x, G = gridDim.x, blk = blockIdx.x, wave = tid >> 6, lane = tid & 63, fr = lane & 15, fq = lane >> 4;
    unsigned char* ws = a.ws;
    const bf16_t* CHK = (const bf16_t*)(ws + OFF_CHK); bf16_t* SALL = (bf16_t*)(ws + OFF_SALL);
    LAS bf16_t* Shi = (LAS bf16_t*)lds; LAS bf16_t* Slo = Shi + 2 * 16 * 72;
    for (int item = blk; item < 256; item += G) {
        const int xcd_ = item & 7, idx_ = item >> 3;
        const int bh = (G == 256) ? xcd_ * 8 + (idx_ >> 2) : (item >> 2), q = (G == 256) ? (idx_ & 3) : (item & 3), j = wave;
        LBAR();
        for (int i = tid; i < 16 * 72; i += 512) { Shi[i] = 0; Slo[i] = 0; }
        LBAR();
        const bf16_t* chk0 = CHK + (size_t)(bh * 32) * 16384;
        constexpr int PF = 16;
        const size_t goff = 12288 + (size_t)(j * 16 + fr) * 64 + fq * 8, hoff = 8192 + (size_t)(q * 16 + fr) * 64 + j * 16 + 4 * fq;
        for (int c0 = 0; c0 < 32; c0 += PF) {
          bf16x8 G0[PF], G1[PF]; u32x2 HQ[PF];
          if (wave < 4) {
#pragma unroll
            for (int u = 0; u < PF; ++u) { const bf16_t* cn = chk0 + (size_t)(c0 + u) * 16384; G0[u] = *(const bf16x8*)(cn + goff); G1[u] = *(const bf16x8*)(cn + goff + 32); HQ[u] = *(const u32x2*)(cn + hoff); }
          }
#pragma unroll
          for (int u = 0; u < PF; ++u) { const int c = c0 + u;
            if (wave < 4) {
                const bf16x8 cg0 = G0[u], cg1 = G1[u]; const u32x2 chq = HQ[u];
                const LAS bf16_t* sh = Shi + (c & 1) * (16 * 72) + fr * 72 + fq * 8; const LAS bf16_t* sl = Slo + (c & 1) * (16 * 72) + fr * 72 + fq * 8;
                const bf16x8 h0 = *(const LAS bf16x8*)sh, h1 = *(const LAS bf16x8*)(sh + 32), l0 = *(const LAS bf16x8*)sl, l1 = *(const LAS bf16x8*)(sl + 32);
                bf16_t* sg = SALL + (size_t)(bh * 32 + c) * 4096 + (q * 16 + fr) * 64 + fq * 8;
                if (wave == 0) *(bf16x8*)sg = h0;
                if (wave == 1) *(bf16x8*)(sg + 32) = h1;
                f32x4 acc = {0.f, 0.f, 0.f, 0.f};
                acc = __builtin_amdgcn_mfma_f32_16x16x32_bf16(cg0, h0, acc, 0, 0, 0); acc = __builtin_amdgcn_mfma_f32_16x16x32_bf16(cg1, h1, acc, 0, 0, 0);
                acc = __builtin_amdgcn_mfma_f32_16x16x32_bf16(cg0, l0, acc, 0, 0, 0); acc = __builtin_amdgcn_mfma_f32_16x16x32_bf16(cg1, l1, acc, 0, 0, 0);
                float hv[4]; unpack4(chq, hv);
                const float s0 = acc[0] + hv[0], s1 = acc[1] + hv[1], s2 = acc[2] + hv[2], s3 = acc[3] + hv[3];
                const u32x2 ph = pack4(s0, s1, s2, s3); float hf[4]; unpack4(ph, hf);
                const u32x2 pl = pack4(s0 - hf[0], s1 - hf[1], s2 - hf[2], s3 - hf[3]);
                const int wo = ((c + 1) & 1) * (16 * 72) + fr * 72 + j * 16 + 4 * fq;
                *(LAS u32x2*)(Shi + wo) = ph; *(LAS u32x2*)(Slo + wo) = pl;
                if (c == 31) *(f32x4*)(a.out + O_WKVP + ((size_t)bh * 64 + q * 16 + fr) * 64 + j * 16 + 4 * fq) = (f32x4){s0, s1, s2, s3};
            }
            LBAR();
          }
        }
    }
}

__device__ void p3c_out(const Args& a) {
    const int tid = threadIdx.x, G = gridDim.x, blk = blockIdx.x, wave = tid >> 6, lane = tid & 63, fr = lane & 15, fq = lane >> 4;
    unsigned char* ws = a.ws;
    const bf16_t* SCN = (const bf16_t*)(ws + OFF_SCNS) - (size_t)MP * 8 * 384; const bf16_t* CHK = (const bf16_t*)(ws + OFF_CHK); const bf16_t* SALL = (const bf16_t*)(ws + OFF_SALL); bf16_t* YC = (bf16_t*)a.out;
    const bf16_t* Z = (const bf16_t*)(ws + OFF_Z); const float* RK = (const float*)(ws + OFF_RK); const float* mu = a.in[10];
    const float* r_k = a.in[17]; const float* ln_w = a.in[18]; const float* ln_b = a.in[19];
    for (int pi = blk; pi < 1024; pi += G) {
        const int unit = pi * 2 + (wave >> 2), it = wave & 3, bh = unit >> 5, c = unit & 31, b = bh >> 3, h = bh & 7;
        const int m = b * TSEQ + c * 64 + it * 16 + fr;
        const bf16_t* chk = CHK + (size_t)unit * 16384; const bf16_t* sall = SALL + (size_t)unit * 4096;
        bf16x8 xq[2];
#pragma unroll
        for (int ks = 0; ks < 2; ++ks) xq[ks] = *(const bf16x8*)(chk + (it * 16 + fr) * 64 + ks * 32 + fq * 8);
        const bool hasprev = (c * 64 + it * 16 + fr) >= 1;
        const bf16_t* zv = Z + (size_t)m * NZ + ZC_S + 1024 + h * 64 + 4 * fq; const bf16_t* zvp = hasprev ? zv - NZ : zv; const float fpv = hasprev ? 1.f : 0.f;
        const float rk = RK[(size_t)unit * 64 + it * 16 + fr];
        bf16_t* yp = YC + (size_t)m * D + 512 + h * 64 + 4 * fq;
        f32x4 acc[4]; u32x2 qy[4], qv[4], qvp[4], qg[4];
#pragma unroll
        for (int jt = 0; jt < 4; ++jt) { qy[jt] = *(const u32x2*)(chk + 4096 + (it * 16 + fr) * 64 + jt * 16 + 4 * fq);
            qv[jt] = *(const u32x2*)(zv + jt * 16); qvp[jt] = *(const u32x2*)(zvp + jt * 16); qg[jt] = *(const u32x2*)(yp + jt * 16); }
#pragma unroll
        for (int jt = 0; jt < 4; ++jt) { acc[jt] = (f32x4){0.f, 0.f, 0.f, 0.f};
#pragma unroll
            for (int ks = 0; ks < 2; ++ks) acc[jt] = __builtin_amdgcn_mfma_f32_16x16x32_bf16(*(const bf16x8*)(sall + (jt * 16 + fr) * 64 + ks * 32 + fq * 8), xq[ks], acc[jt], 0, 0, 0);
        }
        float o[4][4], vv[4][4]; float sm = 0.f;
#pragma unroll
        for (int jt = 0; jt < 4; ++jt) { float yl[4], vc[4], vp[4]; unpack4(qy[jt], yl); unpack4(qv[jt], vc); unpack4(qvp[jt], vp);
            const f32x4 mv = *(const f32x4*)(mu + 1024 + h * 64 + jt * 16 + 4 * fq);
#pragma unroll
            for (int e = 0; e < 4; ++e) { o[jt][e] = acc[jt][e] + yl[e]; sm += o[jt][e]; vv[jt][e] = vc[e] + (vp[e] * fpv - vc[e]) * mv[e]; } }
        sm += __shfl_xor(sm, 16); sm += __shfl_xor(sm, 32);
        const float mean = sm * (1.0f / 64.0f); float var = 0.f;
#pragma unroll
        for (int jt = 0; jt < 4; ++jt)
#pragma unroll
            for (int e = 0; e < 4; ++e) { o[jt][e] -= mean; var += o[jt][e] * o[jt][e]; }
        var += __shfl_xor(var, 16); var += __shfl_xor(var, 32);
        const float rstd = rsqrtf(var * (1.0f / 64.0f) + 64e-5f);
#pragma unroll
        for (int jt = 0; jt < 4; ++jt) { const int ch = h * 64 + jt * 16 + 4 * fq; const f32x4 lw = *(const f32x4*)(ln_w + ch), lb = *(const f32x4*)(ln_b + ch); float gt[4]; unpack4(qg[jt], gt);
            float y[4];
#pragma unroll
            for (int e = 0; e < 4; ++e) { y[e] = (o[jt][e] * rstd * lw[e] + lb[e] + rk * vv[jt][e]) * gt[e];
            }
            *(u32x2*)(yp + jt * 16) = pack4(y[0], y[1], y[2], y[3]); }
    }
    const bf16_t* OS = (const bf16_t*)(ws + OFF_OS);
    const int c = lane * 8, h = lane >> 3, cc = (lane & 7) * 8;
    for (int s = blk * 8 + wave; s < MS; s += G * 8) {
        const int m = MP + s;
        float o[8], r_[8], kp[8], v_[8], g[8];
        const bf16_t* sc = SCN + ((size_t)m * 8 + h) * 384 + cc;
        unpack8(*(const u32x4*)(OS + (size_t)s * 512 + c), o); unpack8(*(const u32x4*)(sc), r_); unpack8(*(const u32x4*)(sc + 128), kp); unpack8(*(const u32x4*)(sc + 192), v_);
        unpack8(*(const u32x4*)(YC + (size_t)m * D + 512 + c), g);
        float sm = 0.f, rk = 0.f;
#pragma unroll
        for (int i = 0; i < 8; ++i) { sm += o[i]; rk += r_[i] * kp[i] * r_k[h * 64 + cc + i]; }
        sm += __shfl_xor(sm, 1); sm += __shfl_xor(sm, 2); sm += __shfl_xor(sm, 4);
        rk += __shfl_xor(rk, 1); rk += __shfl_xor(rk, 2); rk += __shfl_xor(rk, 4);
        const float mean = sm * (1.0f / 64.0f);
        float var = 0.f;
#pragma unroll
        for (int i = 0; i < 8; ++i) { o[i] -= mean; var += o[i] * o[i]; }
        var += __shfl_xor(var, 1); var += __shfl_xor(var, 2); var += __shfl_xor(var, 4);
        const float rstd = rsqrtf(var * (1.0f / 64.0f) + 64e-5f);
        float y[8];
#pragma unroll
        for (int i = 0; i < 8; ++i) y[i] = (o[i] * rstd * ln_w[c + i] + ln_b[c + i] + rk * v_[i]) * g[i];
        *(u32x4*)(YC + (size_t)m * D + 512 + c) = pack8(y);
    }
}

__device__ void p5_out(const Args& a, LAS unsigned char* lds) {
    const int tid = threadIdx.x, G = gridDim.x, blk = blockIdx.x, wave = tid >> 6, lane = tid & 63, fr = lane & 15, fq = lane >> 4;
    unsigned char* ws = a.ws;
    const bf16_t* YC = (const bf16_t*)a.out; const bf16_t* WoutT = (const bf16_t*)(ws + OFF_WOUT); const bf16_t* PB = (const bf16_t*)(ws + OFF_PB); const bf16_t* WppT = (const bf16_t*)(ws + OFF_WPP);
    bf16_t* H1B = (bf16_t*)(ws + OFF_H1B); bf16_t* PP = (bf16_t*)(ws + OFF_PPB);
    { pg8::Gemm g{YC, WoutT, MP, D, D}; pg8::StaticOrder S; S.init(MP, D, G, blk); EpiH1 E{a.in[0], H1B}; pg8::gemm_phase<EpiH1, pg8::StaticOrder>(lds, g, S, E, nullptr); }
    { pg8::Gemm g{PB, WppT, MP, D, DP}; pg8::StaticOrder S; S.init(MP, D, G, blk); EpiF32 E{PP}; pg8::gemm_phase<EpiF32, pg8::StaticOrder>(lds, g, S, E, nullptr); }
    for (int t2 = blk; t2 < 256; t2 += G) {
        const int tile = t2 * 2 + (wave >> 2), ks = wave & 3, rt = tile & 7, ct = tile >> 3; const int row = MP + rt * 16 + fr; const size_t o = (size_t)row * D + ct * 16 + 4 * fq;
        f32x4 acc = mini_tile_k<8>(YC + (size_t)row * D + ks * 256, WoutT + (size_t)(ct * 16 + fr) * D + ks * 256, fq);
        f32x4 acp = mini_tile_k<2>(PB + (size_t)row * DP + ks * 64, WppT + (size_t)(ct * 16 + fr) * DP + ks * 64, fq);
        acc = splitk_reduce(lds, acc, wave, lane);
        acp = splitk_reduce(lds, acp, wave, lane);
        if (ks == 0) {
            const f32x4 v = *(const f32x4*)(a.in[1] + (size_t)(row - MP) * D + ct * 16 + 4 * fq) + acc;
            *(u32x2*)(H1B + o) = pack4(v[0], v[1], v[2], v[3]);
            *(u32x2*)(PP + o) = pack4(acp[0], acp[1], acp[2], acp[3]);
        }
    }
}

__device__ void p6_gate(const Args& a, LAS unsigned char* lds) {
    const int tid = threadIdx.x, G = gridDim.x, blk = blockIdx.x, wave = tid >> 6, lane = tid & 63, fr = lane & 15, fq = lane >> 4;
    unsigned char* ws = a.ws;
    const bf16_t* WpgT = (const bf16_t*)(ws + OFF_WPG); const bf16_t* H1B = (const bf16_t*)(ws + OFF_H1B); const bf16_t* PP = (const bf16_t*)(ws + OFF_PPB);
    { pg8::Gemm g{H1B, WpgT, MP, D, D}; pg8::StaticOrder S; S.init(MP, D, G, blk); EpiH2 E{H1B, PP, a.out}; pg8::gemm_phase<EpiH2, pg8::StaticOrder>(lds, g, S, E, nullptr); }
    for (int t2 = blk; t2 < 256; t2 += G) {
        const int tile = t2 * 2 + (wave >> 2), ks = wave & 3, rt = tile & 7, ct = tile >> 3; const int row = MP + rt * 16 + fr; const size_t o = (size_t)row * D + ct * 16 + 4 * fq;
        f32x4 g = mini_tile_k<8>(H1B + (size_t)row * D + ks * 256, WpgT + (size_t)(ct * 16 + fr) * D + ks * 256, fq);
        g = splitk_reduce(lds, g, wave, lane);
        if (ks == 0) {
            float h[4], p[4]; unpack4(*(const u32x2*)(H1B + o), h); unpack4(*(const u32x2*)(PP + o), p);
            f32x4 v; v[0] = h[0] + sigmoidf_(g[0]) * p[0]; v[1] = h[1] + sigmoidf_(g[1]) * p[1]; v[2] = h[2] + sigmoidf_(g[2]) * p[2]; v[3] = h[3] + sigmoidf_(g[3]) * p[3];
            *(f32x4*)(a.out + o) = v;
        }
    }
}

__device__ void p7_norm(const Args& a) {
    const int tid = threadIdx.x, G = gridDim.x, blk = blockIdx.x, wave = tid >> 6, lane = tid & 63;
    const float* fg = a.in[23];
    f32x4 gv[4];
#pragma unroll
    for (int i = 0; i < 4; ++i) gv[i] = *(const f32x4*)(fg + i * 256 + lane * 4);
    for (int row0 = (blk * 8 + wave) * 2; row0 < MT; row0 += G * 16) {
        f32x4 v[2][4];
#pragma unroll
        for (int r = 0; r < 2; ++r)
#pragma unroll
            for (int i = 0; i < 4; ++i) v[r][i] = *(const f32x4*)(a.out + (size_t)(row0 + r) * D + lane * 4 + i * 256);
#pragma unroll
        for (int r = 0; r < 2; ++r) { float ss = 0.f;
#pragma unroll
            for (int i = 0; i < 4; ++i) ss += v[r][i][0] * v[r][i][0] + v[r][i][1] * v[r][i][1] + v[r][i][2] * v[r][i][2] + v[r][i][3] * v[r][i][3];
#pragma unroll
            for (int o = 32; o >= 1; o >>= 1) ss += __shfl_xor(ss, o);
            const float rs = rsqrtf(ss * (1.0f / D) + 1e-6f);
#pragma unroll
            for (int i = 0; i < 4; ++i) *(f32x4*)(a.out + (size_t)(row0 + r) * D + lane * 4 + i * 256) = v[r][i] * rs * gv[i]; }
    }
}

#define XB_TMO      128
#define XB_XCNT(j)  (256  + 64 * (j))
#define XB_XSUB(j)  (1280 + 64 * (j))
#define XB_XGEN(j)  (2304 + 64 * (j))
#define XB_TOP      3328
#define XB_TOPGEN   3392
#define XCD_BAR_WORDS 3456
#define XB_SPIN_CAP (1u << 18)

__device__ __forceinline__ unsigned xb_ld(unsigned* p)              { return __hip_atomic_load(p, __ATOMIC_RELAXED, __HIP_MEMORY_SCOPE_AGENT); }
__device__ __forceinline__ unsigned xb_add(unsigned* p, unsigned v) { return __hip_atomic_fetch_add(p, v, __ATOMIC_RELAXED, __HIP_MEMORY_SCOPE_AGENT); }
__device__ __forceinline__ unsigned xb_xcc_id() { return (unsigned)__builtin_amdgcn_s_getreg((3 << 11) | 20) & 0xFu; }
#define XB_SPIN(cond, bar) do { unsigned _sp = 0; while (cond) { __builtin_amdgcn_s_sleep(1); \
    if ((++_sp & 255u) == 0u) { if (xb_ld(&(bar)[XB_TMO])) break; if (_sp > XB_SPIN_CAP) { atomicAdd(&(bar)[XB_TMO], 1u); break; } } } } while (0)

struct XcdBarrier {
    unsigned* bar; unsigned x;
    volatile LAS unsigned* st;
};

__device__ __forceinline__ XcdBarrier xcd_barrier_post(unsigned* bar, volatile LAS unsigned* st) {
    XcdBarrier b; b.bar = bar; b.x = xb_xcc_id(); b.st = st;
    if (threadIdx.x == 0) (void)xb_add(&bar[XB_XCNT(b.x)], 1u);
    return b;
}
__device__ __forceinline__ void xcd_barrier_complete(unsigned* bar, unsigned x, unsigned& nloc, unsigned& nx) {
    const unsigned G = gridDim.x * gridDim.y * gridDim.z;
    unsigned sum, cnt, mine, sp = 0u;
    for (;;) {
        sum = 0u; cnt = 0u; mine = 0u;
#pragma unroll
        for (unsigned j = 0; j < 16; ++j) { const unsigned c = xb_ld(&bar[XB_XCNT(j)]); sum += c; cnt += (c > 0u) ? 1u : 0u; mine = (j == x) ? c : mine; }
        if (sum == G) break;
        __builtin_amdgcn_s_sleep(1);
        if ((++sp & 255u) == 0u) { if (xb_ld(&bar[XB_TMO])) break; if (sp > XB_SPIN_CAP) { atomicAdd(&bar[XB_TMO], 1u); break; } }
    }
    nloc = mine > 0u ? mine : 1u; nx = cnt > 0u ? cnt : 1u;
}

__device__ __forceinline__ void xcd_barrier(const XcdBarrier& b) {
    asm volatile("s_waitcnt vmcnt(0)" ::: "memory");
    __syncthreads();
    if (threadIdx.x == 0) {
        unsigned* bar = b.bar;
        __builtin_amdgcn_s_waitcnt(0);
        unsigned nloc = b.st[0], nx = b.st[1];
        if (nloc == 0u) { xcd_barrier_complete(bar, b.x, nloc, nx); b.st[0] = nloc; b.st[1] = nx; }
        const unsigned old = xb_add(&bar[XB_XSUB(b.x)], 1u);
        const unsigned gen = old / nloc;
        if (old + 1u == (gen + 1u) * nloc) {
            __builtin_amdgcn_fence(__ATOMIC_RELEASE, "agent");
            asm volatile("s_waitcnt vmcnt(0)" ::: "memory");
            const unsigned og = xb_add(&bar[XB_TOP], 1u);
            const unsigned tg = og / nx;
            if (og + 1u == (tg + 1u) * nx) xb_add(&bar[XB_TOPGEN], 1u);
            else XB_SPIN(xb_ld(&bar[XB_TOPGEN]) == tg, bar);
            __builtin_amdgcn_fence(__ATOMIC_ACQUIRE, "agent");
            xb_add(&bar[XB_XGEN(b.x)], 1u);
            asm volatile("s_waitcnt vmcnt(0)" ::: "memory");
        } else {
            XB_SPIN(xb_ld(&bar[XB_XGEN(b.x)]) == gen, bar);
            __builtin_amdgcn_fence(__ATOMIC_ACQUIRE, "agent");
            asm volatile("s_waitcnt vmcnt(0)" ::: "memory");
        }
    }
    __syncthreads();
}

__global__ void __launch_bounds__(512, 2) fwd(Args a) {
    extern __shared__ __attribute__((aligned(16))) unsigned char lds_raw[];
    LAS unsigned char* lds = (LAS unsigned char*)lds_raw;
    cg::grid_group grid = cg::this_grid();
    volatile LAS unsigned* xst = (volatile LAS unsigned*)(lds + LDS_BYTES - 16);
    if (threadIdx.x == 0) { xst[0] = 0u; xst[1] = 0u; }
    __syncthreads();
    const XcdBarrier xb = xcd_barrier_post((unsigned*)(a.ws + OFF_BAR), xst);
    if (a.ph_hi > 1000) grid.sync();
#define IN(k) (a.ph_lo <= (k) && (k) < a.ph_hi)
#define GSYNC() xcd_barrier(xb)
#define SEAM(k) do { if (IN(k) && IN((k) + 1)) GSYNC(); } while (0)
#ifndef REP_PHASE
#define REP_PHASE -1
#endif
#define REPS(k) ((REP_PHASE == (k)) ? 2 : 1)
    if (IN(0)) for (int r = 0; r < REPS(0); ++r) { if (r) GSYNC(); p0_prep(a, lds); }
    SEAM(0);
    if (IN(1)) for (int r = 0; r < REPS(1); ++r) { if (r) GSYNC(); p1_gemm_in(a, lds); }
    SEAM(1);
    if (IN(2)) for (int r = 0; r < REPS(2); ++r) { if (r) GSYNC(); p2_all(a, lds); }
    if (IN(2) && !IN(3)) {}
    else if (!IN(2) && IN(3)) {}
    if (IN(3)) for (int r = 0; r < REPS(3); ++r) { if (r) GSYNC(); __syncthreads(); p3a_chunks(a, lds); }
    SEAM(3);
    if (IN(4)) for (int r = 0; r < REPS(4); ++r) { if (r) GSYNC(); p3b_seq(a, lds); if (r == 0) p3_sample_step(a, (int)blockIdx.x, (int)gridDim.x); }
    SEAM(4);
    if (IN(5)) p3c_out(a);
    SEAM(5);
    if (IN(6)) p5_out(a, lds);
    SEAM(6);
    if (IN(7)) p6_gate(a, lds);
    SEAM(7);
#if REP_PHASE == 99
    GSYNC(); GSYNC(); GSYNC(); GSYNC();
#endif
    if (IN(8)) p7_norm(a);
}

#ifndef N_LAUNCH_MODE
#define N_LAUNCH_MODE 1
#endif
extern "C" void kernel_launch(void* const* d_in, const int* in_sizes, int n_in, void* d_out, int out_size, void* d_ws, size_t ws_size, hipStream_t stream) {
    static int grid = 0;
    if (grid == 0) {
        if (n_in != 24 || ws_size < WS_END) { fprintf(stderr, "kernel_launch: unexpected n_in %d / ws_size %zu (need %zu)\n", n_in, ws_size, (size_t)WS_END); grid = -1; return; }
        int dev = 0, cus = 0, per_cu = 0;
        (void)hipGetDevice(&dev); (void)hipDeviceGetAttribute(&cus, hipDeviceAttributeMultiprocessorCount, dev);
        if (hipFuncSetAttribute((const void*)fwd, hipFuncAttributeMaxDynamicSharedMemorySize, LDS_BYTES) != hipSuccess) { fprintf(stderr, "kernel_launch: hipFuncSetAttribute failed\n"); grid = -1; return; }
        if (hipOccupancyMaxActiveBlocksPerMultiprocessor(&per_cu, (const void*)fwd, 512, LDS_BYTES) != hipSuccess || per_cu < 1) { fprintf(stderr, "kernel_launch: occupancy query gives %d\n", per_cu); per_cu = 1; }
        (void)hipGetLastError();
        grid = cus;
    }
    if (grid < 0) return;
    Args a{};
    for (int i = 0; i < 24; ++i) a.in[i] = (const float*)d_in[i];
    a.out = (float*)d_out; a.ws = (unsigned char*)d_ws;
    (void)hipMemsetAsync((unsigned char*)d_ws + OFF_BAR, 0, XCD_BAR_WORDS * 4, stream);
    if (N_LAUNCH_MODE == 1) {
        a.ph_lo = 0; a.ph_hi = 9;
        void* args[] = {&a};
        hipError_t e = hipLaunchCooperativeKernel((const void*)fwd, dim3(grid), dim3(512), args, LDS_BYTES, stream);
        if (e != hipSuccess) fprintf(stderr, "kernel_launch: cooperative launch failed: %s (grid %d)\n", hipGetErrorString(e), grid);
    } else {
        for (int ph = 0; ph < 9; ++ph) { a.ph_lo = ph; a.ph_hi = ph + 1; hipLaunchKernelGGL(fwd, dim3(grid), dim3(512), LDS_BYTES, stream, a); }
    }
}
```

```cpp
#include <hip/hip_runtime.h>
#include <hip/hip_cooperative_groups.h>
#include <cstdio>
namespace pg8 {
#define PG8_LAS __attribute__((address_space(3)))
typedef unsigned short bf16_t;
typedef short bf16x8 __attribute__((ext_vector_type(8)));
typedef float f32x4 __attribute__((ext_vector_type(4)));
typedef unsigned u32x4 __attribute__((ext_vector_type(4)));
constexpr int BM = 256, BK = 64, HALF = 128, HTB = HALF * BK * 2  , STAGE_BYTES = 8 * HTB, NXCD = 8, WGM = 8;

__host__ __device__ __forceinline__ int lds_byte(int r, int c) { const int st = (r >> 4) * 2 + (c >> 5), rr = r & 15, cc = c & 31, ob = rr * 64 + cc * 2; return st * 1024 + (ob ^ (((ob >> 9) & 1) << 5)); }
__host__ __device__ __forceinline__ void stage_rc(int b, int& R, int& C) { const int st = b / 1024, sb = b % 1024, swz = sb ^ (((sb >> 9) & 1) << 5); R = (st >> 1) * 16 + swz / 64; C = (st & 1) * 32 + (swz % 64) / 2; }
__host__ __device__ __forceinline__ int perm32(int rho) { const int n = rho >> 4, i = rho & 15; return 8 * (i >> 2) + 4 * n + (i & 3); }

struct Unit { int pm, pn; };
struct Gemm { const bf16_t* A; const bf16_t* Bt; int M, N, K; };

struct StaticOrder {
    int nM, nN, nwg, G, c;
    __host__ __device__ void init(int M, int N, int G_, int c_) { nM = M / BM; nN = N / BM; nwg = nM * nN; G = G_; c = c_; }
    __host__ __device__ bool next(int i, Unit& u) const {
        const long L = (long)i * G + c; if (L >= nwg) return false;
        int wgid = (int)L; { const int q = nwg / NXCD, r = nwg % NXCD, xcd = wgid % NXCD, off = wgid / NXCD; wgid = (xcd < r ? xcd * (q + 1) : r * (q + 1) + (xcd - r) * q) + off; }
        const int nig = WGM * nN, gid = wgid / nig, fm = gid * WGM, gsz = (nM - fm) < WGM ? (nM - fm) : WGM;
        u.pm = fm + ((wgid % nig) % gsz); u.pn = (wgid % nig) / gsz; return true;
    }
    __device__ __forceinline__ void a_ready(const Unit&) const {}
    __device__ __forceinline__ void done(const Unit&) const {}
};
typedef __bf16 bf16v2_t __attribute__((ext_vector_type(2)));
typedef float f32v2_t __attribute__((ext_vector_type(2)));
__device__ __forceinline__ unsigned cvt_pk_bf16(float lo, float hi) { const bf16v2_t r = __builtin_convertvector((f32v2_t){lo, hi}, bf16v2_t); return __builtin_bit_cast(unsigned, r); }
template <class Epi, class Sched, bool STAMP = false>
__device__ __forceinline__ void gemm_phase(PG8_LAS unsigned char* lds, const Gemm g, const Sched& S, const Epi& E, unsigned long long* stamps) {
    const int tid = threadIdx.x, wid = __builtin_amdgcn_readfirstlane(tid >> 6), lane = tid & 63, wr = wid >> 2, wc = wid & 3, fr = lane & 15, fq = lane >> 4;
    const int K = g.K, nt = K / BK;
    int ts_lo = 0, ts_hi = 0, nts = 0; const unsigned long long rt_entry = STAMP ? (unsigned long long)wall_clock64() : 0ull;
#define PG8_STAMP() do { if (STAMP && wid == 0 && nts < 64) { const unsigned long long _c = (unsigned long long)clock64(); \
        ts_lo = (lane == nts) ? (int)(unsigned)_c : ts_lo; ts_hi = (lane == nts) ? (int)(unsigned)(_c >> 32) : ts_hi; ++nts; } } while (0)
    PG8_STAMP();
    unsigned voffA[2], voffB[2];
#pragma unroll
    for (int i = 0; i < 2; ++i) { int R, C; stage_rc(tid * 16 + i * 8192, R, C); const int Rb = Epi::PERM ? ((R & ~31) + perm32(R & 31)) : R;
        voffA[i] = (unsigned)(R * K + C) * 2u; voffB[i] = (unsigned)(Rb * K + C) * 2u; }
    const size_t kstep = (size_t)(BK * 2);
    const size_t hstep = (size_t)HALF * K * 2;
    const size_t tstep = 2 * hstep;
    const unsigned ldsw = (unsigned)wid * 1024u;
    const int aoff = lds_byte(wr * 64 + fr, fq * 8), boff = lds_byte(wc * 32 + fr, fq * 8);
#define PG8_SA(b, h) (((b) * 2 + (h)) * HTB)
#define PG8_SB(b, h) ((4 + (b) * 2 + (h)) * HTB)
#define PG8_STAGE(bufoff, gbase, voff) do { _Pragma("unroll") for (int _i = 0; _i < 2; ++_i) \
        __builtin_amdgcn_global_load_lds((const unsigned*)((const char*)(gbase) + (voff)[_i]), (PG8_LAS unsigned*)(lds + (bufoff) + ldsw + _i * 8192), 16, 0, 0); } while (0)
#define PG8_LDA(dst, b, h) do { _Pragma("unroll") for (int m = 0; m < 4; ++m) _Pragma("unroll") for (int k = 0; k < 2; ++k) dst[m][k] = *(const PG8_LAS bf16x8*)(lds + PG8_SA(b, h) + aoff + m * 2048 + k * 1024); } while (0)
#define PG8_LDB(dst, b, h) do { _Pragma("unroll") for (int n = 0; n < 2; ++n) _Pragma("unroll") for (int k = 0; k < 2; ++k) dst[n][k] = *(const PG8_LAS bf16x8*)(lds + PG8_SB(b, h) + boff + n * 2048 + k * 1024); } while (0)
#define PG8_MMA(ai, bj, At, Bt) do { __builtin_amdgcn_s_setprio(1); _Pragma("unroll") for (int m = 0; m < 4; ++m) _Pragma("unroll") for (int n = 0; n < 2; ++n) _Pragma("unroll") for (int k = 0; k < 2; ++k) \
        acc[ai][bj][m][n] = __builtin_amdgcn_mfma_f32_16x16x32_bf16(Bt[n][k], At[m][k], acc[ai][bj][m][n], 0, 0, 0); __builtin_amdgcn_s_setprio(0); } while (0)
#define PG8_WAIT_V(n) asm volatile("s_waitcnt vmcnt(" #n ")" ::: "memory")
#define PG8_WAIT_L(n) asm volatile("s_waitcnt lgkmcnt(" #n ")" ::: "memory")
#define PG8_BAR __builtin_amdgcn_s_barrier()
#define PG8_SCHED __builtin_amdgcn_sched_barrier(0)
    Unit cur, nxt; int ui = 0;
    if (!S.next(0, cur)) return;
    f32x4 acc[2][2][4][2];
#pragma unroll
    for (int a = 0; a < 2; ++a)
#pragma unroll
        for (int b = 0; b < 2; ++b)
#pragma unroll
            for (int m = 0; m < 4; ++m)
#pragma unroll
                for (int n = 0; n < 2; ++n) acc[a][b][m][n] = (f32x4){0.f, 0.f, 0.f, 0.f};
    bf16x8 At[4][2], B0[2][2], B1[2][2];
    const char* cA = (const char*)g.A + (size_t)cur.pm * tstep; const char* cB = (const char*)g.Bt + (size_t)cur.pn * tstep;
    S.a_ready(cur);
    PG8_STAGE(PG8_SB(0, 0), cB, voffB); PG8_STAGE(PG8_SA(0, 0), cA, voffA); PG8_STAGE(PG8_SB(0, 1), cB + hstep, voffB); PG8_STAGE(PG8_SA(0, 1), cA + hstep, voffA);
    if (wr == 1) PG8_BAR;
    PG8_WAIT_V(4); PG8_BAR;
    PG8_STAGE(PG8_SB(1, 0), cB + kstep, voffB); PG8_STAGE(PG8_SA(1, 0), cA + kstep, voffA); PG8_STAGE(PG8_SB(1, 1), cB + hstep + kstep, voffB);
    PG8_WAIT_V(6); PG8_BAR;
    PG8_STAMP();
    for (;;) {
        const bool has_next = S.next(ui + 1, nxt);
        const char* nA = has_next ? (const char*)g.A + (size_t)nxt.pm * tstep : cA; const char* nB = has_next ? (const char*)g.Bt + (size_t)nxt.pn * tstep : cB;
        for (int t = 0; t < nt; t += 2) {
            const bool last = (t == nt - 2);
            const char* a1 = cA + (size_t)(t + 1) * kstep;
            const char* a2 = last ? nA : cA + (size_t)(t + 2) * kstep; const char* b2 = last ? nB : cB + (size_t)(t + 2) * kstep;
            const char* a3 = a2 + kstep; const char* b3 = b2 + kstep;
            if (last && has_next) S.a_ready(nxt);
            PG8_LDB(B0, 0, 0); PG8_SCHED; PG8_LDA(At, 0, 0); PG8_STAGE(PG8_SA(1, 1), a1 + hstep, voffA);
            PG8_WAIT_L(8); PG8_BAR; PG8_WAIT_L(0); PG8_MMA(0, 0, At, B0); PG8_BAR; PG8_SCHED;
            PG8_LDB(B1, 0, 1); PG8_STAGE(PG8_SB(0, 0), b2, voffB);
            PG8_BAR; PG8_WAIT_L(0); PG8_MMA(0, 1, At, B1); PG8_BAR;
            PG8_LDA(At, 0, 1); PG8_STAGE(PG8_SA(0, 0), a2, voffA);
            PG8_BAR; PG8_WAIT_L(0); PG8_MMA(1, 0, At, B0); PG8_BAR; PG8_SCHED;
            PG8_STAGE(PG8_SB(0, 1), b2 + hstep, voffB);
            PG8_WAIT_V(6); PG8_BAR; PG8_MMA(1, 1, At, B1); PG8_BAR;
            PG8_LDB(B0, 1, 0); PG8_SCHED; PG8_LDA(At, 1, 0); PG8_STAGE(PG8_SA(0, 1), a2 + hstep, voffA);
            PG8_WAIT_L(8); PG8_BAR; PG8_WAIT_L(0); PG8_MMA(0, 0, At, B0); PG8_BAR; PG8_SCHED;
            PG8_LDB(B1, 1, 1); PG8_STAGE(PG8_SB(1, 0), b3, voffB);
            PG8_BAR; PG8_WAIT_L(0); PG8_MMA(0, 1, At, B1); PG8_BAR;
            PG8_LDA(At, 1, 1); PG8_STAGE(PG8_SA(1, 0), a3, voffA);
            PG8_BAR; PG8_WAIT_L(0); PG8_MMA(1, 0, At, B0); PG8_BAR; PG8_SCHED;
            PG8_STAGE(PG8_SB(1, 1), b3 + hstep, voffB);
            PG8_WAIT_V(6); PG8_BAR; PG8_MMA(1, 1, At, B1); PG8_BAR;
        }
        PG8_STAMP();
        if constexpr (!Epi::AFTER_DRAIN) { E(acc, cur, wr, wc, fr, fq); S.done(cur); }
        PG8_STAMP();
        if (!has_next) break;
#pragma unroll
        for (int a = 0; a < 2; ++a)
#pragma unroll
            for (int b = 0; b < 2; ++b)
#pragma unroll
                for (int m = 0; m < 4; ++m)
#pragma unroll
                    for (int n = 0; n < 2; ++n) acc[a][b][m][n] = (f32x4){0.f, 0.f, 0.f, 0.f};
        cur = nxt; cA = nA; cB = nB; ++ui;
    }
    PG8_WAIT_V(0);
    if (wr == 0) PG8_BAR;
    PG8_BAR;
    if constexpr (Epi::AFTER_DRAIN) { E.fused(acc, cur, wr, wc, fr, fq, lds, wid, lane); S.done(cur); }
    PG8_STAMP();
    if (STAMP && wid == 0) { stamps[lane] = lane < nts ? (((unsigned long long)(unsigned)ts_hi << 32) | (unsigned)ts_lo) : 0ull;
        if (lane == 62) stamps[62] = rt_entry; if (lane == 63) stamps[63] = (unsigned long long)wall_clock64(); }
#undef PG8_STAMP
#undef PG8_SA
#undef PG8_SB
#undef PG8_STAGE
#undef PG8_LDA
#undef PG8_LDB
#undef PG8_MMA
#undef PG8_WAIT_V
#undef PG8_WAIT_L
#undef PG8_BAR
#undef PG8_SCHED
}
}

namespace cg = cooperative_groups;
using pg8::bf16_t; using pg8::bf16x8; using pg8::f32x4; using pg8::u32x4; using pg8::Unit; using pg8::cvt_pk_bf16;
typedef unsigned u32x2 __attribute__((ext_vector_type(2)));
#define LAS __attribute__((address_space(3)))
#define LBAR() do { asm volatile("s_waitcnt lgkmcnt(0)" ::: "memory"); __builtin_amdgcn_s_barrier(); asm volatile("" ::: "memory"); } while (0)

constexpr int D = 1024, TSEQ = 2048, NB = 8, MP = NB * TSEQ, MS = 128, MT = MP + MS;
constexpr int RW = 512, NH = 8, SW = 1664, NZ = 4224, NZP = 4352, DP = 256;
constexpr int ZC_S = 2048, ZC_GR = 3712;
constexpr int LDS_BYTES = 159744;

constexpr size_t OFF_WIN = 0;
constexpr size_t OFF_WOUT = OFF_WIN + (size_t)NZP * D * 2;
constexpr size_t OFF_WPG = OFF_WOUT + (size_t)D * D * 2;
constexpr size_t OFF_WPP = OFF_WPG + (size_t)D * D * 2;
constexpr size_t OFF_WUP = OFF_WPP + (size_t)D * DP * 2;
constexpr size_t OFF_AUP = OFF_WUP + (size_t)RW * 64 * 2;
constexpr size_t OFF_RS = OFF_AUP + (size_t)RW * 64 * 2;
constexpr size_t OFF_PB = OFF_RS + (size_t)16640 * 4;
constexpr size_t OFF_Z = OFF_PB + (size_t)MT * DP * 2;
constexpr size_t OFF_SCN = OFF_Z + (size_t)MT * NZ * 2;
constexpr size_t OFF_BAR = OFF_SCN + (size_t)MT * NH * 384 * 2;
constexpr size_t WS_END = OFF_BAR + 16384;
constexpr size_t OFF_H1B = OFF_Z;
constexpr size_t OFF_PPB = OFF_H1B + (size_t)MT * D * 2;
constexpr size_t OFF_H2B = OFF_PPB + (size_t)MT * D * 2;
static_assert(OFF_H2B + (size_t)MT * D * 2 <= OFF_SCN, "overlay");
constexpr size_t PPD_OFF = (size_t)MT * D * 2;
constexpr size_t OFF_CHK = OFF_SCN;
constexpr size_t OFF_SALL = OFF_CHK + (size_t)2048 * 16384 * 2;
constexpr size_t OFF_OS = OFF_SALL + (size_t)2048 * 4096 * 2;
constexpr size_t OFF_SCNS = OFF_OS + (size_t)128 * 512 * 2;
constexpr size_t OFF_RK = OFF_SCNS + (size_t)MS * NH * 384 * 2;
static_assert(OFF_RK + (size_t)2048 * 64 * 4 <= OFF_BAR, "overlay");
constexpr size_t O_Y = 0, O_CONVP = (size_t)MT * D, O_SHIFTP = O_CONVP + 8 * 2 * 512, O_WKVP = O_SHIFTP + 8 * SW,
                 O_CONVS = O_WKVP + 8 * 8 * 64 * 64, O_SHIFTS = O_CONVS + 128 * 2 * 512, O_WKVS = O_SHIFTS + 128 * SW;

struct Args { const float* in[24]; float* out; unsigned char* ws; int ph_lo, ph_hi; };

__device__ __forceinline__ float bf2f(unsigned short b) { return __uint_as_float(((unsigned)b) << 16); }
__device__ __forceinline__ float bflo(unsigned w) { return __uint_as_float(w << 16); }
__device__ __forceinline__ float bfhi(unsigned w) { return __uint_as_float(w & 0xffff0000u); }
__device__ __forceinline__ unsigned short f2bf(float f) { return (unsigned short)(cvt_pk_bf16(f, 0.f) & 0xffffu); }
__device__ __forceinline__ void unpack8(const u32x4 q, float (&f)[8]) {
    f[0] = bflo(q.x); f[1] = bfhi(q.x); f[2] = bflo(q.y); f[3] = bfhi(q.y); f[4] = bflo(q.z); f[5] = bfhi(q.z); f[6] = bflo(q.w); f[7] = bfhi(q.w); }
__device__ __forceinline__ void unpack4(const u32x2 q, float (&f)[4]) { f[0] = bflo(q.x); f[1] = bfhi(q.x); f[2] = bflo(q.y); f[3] = bfhi(q.y); }
__device__ __forceinline__ u32x4 pack8(const float (&f)[8]) { u32x4 q; q.x = cvt_pk_bf16(f[0], f[1]); q.y = cvt_pk_bf16(f[2], f[3]); q.z = cvt_pk_bf16(f[4], f[5]); q.w = cvt_pk_bf16(f[6], f[7]); return q; }
__device__ __forceinline__ u32x2 pack4(float a, float b, float c, float d) { u32x2 q; q.x = cvt_pk_bf16(a, b); q.y = cvt_pk_bf16(c, d); return q; }
__device__ __forceinline__ float sigmoidf_(float x) { return __builtin_amdgcn_rcpf(1.0f + __expf(-x)); }
__device__ __forceinline__ float siluf_(float x) { return x * __builtin_amdgcn_rcpf(1.0f + __expf(-x)); }
template <int CTRL> __device__ __forceinline__ float dppf(float x) { return __int_as_float(__builtin_amdgcn_update_dpp(0, __float_as_int(x), CTRL, 0xf, 0xf, false)); }
__device__ __forceinline__ float rowsum16(float x) { x += dppf<0x128>(x); x += dppf<0x124>(x); x += dppf<0x122>(x); x += dppf<0x121>(x); return x; }

__device__ __forceinline__ f32x4 mini_tile(const bf16_t* arow, const bf16_t* brow, int K, int fq) {
    f32x4 acc = {0.f, 0.f, 0.f, 0.f};
    const bf16_t* ap = arow + fq * 8; const bf16_t* bp = brow + fq * 8;
    for (int k0 = 0; k0 < K; k0 += 256) {
        bf16x8 av[8], bv[8];
#pragma unroll
        for (int j = 0; j < 8; ++j) { av[j] = *(const bf16x8*)(ap + k0 + j * 32); bv[j] = *(const bf16x8*)(bp + k0 + j * 32); }
#pragma unroll
        for (int j = 0; j < 8; ++j) acc = __builtin_amdgcn_mfma_f32_16x16x32_bf16(bv[j], av[j], acc, 0, 0, 0);
    }
    return acc;
}

template <int NSTEP> __device__ __forceinline__ f32x4 mini_tile_k(const bf16_t* arow, const bf16_t* brow, int fq) {
    f32x4 acc = {0.f, 0.f, 0.f, 0.f};
    bf16x8 av[NSTEP], bv[NSTEP];
#pragma unroll
    for (int j = 0; j < NSTEP; ++j) { av[j] = *(const bf16x8*)(arow + fq * 8 + j * 32); bv[j] = *(const bf16x8*)(brow + fq * 8 + j * 32); }
#pragma unroll
    for (int j = 0; j < NSTEP; ++j) acc = __builtin_amdgcn_mfma_f32_16x16x32_bf16(bv[j], av[j], acc, 0, 0, 0);
    return acc;
}
__device__ __forceinline__ f32x4 splitk_reduce(LAS unsigned char* lds, f32x4 acc, int wave, int lane) {
    LAS f32x4* red = (LAS f32x4*)lds;
    __syncthreads();
    red[wave * 64 + lane] = acc;
    __syncthreads();
    if ((wave & 3) == 0) acc = (acc + red[(wave + 1) * 64 + lane]) + (red[(wave + 2) * 64 + lane] + red[(wave + 3) * 64 + lane]);
    return acc;
}

struct EpiZ {
    static constexpr bool PERM = true, AFTER_DRAIN = false;
    bf16_t* Z; const float* rs;
    __device__ __forceinline__ void operator()(const f32x4 (&acc)[2][2][4][2], const Unit& u, int wr, int wc, int fr, int fq) const {
        const int row0 = u.pm * 256 + wr * 64 + fr, col0 = u.pn * 256 + wc * 32 + 8 * fq;
        float sc[2][4];
#pragma unroll
        for (int ai = 0; ai < 2; ++ai)
#pragma unroll
            for (int m = 0; m < 4; ++m) sc[ai][m] = rs[row0 + ai * 128 + m * 16];
#pragma unroll
        for (int ai = 0; ai < 2; ++ai)
#pragma unroll
            for (int m = 0; m < 4; ++m) { const int row = row0 + ai * 128 + m * 16; const float s = sc[ai][m]; bf16_t* rp = Z + (size_t)row * NZ + col0;
#pragma unroll
                for (int bj = 0; bj < 2; ++bj) { if (col0 + bj * 128 < NZ && row < MT) { const f32x4 v0 = acc[ai][bj][m][0] * s, v1 = acc[ai][bj][m][1] * s; u32x4 w;
                    w.x = cvt_pk_bf16(v0[0], v0[1]); w.y = cvt_pk_bf16(v0[2], v0[3]); w.z = cvt_pk_bf16(v1[0], v1[1]); w.w = cvt_pk_bf16(v1[2], v1[3]); *(u32x4*)(rp + bj * 128) = w; } } }
    }
};
struct EpiH1 {
    static constexpr bool PERM = true, AFTER_DRAIN = false;
    const float* x; bf16_t* H1B;
    __device__ __forceinline__ void operator()(const f32x4 (&acc)[2][2][4][2], const Unit& u, int wr, int wc, int fr, int fq) const {
        const int row0 = u.pm * 256 + wr * 64 + fr, col0 = u.pn * 256 + wc * 32 + 8 * fq;
#pragma unroll
        for (int ai = 0; ai < 2; ++ai)
#pragma unroll
            for (int mp = 0; mp < 2; ++mp) {
                f32x4 xv[2][2][2];
#pragma unroll
                for (int mm = 0; mm < 2; ++mm)
#pragma unroll
                    for (int bj = 0; bj < 2; ++bj) { const size_t o = (size_t)(row0 + ai * 128 + (mp * 2 + mm) * 16) * D + col0 + bj * 128; xv[mm][bj][0] = *(const f32x4*)(x + o); xv[mm][bj][1] = *(const f32x4*)(x + o + 4); }
#pragma unroll
                for (int mm = 0; mm < 2; ++mm)
#pragma unroll
                    for (int bj = 0; bj < 2; ++bj) { const int m = mp * 2 + mm; const size_t o = (size_t)(row0 + ai * 128 + m * 16) * D + col0 + bj * 128;
                        const f32x4 v0 = xv[mm][bj][0] + acc[ai][bj][m][0], v1 = xv[mm][bj][1] + acc[ai][bj][m][1]; u32x4 w;
                        w.x = cvt_pk_bf16(v0[0], v0[1]); w.y = cvt_pk_bf16(v0[2], v0[3]); w.z = cvt_pk_bf16(v1[0], v1[1]); w.w = cvt_pk_bf16(v1[2], v1[3]); *(u32x4*)(H1B + o) = w; }
                asm volatile("" ::: "memory"); }
    }
};
struct EpiF32 {
    static constexpr bool PERM = true, AFTER_DRAIN = false;
    bf16_t* C;
    __device__ __forceinline__ void operator()(const f32x4 (&acc)[2][2][4][2], const Unit& u, int wr, int wc, int fr, int fq) const {
        const int row0 = u.pm * 256 + wr * 64 + fr, col0 = u.pn * 256 + wc * 32 + 8 * fq;
#pragma unroll
        for (int ai = 0; ai < 2; ++ai)
#pragma unroll
            for (int m = 0; m < 4; ++m) { const size_t off = (size_t)(row0 + ai * 128 + m * 16) * D + col0;
#pragma unroll
                for (int bj = 0; bj < 2; ++bj) { const f32x4 v0 = acc[ai][bj][m][0], v1 = acc[ai][bj][m][1]; u32x4 w;
                    w.x = cvt_pk_bf16(v0[0], v0[1]); w.y = cvt_pk_bf16(v0[2], v0[3]); w.z = cvt_pk_bf16(v1[0], v1[1]); w.w = cvt_pk_bf16(v1[2], v1[3]); *(u32x4*)(C + off + bj * 128) = w; } }
    }
};
struct EpiH2 {
    static constexpr bool PERM = true, AFTER_DRAIN = false;
    const bf16_t* H1; const bf16_t* PP; bf16_t* out;
    __device__ __forceinline__ void operator()(const f32x4 (&acc)[2][2][4][2], const Unit& u, int wr, int wc, int fr, int fq) const {
        const int row0 = u.pm * 256 + wr * 64 + fr, col0 = u.pn * 256 + wc * 32 + 8 * fq;
#pragma unroll
        for (int ai = 0; ai < 2; ++ai)
#pragma unroll
            for (int mp = 0; mp < 2; ++mp) {
                u32x4 qh[2][2], qp[2][2];
#pragma unroll
                for (int mm = 0; mm < 2; ++mm)
#pragma unroll
                    for (int bj = 0; bj < 2; ++bj) { const size_t o = (size_t)(row0 + ai * 128 + (mp * 2 + mm) * 16) * D + col0 + bj * 128; qh[mm][bj] = *(const u32x4*)(H1 + o); qp[mm][bj] = *(const u32x4*)(PP + o); }
#pragma unroll
                for (int mm = 0; mm < 2; ++mm)
#pragma unroll
                    for (int bj = 0; bj < 2; ++bj) { const int m = mp * 2 + mm; const size_t o = (size_t)(row0 + ai * 128 + m * 16) * D + col0 + bj * 128; float h[8], p[8]; unpack8(qh[mm][bj], h); unpack8(qp[mm][bj], p);
                        const f32x4 g0 = acc[ai][bj][m][0], g1 = acc[ai][bj][m][1]; f32x4 v0, v1;
#pragma unroll
                        for (int e = 0; e < 4; ++e) { v0[e] = h[e] + sigmoidf_(g0[e]) * p[e]; v1[e] = h[4 + e] + sigmoidf_(g1[e]) * p[4 + e]; }
                        u32x4 w; w.x = cvt_pk_bf16(v0[0], v0[1]); w.y = cvt_pk_bf16(v0[2], v0[3]); w.z = cvt_pk_bf16(v1[0], v1[1]); w.w = cvt_pk_bf16(v1[2], v1[3]); *(u32x4*)(out + o) = w; }
                asm volatile("" ::: "memory"); }
    }
};

struct P0Job { const float* src; bf16_t* dst; const float* gsc; int K, N, k0, n0; };
__device__ __forceinline__ P0Job p0_decode(const Args& a, int job) {
    constexpr int NJ_IN = 16 * 68, NJ_SQ = 256, NJ_PP = 64, NJ_LO = 8;
    unsigned char* ws = a.ws; P0Job J; J.gsc = nullptr; int kt, nt; int j = job;
    if (j < NJ_IN) { J.src = a.in[8]; J.dst = (bf16_t*)(ws + OFF_WIN); J.gsc = a.in[7]; J.K = 1024; J.N = NZ; kt = j & 15; nt = j >> 4; }
    else if ((j -= NJ_IN) < NJ_SQ) { J.src = a.in[20]; J.dst = (bf16_t*)(ws + OFF_WOUT); J.K = 1024; J.N = 1024; kt = j & 15; nt = j >> 4; }
    else if ((j -= NJ_SQ) < NJ_SQ) { J.src = a.in[21]; J.dst = (bf16_t*)(ws + OFF_WPG); J.K = 1024; J.N = 1024; kt = j & 15; nt = j >> 4; }
    else if ((j -= NJ_SQ) < NJ_PP) { J.src = a.in[22]; J.dst = (bf16_t*)(ws + OFF_WPP); J.K = 256; J.N = 1024; kt = j & 3; nt = j >> 2; }
    else if ((j -= NJ_PP) < NJ_LO) { J.src = a.in[12]; J.dst = (bf16_t*)(ws + OFF_WUP); J.K = 64; J.N = 512; kt = 0; nt = j; }
    else { j -= NJ_LO; J.src = a.in[14]; J.dst = (bf16_t*)(ws + OFF_AUP); J.K = 64; J.N = 512; kt = 0; nt = j; }
    J.k0 = kt * 64; J.n0 = nt * 64; return J;
}
__device__ void p0_prep(const Args& a, LAS unsigned char* lds) {
    const int tid = threadIdx.x, G = gridDim.x, blk = blockIdx.x, wave = tid >> 6, lane = tid & 63;
    LAS float* tile = (LAS float*)lds;
    unsigned char* ws = a.ws;
    constexpr int NJOBS = 16 * 68 + 2 * 256 + 64 + 2 * 8, MAXJ = 7;
    const int li = tid >> 4, lj = (tid & 15) * 4;
    for (int base = blk; base < NJOBS; base += G * MAXJ) {
        f32x4 v[MAXJ][2];
#pragma unroll
        for (int sl = 0; sl < MAXJ; ++sl) { const int job = base + sl * G;
            if (job < NJOBS) { const P0Job J = p0_decode(a, job);
#pragma unroll
                for (int q = 0; q < 2; ++q) { const int i = li + 32 * q; f32x4 x = {0.f, 0.f, 0.f, 0.f};
                    if (J.n0 + lj < J.N) { x = *(const f32x4*)(J.src + (size_t)(J.k0 + i) * J.N + J.n0 + lj); if (J.gsc) x = x * J.gsc[J.k0 + i]; }
                    v[sl][q] = x; } } }
#pragma unroll
        for (int sl = 0; sl < MAXJ; ++sl) { const int job = base + sl * G;
            if (job < NJOBS) { const P0Job J = p0_decode(a, job);
#pragma unroll
                for (int q = 0; q < 2; ++q) { const int i = li + 32 * q;
#pragma unroll
                    for (int e = 0; e < 4; ++e) tile[i * 65 + lj + e] = v[sl][q][e]; }
                LBAR();
#pragma unroll
                for (int it = 0; it < 4; ++it) { const int item = it * 512 + tid, jj = item >> 5, i2 = item & 31;
                    *(unsigned*)(J.dst + (size_t)(J.n0 + jj) * J.K + J.k0 + 2 * i2) = cvt_pk_bf16(tile[(2 * i2) * 65 + jj], tile[(2 * i2 + 1) * 65 + jj]); }
                LBAR(); } }
    }
    bf16_t* XB = (bf16_t*)a.out; float* RS = (float*)(ws + OFF_RS);
    for (int row0 = (blk * 8 + wave) * 2; row0 < MT; row0 += G * 16) {
        f32x4 v[2][4];
#pragma unroll
        for (int r = 0; r < 2; ++r) { const int row = row0 + r; const float* src = row < MP ? a.in[0] + (size_t)row * D : a.in[1] + (size_t)(row - MP) * D;
#pragma unroll
            for (int i = 0; i < 4; ++i) v[r][i] = *(const f32x4*)(src + i * 256 + lane * 4); }
#pragma unroll
        for (int r = 0; r < 2; ++r) { const int row = row0 + r; float ss = 0.f;
#pragma unroll
            for (int i = 0; i < 4; ++i) { const f32x4 x = v[r][i]; ss += x[0] * x[0] + x[1] * x[1] + x[2] * x[2] + x[3] * x[3];
                *(u32x2*)(XB + (size_t)row * D + i * 256 + lane * 4) = pack4(x[0], x[1], x[2], x[3]); }
#pragma unroll
            for (int o = 32; o >= 1; o >>= 1) ss += __shfl_xor(ss, o);
            if (lane == 0) RS[row] = rsqrtf(ss * (1.0f / D) + 1e-6f); }
    }
    bf16_t* PB = (bf16_t*)(ws + OFF_PB);
    constexpr size_t NP4 = (size_t)MT * DP / 4;
    for (size_t i0 = (size_t)blk * 512 + tid; i0 < NP4; i0 += (size_t)G * 512 * 4) {
        f32x4 v[4];
#pragma unroll
        for (int u = 0; u < 4; ++u) { const size_t i = i0 + (size_t)u * G * 512; const size_t e = i * 4;
            if (i < NP4) v[u] = e < (size_t)MP * DP ? *(const f32x4*)(a.in[2] + e) : *(const f32x4*)(a.in[3] + (e - (size_t)MP * DP)); }
#pragma unroll
        for (int u = 0; u < 4; ++u) { const size_t i = i0 + (size_t)u * G * 512; if (i < NP4) *(u32x2*)(PB + i * 4) = pack4(v[u][0], v[u][1], v[u][2], v[u][3]); }
    }
}

__device__ void p1_gemm_in(const Args& a, LAS unsigned char* lds) {
    const int tid = threadIdx.x, G = gridDim.x, blk = blockIdx.x, wave = tid >> 6, lane = tid & 63, fr = lane & 15, fq = lane >> 4;
    unsigned char* ws = a.ws;
    const bf16_t* XB = (const bf16_t*)a.out; const bf16_t* WinT = (const bf16_t*)(ws + OFF_WIN); const float* RS = (const float*)(ws + OFF_RS); bf16_t* Z = (bf16_t*)(ws + OFF_Z);
    {
        pg8::Gemm g{XB, WinT, MP + 256, NZP, D}; pg8::StaticOrder S; S.init(MP + 256, NZP, G, blk); EpiZ E{Z, RS};
        pg8::gemm_phase<EpiZ, pg8::StaticOrder>(lds, g, S, E, nullptr);
    }
    const bool r256 = (G == 256);
    if (!r256 || blk >= 81) {
        const bf16_t* PB = (const bf16_t*)(ws + OFF_PB); const bf16_t* WppT = (const bf16_t*)(ws + OFF_WPP); bf16_t* PP = (bf16_t*)((unsigned char*)a.out + PPD_OFF);
        pg8::Gemm g{PB, WppT, MP, D, DP}; pg8::StaticOrder S; S.init(MP, D, r256 ? 175 : G, r256 ? blk - 81 : blk); EpiF32 E{PP};
        pg8::gemm_phase<EpiF32, pg8::StaticOrder>(lds, g, S, E, nullptr);
    }
}

template <bool smp> __device__ void p2_tile(const Args& a, LAS unsigned char* lds, int tile) {
    const int tid = threadIdx.x, wave = tid >> 6, lane = tid & 63, fr = lane & 15, fq = lane >> 4;
    unsigned char* ws = a.ws;
    const int ntok = smp ? 8 : 64;
    const int m0 = smp ? MP + (tile - 256) * 8 : tile * 64;
    const int t0 = smp ? 0 : (tile & 31) * 64;
    const int bidx = tile >> 5;
    const bf16_t* __restrict__ Z = (const bf16_t*)(ws + OFF_Z); bf16_t* __restrict__ YC = (bf16_t*)a.out; bf16_t* __restrict__ SCN = (bf16_t*)(ws + OFF_SCNS) - (size_t)MP * 8 * 384;
    const float* state_conv = a.in[4]; const float* state_shift = a.in[5]; const float* conv_w = a.in[9]; const float* mu = a.in[10];
    {
        const int c0 = (tid & 63) * 8;
        float cw0[8], cw1[8], cw2[8];
#pragma unroll
        for (int i = 0; i < 8; ++i) { cw0[i] = conv_w[c0 + i]; cw1[i] = conv_w[512 + c0 + i]; cw2[i] = conv_w[1024 + c0 + i]; }
#pragma unroll 2
        for (int tok = tid >> 6; tok < ntok; tok += 8) {
            const int m = m0 + tok, t = t0 + tok;
            const bf16_t* zr = Z + (size_t)m * NZ;
            float fB[8], fC[8], fH[8], fG[8], u0[8], u1[8], u2[8];
            const u32x4 qB = *(const u32x4*)(zr + c0), qC = *(const u32x4*)(zr + 512 + c0), qH = *(const u32x4*)(zr + 1024 + c0), qG = *(const u32x4*)(zr + 1536 + c0);
            if (smp) {
                const float* sc = state_conv + (size_t)(m - MP) * 1024 + c0;
                const f32x4 x0 = *(const f32x4*)(sc), x1 = *(const f32x4*)(sc + 4), y0 = *(const f32x4*)(sc + 512), y1 = *(const f32x4*)(sc + 516);
#pragma unroll
                for (int i = 0; i < 4; ++i) { u2[i] = x0[i]; u2[4 + i] = x1[i]; u1[i] = y0[i]; u1[4 + i] = y1[i]; }
            } else {
                const bf16_t* z1 = t >= 1 ? zr - NZ : zr; const bf16_t* z2 = t >= 2 ? zr - 2 * NZ : zr;
                const u32x4 qC1 = *(const u32x4*)(z1 + 512 + c0), qH1 = *(const u32x4*)(z1 + 1024 + c0), qC2 = *(const u32x4*)(z2 + 512 + c0), qH2 = *(const u32x4*)(z2 + 1024 + c0);
                float c1[8], h1[8], c2[8], h2[8]; unpack8(qC1, c1); unpack8(qH1, h1); unpack8(qC2, c2); unpack8(qH2, h2);
                const float f1 = t >= 1 ? 1.f : 0.f, f2 = t >= 2 ? 1.f : 0.f;
#pragma unroll
                for (int i = 0; i < 8; ++i) { u1[i] = c1[i] * h1[i] * f1; u2[i] = c2[i] * h2[i] * f2; }
            }
            unpack8(qB, fB); unpack8(qC, fC); unpack8(qH, fH); unpack8(qG, fG);
            float y[8];
#pragma unroll
            for (int i = 0; i < 8; ++i) { u0[i] = fC[i] * fH[i]; const float cv = cw0[i] * u2[i] + cw1[i] * u1[i] + cw2[i] * u0[i]; y[i] = fB[i] * cv * siluf_(fG[i]); }
            *(u32x4*)(YC + (size_t)m * D + c0) = pack8(y);
            { float gr[8]; unpack8(*(const u32x4*)(zr + ZC_GR + c0), gr);
#pragma unroll
              for (int i = 0; i < 8; ++i) gr[i] = siluf_(gr[i]);
              *(u32x4*)(YC + (size_t)m * D + 512 + c0) = pack8(gr); }
            float* co = nullptr;
            if (smp) co = a.out + O_CONVS + (size_t)(m - MP) * 1024 + c0; else if (t == TSEQ - 1) co = a.out + O_CONVP + (size_t)bidx * 1024 + c0;
            if (co) {
                *(f32x4*)(co) = (f32x4){u1[0], u1[1], u1[2], u1[3]}; *(f32x4*)(co + 4) = (f32x4){u1[4], u1[5], u1[6], u1[7]};
                *(f32x4*)(co + 512) = (f32x4){u0[0], u0[1], u0[2], u0[3]}; *(f32x4*)(co + 516) = (f32x4){u0[4], u0[5], u0[6], u0[7]}; }
        }
    }
    LAS bf16_t* Awd = (LAS bf16_t*)lds; LAS bf16_t* Aad = Awd + 64 * 72;
    if (smp) {
        const int j0 = (tid & 15) * 8;
        f32x4 m0v = *(const f32x4*)(mu + 1536 + j0), m1v = *(const f32x4*)(mu + 1536 + j0 + 4);
#pragma unroll 2
        for (int tok = tid >> 4; tok < ntok; tok += 32) {
            const int m = m0 + tok;
            const bf16_t* zr = Z + (size_t)m * NZ + ZC_S + 1536 + j0;
            float cur[8], prev[8], zm[8];
            unpack8(*(const u32x4*)zr, cur);
            if (smp) { const float* sp = state_shift + (size_t)(m - MP) * SW + 1536 + j0; const f32x4 x0 = *(const f32x4*)sp, x1 = *(const f32x4*)(sp + 4);
#pragma unroll
                for (int i = 0; i < 4; ++i) { prev[i] = x0[i]; prev[4 + i] = x1[i]; } }
            else { const bool hp = (t0 + tok) >= 1; unpack8(*(const u32x4*)(hp ? zr - NZ : zr), prev);
                if (!hp) {
#pragma unroll
                    for (int i = 0; i < 8; ++i) prev[i] = 0.f; } }
#pragma unroll
            for (int i = 0; i < 8; ++i) { const float mm = i < 4 ? m0v[i] : m1v[i - 4]; zm[i] = cur[i] + (prev[i] - cur[i]) * mm; }
            if (j0 < 64) {
#pragma unroll
                for (int i = 0; i < 8; ++i) { const float e2 = __expf(2.0f * zm[i]); zm[i] = 1.0f - 2.0f * __builtin_amdgcn_rcpf(e2 + 1.0f); }
                *(LAS u32x4*)(Awd + tok * 72 + j0) = pack8(zm);
            } else *(LAS u32x4*)(Aad + tok * 72 + (j0 - 64)) = pack8(zm);
        }
    }
    __syncthreads();
    if (smp) {
        const int h = wave;
        const bf16_t* WupT = (const bf16_t*)(ws + OFF_WUP); const bf16_t* AupT = (const bf16_t*)(ws + OFF_AUP);
        const float* __restrict__ w0 = a.in[11]; const float* __restrict__ a0p = a.in[13]; const float* __restrict__ k_k = a.in[15]; const float* __restrict__ k_a = a.in[16];
        const int nmt = (ntok + 15) >> 4;
#pragma unroll 1
        for (int mt = 0; mt < nmt; ++mt) {
            u32x2 zc[4][3], zq[4][3];
            {   const int tok_ = (mt * 16 + fr) < ntok ? (mt * 16 + fr) : 0; const bf16_t* zr_ = Z + (size_t)(m0 + tok_) * NZ + ZC_S; const bf16_t* zp_ = ((!smp) && (t0 + tok_ >= 1)) ? zr_ - NZ : zr_;
#pragma unroll
                for (int nt = 0; nt < 4; ++nt) { const int c = h * 64 + nt * 16 + 4 * fq;
                    zc[nt][0] = *(const u32x2*)(zr_ + c); zc[nt][1] = *(const u32x2*)(zr_ + 512 + c); zc[nt][2] = *(const u32x2*)(zr_ + 1024 + c);
                    if (!smp) { zq[nt][0] = *(const u32x2*)(zp_ + c); zq[nt][1] = *(const u32x2*)(zp_ + 512 + c); zq[nt][2] = *(const u32x2*)(zp_ + 1024 + c); } } }
            bf16x8 aw[2], aa[2];
#pragma unroll
            for (int ks = 0; ks < 2; ++ks) { aw[ks] = *(const LAS bf16x8*)(Awd + (mt * 16 + fr) * 72 + ks * 32 + fq * 8); aa[ks] = *(const LAS bf16x8*)(Aad + (mt * 16 + fr) * 72 + ks * 32 + fq * 8); }
            f32x4 accw[4], acca[4];
#pragma unroll
            for (int nt = 0; nt < 4; ++nt) { accw[nt] = (f32x4){0.f, 0.f, 0.f, 0.f}; acca[nt] = (f32x4){0.f, 0.f, 0.f, 0.f};
#pragma unroll
                for (int ks = 0; ks < 2; ++ks) { const size_t bo = (size_t)(h * 64 + nt * 16 + fr) * 64 + ks * 32 + fq * 8;
                    accw[nt] = __builtin_amdgcn_mfma_f32_16x16x32_bf16(*(const bf16x8*)(WupT + bo), aw[ks], accw[nt], 0, 0, 0);
                    acca[nt] = __builtin_amdgcn_mfma_f32_16x16x32_bf16(*(const bf16x8*)(AupT + bo), aa[ks], acca[nt], 0, 0, 0); } }
            const bool valid = (mt * 16 + fr) < ntok;
            const int tok = valid ? (mt * 16 + fr) : 0, m = m0 + tok, t = t0 + tok;
            const bf16_t* zr = Z + (size_t)m * NZ + ZC_S;
            const bool hasprev = (!smp) && (t >= 1);
            const bf16_t* zp = hasprev ? zr - NZ : zr;
            const float fp = hasprev ? 1.f : 0.f;
            bf16_t* so = SCN + ((size_t)m * 8 + h) * 384 + 4 * fq;
            float kk[4][4], av[4][4]; float ss = 0.f;
#pragma unroll
            for (int nt = 0; nt < 4; ++nt) {
                const int c = h * 64 + nt * 16 + 4 * fq;
                float cr[4], ck[4], cv[4], pr[4], pk[4], pv[4];
                unpack4(zc[nt][0], cr); unpack4(zc[nt][1], ck); unpack4(zc[nt][2], cv);
                if (smp) { const float* sp = state_shift + (size_t)(m - MP) * SW + c; const f32x4 x0 = *(const f32x4*)sp, x1 = *(const f32x4*)(sp + 512), x2 = *(const f32x4*)(sp + 1024);
#pragma unroll
                    for (int i = 0; i < 4; ++i) { pr[i] = x0[i]; pk[i] = x1[i]; pv[i] = x2[i]; } }
                else { unpack4(zq[nt][0], pr); unpack4(zq[nt][1], pk); unpack4(zq[nt][2], pv);
#pragma unroll
                    for (int i = 0; i < 4; ++i) { pr[i] *= fp; pk[i] *= fp; pv[i] *= fp; } }
                const f32x4 mr = *(const f32x4*)(mu + c), mk = *(const f32x4*)(mu + 512 + c), mv = *(const f32x4*)(mu + 1024 + c);
                const f32x4 w0v = *(const f32x4*)(w0 + c), a0v = *(const f32x4*)(a0p + c), kkv = *(const f32x4*)(k_k + c), kav = *(const f32x4*)(k_a + c);
                float r_[4], e_[4], kp[4], v_[4];
#pragma unroll
                for (int i = 0; i < 4; ++i) {
                    r_[i] = cr[i] + (pr[i] - cr[i]) * mr[i]; const float k = ck[i] + (pk[i] - ck[i]) * mk[i]; v_[i] = cv[i] + (pv[i] - cv[i]) * mv[i];
                    e_[i] = 0.60653065971f * sigmoidf_(w0v[i] + accw[nt][i]);
                    const float al = sigmoidf_(a0v[i] + acca[nt][i]); av[nt][i] = al;
                    const float kq = k * kkv[i]; kk[nt][i] = kq; ss += kq * kq;
                    kp[i] = k * (1.0f + (al - 1.0f) * kav[i]);
                }
                if (valid) {
                *(u32x2*)(so + 0 * 64 + nt * 16) = pack4(r_[0], r_[1], r_[2], r_[3]);
                *(u32x2*)(so + 1 * 64 + nt * 16) = pack4(e_[0], e_[1], e_[2], e_[3]);
                *(u32x2*)(so + 2 * 64 + nt * 16) = pack4(kp[0], kp[1], kp[2], kp[3]);
                *(u32x2*)(so + 3 * 64 + nt * 16) = pack4(v_[0], v_[1], v_[2], v_[3]); }
            }
            ss += __shfl_xor(ss, 16); ss += __shfl_xor(ss, 32);
            const float inv = 1.0f / fmaxf(sqrtf(ss), 1e-12f);
#pragma unroll
            for (int nt = 0; nt < 4; ++nt) {
                float q[4], b[4];
#pragma unroll
                for (int i = 0; i < 4; ++i) { q[i] = kk[nt][i] * inv; b[i] = q[i] * av[nt][i]; }
                if (valid) {
                *(u32x2*)(so + 4 * 64 + nt * 16) = pack4(q[0], q[1], q[2], q[3]);
                *(u32x2*)(so + 5 * 64 + nt * 16) = pack4(b[0], b[1], b[2], b[3]); }
            }
        }
    }
    if (!smp && (tile & 31) == 31) { for (int j = tid; j < SW; j += 512) a.out[O_SHIFTP + (size_t)bidx * SW + j] = bf2f(Z[(size_t)(m0 + 63) * NZ + ZC_S + j]); }
    __syncthreads();
}
__device__ void p2_all(const Args& a, LAS unsigned char* lds) {
    const int tid = threadIdx.x, G = gridDim.x, blk = blockIdx.x;
    for (int t = blk; t < 272; t += G) { if (t < 256) p2_tile<false>(a, lds, t); else p2_tile<true>(a, lds, t); }
    const bf16_t* Z = (const bf16_t*)(a.ws + OFF_Z);
    for (int idx = blk * 512 + tid; idx < MS * SW; idx += G * 512) { const int sidx = idx / SW, j = idx - sidx * SW; a.out[O_SHIFTS + idx] = bf2f(Z[(size_t)(MP + sidx) * NZ + ZC_S + j]); }
}

constexpr int SLOT = 64 * 72;
__device__ __forceinline__ void mm_nt(const LAS bf16_t* X, const LAS bf16_t* Y, int it, int jt0, int fr, int fq, f32x4 (&acc)[2]) {
    bf16x8 xa[2];
#pragma unroll
    for (int ks = 0; ks < 2; ++ks) xa[ks] = *(const LAS bf16x8*)(X + (it * 16 + fr) * 72 + ks * 32 + fq * 8);
#pragma unroll
    for (int u = 0; u < 2; ++u)
#pragma unroll
        for (int ks = 0; ks < 2; ++ks) acc[u] = __builtin_amdgcn_mfma_f32_16x16x32_bf16(*(const LAS bf16x8*)(Y + ((jt0 + u) * 16 + fr) * 72 + ks * 32 + fq * 8), xa[ks], acc[u], 0, 0, 0);
}
template <int MASK> __device__ __forceinline__ f32x4 mask4(f32x4 v, int i, int j0) {
#pragma unroll
    for (int e = 0; e < 4; ++e) { const int j = j0 + e; const bool keep = MASK == 0 ? true : MASK == 1 ? (j < i) : MASK == 2 ? (j > i) : (j <= i); v[e] = keep ? v[e] : 0.f; }
    return v;
}
__device__ __forceinline__ void st4(LAS bf16_t* dst, int i, int j0, f32x4 v) { *(LAS u32x2*)(dst + i * 72 + j0) = pack4(v[0], v[1], v[2], v[3]); }
__device__ __forceinline__ f32x4 ld4(const LAS bf16_t* src, int i, int j0) { float f[4]; unpack4(*(const LAS u32x2*)(src + i * 72 + j0), f); return (f32x4){f[0], f[1], f[2], f[3]}; }
__device__ __forceinline__ void st4t(LAS bf16_t* dst, int i, int j0, f32x4 v) {
    const unsigned lo = cvt_pk_bf16(v[0], v[1]), hi = cvt_pk_bf16(v[2], v[3]);
    dst[(j0 + 0) * 72 + i] = (bf16_t)(lo & 0xffffu); dst[(j0 + 1) * 72 + i] = (bf16_t)(lo >> 16); dst[(j0 + 2) * 72 + i] = (bf16_t)(hi & 0xffffu); dst[(j0 + 3) * 72 + i] = (bf16_t)(hi >> 16); }
__device__ __forceinline__ void stg4(bf16_t* dst, int i, int j0, f32x4 v) { *(u32x2*)(dst + i * 64 + j0) = pack4(v[0], v[1], v[2], v[3]); }
#define ZACC() do { acc[0] = (f32x4){0.f, 0.f, 0.f, 0.f}; acc[1] = (f32x4){0.f, 0.f, 0.f, 0.f}; } while (0)

__device__ void p3a_chunks(const Args& a, LAS unsigned char* lds) {
    const int tid = threadIdx.x, G = gridDim.x, blk = blockIdx.x, wave = tid >> 6, lane = tid & 63, fr = lane & 15, fq = lane >> 4;
    unsigned char* ws = a.ws;
    const bf16_t* SCN = (const bf16_t*)(ws + OFF_SCNS) - (size_t)MP * 8 * 384;
    bf16_t* CHK = (bf16_t*)(ws + OFF_CHK); const bf16_t* Z = (const bf16_t*)(ws + OFF_Z); float* RK = (float*)(ws + OFF_RK);
    const bf16_t* WupT = (const bf16_t*)(ws + OFF_WUP); const bf16_t* AupT = (const bf16_t*)(ws + OFF_AUP);
    LAS bf16_t* SL = (LAS bf16_t*)lds;
#define S_(n) (SL + (n) * SLOT)
    LAS bf16_t* zraw = S_(8);
    LAS float* tot = (LAS float*)(lds + 17 * SLOT * 2);
    LAS float* pc = tot + 512;
    LAS float* LWf = (LAS float*)(lds + 2 * SLOT * 2);
    LAS float* LAf = (LAS float*)(lds + 4 * SLOT * 2);
    const int it = wave >> 1, jt0 = (wave & 1) * 2, irow = it * 16 + fr;
    u32x4 rg[6];
#define P3A_LOAD(unit_) do { const int bh_ = (unit_) >> 5, c_ = (unit_) & 31; const int mm0 = (bh_ >> 3) * TSEQ + c_ * 64; const int hh = bh_ & 7; \
        _Pragma("unroll") for (int i = 0; i < 6; ++i) { const int p = tid + 512 * i; if (p < 65 * 40) { const int rr = p / 40, sg = p - rr * 40, seg = sg >> 3, o8 = sg & 7; \
            const int col = seg < 3 ? (ZC_S + seg * 512 + hh * 64) : (ZC_S + 1536 + (seg - 3) * 64); const int mrow = (rr == 0 && c_ == 0) ? mm0 : (mm0 - 1 + rr); \
            rg[i] = *(const u32x4*)(Z + (size_t)mrow * NZ + col + o8 * 8); } } } while (0)
    if (blk < 2048) P3A_LOAD(blk);
    int hcur = -1;
    float mur = 0.f, muk = 0.f, muv = 0.f, muwd = 0.f, muad = 0.f, w0k = 0.f, a0k = 0.f, kkk = 0.f, kak = 0.f, rkk = 0.f;
    for (int unit = blk; unit < 2048; unit += G) {
        const int h = (unit >> 5) & 7, c = unit & 31, k = tid & 63, g = tid >> 6;
        if (h != hcur) {
            const float* mu = a.in[10];
            mur = mu[h * 64 + k]; muk = mu[512 + h * 64 + k]; muv = mu[1024 + h * 64 + k]; muwd = mu[1536 + k]; muad = mu[1600 + k];
            w0k = a.in[11][h * 64 + k]; a0k = a.in[13][h * 64 + k]; kkk = a.in[15][h * 64 + k]; kak = a.in[16][h * 64 + k]; rkk = a.in[17][h * 64 + k];
            const int row = tid >> 3, o8 = tid & 7;
            *(LAS u32x4*)(S_(15) + row * 72 + o8 * 8) = *(const u32x4*)(WupT + (size_t)(h * 64 + row) * 64 + o8 * 8);
            *(LAS u32x4*)(S_(16) + row * 72 + o8 * 8) = *(const u32x4*)(AupT + (size_t)(h * 64 + row) * 64 + o8 * 8);
            hcur = h; }
#pragma unroll
        for (int i = 0; i < 6; ++i) { const int p = tid + 512 * i; if (p < 65 * 40) { const int rr = p / 40, sg = p - rr * 40, seg = sg >> 3, o8 = sg & 7; *(LAS u32x4*)(zraw + rr * 320 + seg * 64 + o8 * 8) = rg[i]; } }
        LBAR();
        float r_[8], kx[8], v_[8];
        {
            const float fp0 = (c != 0) ? 1.f : 0.f;
            float zz[9][5];
#pragma unroll
            for (int rr = 0; rr < 9; ++rr) { const LAS bf16_t* zp_ = zraw + (g * 8 + rr) * 320 + k;
#pragma unroll
                for (int sg = 0; sg < 5; ++sg) zz[rr][sg] = bf2f(zp_[sg * 64]); }
            if (g == 0) {
#pragma unroll
                for (int sg = 0; sg < 5; ++sg) zz[0][sg] *= fp0; }
#pragma unroll
            for (int j = 0; j < 8; ++j) { const int t = g * 8 + j;
                const float c0 = zz[j + 1][0], c1 = zz[j + 1][1], c2 = zz[j + 1][2], c3 = zz[j + 1][3], c4 = zz[j + 1][4];
                const float p0 = zz[j][0], p1 = zz[j][1], p2 = zz[j][2], p3 = zz[j][3], p4 = zz[j][4];
                r_[j] = c0 + (p0 - c0) * mur; kx[j] = c1 + (p1 - c1) * muk; v_[j] = c2 + (p2 - c2) * muv;
                const float wd = c3 + (p3 - c3) * muwd, ad = c4 + (p4 - c4) * muad;
                const float e2 = __expf(2.0f * wd);
                S_(0)[t * 72 + k] = f2bf(1.0f - 2.0f * __builtin_amdgcn_rcpf(e2 + 1.0f)); S_(1)[t * 72 + k] = f2bf(ad); }
        }
        LBAR();
        f32x4 acc[2];
        ZACC(); mm_nt(S_(0), S_(15), it, jt0, fr, fq, acc);
#pragma unroll
        for (int u = 0; u < 2; ++u) *(LAS f32x4*)(LWf + irow * 64 + (jt0 + u) * 16 + 4 * fq) = acc[u];
        ZACC(); mm_nt(S_(1), S_(16), it, jt0, fr, fq, acc);
#pragma unroll
        for (int u = 0; u < 2; ++u) *(LAS f32x4*)(LAf + irow * 64 + (jt0 + u) * 16 + 4 * fq) = acc[u];
        LBAR();
        {
            float ev[8], cs[8], qn[8], bbv[8], kpv[8]; float run = 0.f;
#pragma unroll
            for (int j = 0; j < 8; ++j) { const int t = g * 8 + j;
                const float e = 0.60653065971f * sigmoidf_(w0k + LWf[t * 64 + k]); const float al = sigmoidf_(a0k + LAf[t * 64 + k]);
                const float kq = kx[j] * kkk, kp = kx[j] * (1.0f + (al - 1.0f) * kak);
                float ss = kq * kq, rs_ = r_[j] * kp * rkk;
                ss = rowsum16(ss); rs_ = rowsum16(rs_);
                ss += __shfl_xor(ss, 16); rs_ += __shfl_xor(rs_, 16); ss += __shfl_xor(ss, 32); rs_ += __shfl_xor(rs_, 32);
                const float inv = __builtin_amdgcn_rsqf(fmaxf(ss, 1e-24f));
                qn[j] = kq * inv; bbv[j] = qn[j] * al; kpv[j] = kp;
                if (lane == 0) RK[(size_t)unit * 64 + t] = rs_;
                ev[j] = e; run += e; cs[j] = run; }
            tot[g * 64 + k] = run;
            LBAR();
            float off = 0.f;
#pragma unroll
            for (int gg = 0; gg < 7; ++gg) { const float tv = tot[gg * 64 + k]; off += gg < g ? tv : 0.f; }
            float ak[8], bk[8], kk_[8];
#pragma unroll
            for (int j = 0; j < 8; ++j) { const int t = g * 8 + j; const float cum = off + cs[j];
                const float P = __expf(-cum), Pm1 = __expf(ev[j] - cum), iP = __builtin_amdgcn_rcpf(P);
                const float at = -qn[j] * Pm1, bt = bbv[j] * iP, kt = kpv[j] * iP, rt = r_[j] * P;
                S_(0)[t * 72 + k] = f2bf(at); S_(1)[t * 72 + k] = f2bf(bt); S_(2)[t * 72 + k] = f2bf(kt); S_(3)[t * 72 + k] = f2bf(rt);
                ak[j] = at; bk[j] = bt; kk_[j] = kt;
                if (j == 7 && g == 7) pc[k] = P; }
            *(LAS u32x4*)(S_(4) + k * 72 + g * 8) = pack8(ak); *(LAS u32x4*)(S_(5) + k * 72 + g * 8) = pack8(bk);
            *(LAS u32x4*)(S_(6) + k * 72 + g * 8) = pack8(kk_); *(LAS u32x4*)(S_(7) + k * 72 + g * 8) = pack8(v_);
        }
        LBAR();
        { const int nxt = (unit + G < 2048) ? unit + G : unit; P3A_LOAD(nxt); }
        ZACC(); mm_nt(S_(0), S_(1), it, jt0, fr, fq, acc);
#pragma unroll
        for (int u = 0; u < 2; ++u) { const int j0 = (jt0 + u) * 16 + 4 * fq; f32x4 v = mask4<1>(acc[u], irow, j0); st4(S_(11), irow, j0, v); st4t(S_(12), irow, j0, v);
#pragma unroll
            for (int e = 0; e < 4; ++e) v[e] += (j0 + e == irow) ? 1.f : 0.f;
            st4(S_(13), irow, j0, v); }
        ZACC(); mm_nt(S_(0), S_(2), it, jt0, fr, fq, acc);
#pragma unroll
        for (int u = 0; u < 2; ++u) { const int j0 = (jt0 + u) * 16 + 4 * fq; st4(S_(8), irow, j0, mask4<1>(acc[u], irow, j0)); }
        ZACC(); mm_nt(S_(3), S_(1), it, jt0, fr, fq, acc);
#pragma unroll
        for (int u = 0; u < 2; ++u) { const int j0 = (jt0 + u) * 16 + 4 * fq; st4(S_(9), irow, j0, mask4<3>(acc[u], irow, j0)); }
        ZACC(); mm_nt(S_(3), S_(2), it, jt0, fr, fq, acc);
#pragma unroll
        for (int u = 0; u < 2; ++u) { const int j0 = (jt0 + u) * 16 + 4 * fq; st4(S_(10), irow, j0, mask4<3>(acc[u], irow, j0)); }
        LBAR();
        ZACC(); mm_nt(S_(11), S_(12), it, jt0, fr, fq, acc);
#pragma unroll
        for (int u = 0; u < 2; ++u) { st4(S_(1), irow, (jt0 + u) * 16 + 4 * fq, acc[u]); st4t(S_(2), irow, (jt0 + u) * 16 + 4 * fq, acc[u]); }
        ZACC(); mm_nt(S_(7), S_(8), it, jt0, fr, fq, acc);
#pragma unroll
        for (int u = 0; u < 2; ++u) st4(S_(0), irow, (jt0 + u) * 16 + 4 * fq, acc[u]);
        LBAR();
#pragma unroll
        for (int sgi = 0; sgi < 4; ++sgi) {
            const int pa = (sgi & 1) ? 11 : 1, pta = (sgi & 1) ? 12 : 2, pb = (sgi & 1) ? 1 : 11, ptb = (sgi & 1) ? 2 : 12, tla = (sgi & 1) ? 14 : 13, tlb = (sgi & 1) ? 13 : 14;
            ZACC(); mm_nt(S_(tla), S_(pta), it, jt0, fr, fq, acc);
#pragma unroll
            for (int u = 0; u < 2; ++u) { const int j0 = (jt0 + u) * 16 + 4 * fq; st4(S_(tlb), irow, j0, acc[u] + ld4(S_(tla), irow, j0)); }
            ZACC(); mm_nt(S_(pa), S_(pta), it, jt0, fr, fq, acc);
#pragma unroll
            for (int u = 0; u < 2; ++u) { if (sgi < 3) st4(S_(pb), irow, (jt0 + u) * 16 + 4 * fq, acc[u]); st4t(S_(ptb), irow, (jt0 + u) * 16 + 4 * fq, acc[u]); }
            LBAR();
        }
        ZACC(); mm_nt(S_(13), S_(2), it, jt0, fr, fq, acc);
#pragma unroll
        for (int u = 0; u < 2; ++u) { const int j0 = (jt0 + u) * 16 + 4 * fq; st4(S_(14), irow, j0, acc[u] + ld4(S_(13), irow, j0)); }
        LBAR();
        ZACC(); mm_nt(S_(0), S_(14), it, jt0, fr, fq, acc);
#pragma unroll
        for (int u = 0; u < 2; ++u) st4(S_(1), irow, (jt0 + u) * 16 + 4 * fq, acc[u]);
        ZACC(); mm_nt(S_(4), S_(14), it, jt0, fr, fq, acc);
#pragma unroll
        for (int u = 0; u < 2; ++u) st4(S_(2), irow, (jt0 + u) * 16 + 4 * fq, acc[u]);
        LBAR();
        bf16_t* chk = CHK + (size_t)unit * 16384;
        ZACC();
        mm_nt(S_(9), S_(2), it, jt0, fr, fq, acc);
#pragma unroll
        for (int u = 0; u < 2; ++u) { const int j0 = (jt0 + u) * 16 + 4 * fq; stg4(chk, irow, j0, acc[u] + ld4(S_(3), irow, j0)); }
        ZACC();
        mm_nt(S_(9), S_(1), it, jt0, fr, fq, acc);
        mm_nt(S_(10), S_(7), it, jt0, fr, fq, acc);
#pragma unroll
        for (int u = 0; u < 2; ++u) stg4(chk + 4096, irow, (jt0 + u) * 16 + 4 * fq, acc[u]);
        ZACC();
        mm_nt(S_(1), S_(5), it, jt0, fr, fq, acc);
        mm_nt(S_(7), S_(6), it, jt0, fr, fq, acc);
#pragma unroll
        for (int u = 0; u < 2; ++u) { const int j0 = (jt0 + u) * 16 + 4 * fq; const f32x4 pv = *(const LAS f32x4*)(pc + j0); stg4(chk + 8192, irow, j0, acc[u] * pv); }
        ZACC();
        mm_nt(S_(5), S_(2), it, jt0, fr, fq, acc);
        { const float pr = pc[irow];
#pragma unroll
          for (int u = 0; u < 2; ++u) { const int j0 = (jt0 + u) * 16 + 4 * fq; f32x4 v = acc[u];
#pragma unroll
              for (int e = 0; e < 4; ++e) v[e] = (v[e] + ((j0 + e == irow) ? 1.f : 0.f)) * pr;
              stg4(chk + 12288, irow, j0, v); } }
        LBAR();
    }
#undef P3A_LOAD
#undef S_
}

__device__ void p3_sample_step(const Args& a, int blk, int G) {
    const int tid = threadIdx.x;
    unsigned char* ws = a.ws;
    const bf16_t* SCN = (const bf16_t*)(ws + OFF_SCNS) - (size_t)MP * 8 * 384;
    const float* state_wkv = a.in[6]; bf16_t* OS = (bf16_t*)(ws + OFF_OS);
    const int row = tid >> 3, c0 = (tid & 7) * 8;
    constexpr int NI = 4;
    for (int it0 = blk; it0 < MS * NH; it0 += G * NI) {
        u32x4 q[NI][5]; f32x4 sA[NI], sB[NI]; unsigned short vq[NI];
#pragma unroll
        for (int n = 0; n < NI; ++n) { const int itn = (it0 + n * G < MS * NH) ? it0 + n * G : it0; const int s_ = itn >> 3, h = itn & 7, m = MP + s_;
            const bf16_t* sc = SCN + ((size_t)m * 8 + h) * 384; const size_t so = ((size_t)(s_ * 8 + h) * 64 + row) * 64 + c0;
            q[n][0] = *(const u32x4*)(sc + c0); q[n][1] = *(const u32x4*)(sc + 64 + c0); q[n][2] = *(const u32x4*)(sc + 128 + c0); q[n][3] = *(const u32x4*)(sc + 256 + c0); q[n][4] = *(const u32x4*)(sc + 320 + c0);
            vq[n] = sc[192 + row]; sA[n] = *(const f32x4*)(state_wkv + so); sB[n] = *(const f32x4*)(state_wkv + so + 4); }
#pragma unroll
        for (int n = 0; n < NI; ++n) { const int itn = it0 + n * G; if (itn < MS * NH) { const int s_ = itn >> 3, h = itn & 7;
            float r_[8], e_[8], kp[8], kq[8], bb[8];
            unpack8(q[n][0], r_); unpack8(q[n][1], e_); unpack8(q[n][2], kp); unpack8(q[n][3], kq); unpack8(q[n][4], bb);
            const float vv = bf2f(vq[n]);
            const size_t so = ((size_t)(s_ * 8 + h) * 64 + row) * 64 + c0;
            float S[8] = {sA[n][0], sA[n][1], sA[n][2], sA[n][3], sB[n][0], sB[n][1], sB[n][2], sB[n][3]};
            float d = 0.f;
#pragma unroll
            for (int i = 0; i < 8; ++i) d += S[i] * kq[i];
            d += __shfl_xor(d, 1); d += __shfl_xor(d, 2); d += __shfl_xor(d, 4);
            float y = 0.f;
#pragma unroll
            for (int i = 0; i < 8; ++i) { S[i] = S[i] * __expf(-e_[i]) + (-d) * bb[i] + vv * kp[i]; y += S[i] * r_[i]; }
            y += __shfl_xor(y, 1); y += __shfl_xor(y, 2); y += __shfl_xor(y, 4);
            *(f32x4*)(a.out + O_WKVS + so) = (f32x4){S[0], S[1], S[2], S[3]}; *(f32x4*)(a.out + O_WKVS + so + 4) = (f32x4){S[4], S[5], S[6], S[7]};
            if ((tid & 7) == 0) OS[(size_t)s_ * 512 + h * 64 + row] = f2bf(y); } }
    }
}

__device__ void p3b_seq(const Args& a, LAS unsigned char* lds) {
    const int tid = threadIdx.x, G = gridDim.x, blk = blockIdx.x, wave = tid >> 6, lane = tid & 63, fr = lane & 15, fq = lane >> 4;
    unsigned char* ws = a.ws;
    const bf16_t* CHK = (const bf16_t*)(ws + OFF_CHK); bf16_t* SALL = (bf16_t*)(ws + OFF_SALL);
    LAS bf16_t* Shi = (LAS bf16_t*)lds; LAS bf16_t* Slo = Shi + 2 * 16 * 72;
    for (int item = blk; item < 256; item += G) {
        const int xcd_ = item & 7, idx_ = item >> 3;
        const int bh = (G == 256) ? xcd_ * 8 + (idx_ >> 2) : (item >> 2), q = (G == 256) ? (idx_ & 3) : (item & 3), j = wave;
        LBAR();
        for (int i = tid; i < 16 * 72; i += 512) { Shi[i] = 0; Slo[i] = 0; }
        LBAR();
        const bf16_t* chk0 = CHK + (size_t)(bh * 32) * 16384;
        constexpr int PF = 16;
        const size_t goff = 12288 + (size_t)(j * 16 + fr) * 64 + fq * 8, hoff = 8192 + (size_t)(q * 16 + fr) * 64 + j * 16 + 4 * fq;
        for (int c0 = 0; c0 < 32; c0 += PF) {
          bf16x8 G0[PF], G1[PF]; u32x2 HQ[PF];
          if (wave < 4) {
#pragma unroll
            for (int u = 0; u < PF; ++u) { const bf16_t* cn = chk0 + (size_t)(c0 + u) * 16384; G0[u] = *(const bf16x8*)(cn + goff); G1[u] = *(const bf16x8*)(cn + goff + 32); HQ[u] = *(const u32x2*)(cn + hoff); }
          }
#pragma unroll
          for (int u = 0; u < PF; ++u) { const int c = c0 + u;
            if (wave < 4) {
                const bf16x8 cg0 = G0[u], cg1 = G1[u]; const u32x2 chq = HQ[u];
                const LAS bf16_t* sh = Shi + (c & 1) * (16 * 72) + fr * 72 + fq * 8; const LAS bf16_t* sl = Slo + (c & 1) * (16 * 72) + fr * 72 + fq * 8;
                const bf16x8 h0 = *(const LAS bf16x8*)sh, h1 = *(const LAS bf16x8*)(sh + 32), l0 = *(const LAS bf16x8*)sl, l1 = *(const LAS bf16x8*)(sl + 32);
                bf16_t* sg = SALL + (size_t)(bh * 32 + c) * 4096 + (q * 16 + fr) * 64 + fq * 8;
                if (wave == 0) *(bf16x8*)sg = h0;
                if (wave == 1) *(bf16x8*)(sg + 32) = h1;
                f32x4 acc = {0.f, 0.f, 0.f, 0.f};
                acc = __builtin_amdgcn_mfma_f32_16x16x32_bf16(cg0, h0, acc, 0, 0, 0); acc = __builtin_amdgcn_mfma_f32_16x16x32_bf16(cg1, h1, acc, 0, 0, 0);
                acc = __builtin_amdgcn_mfma_f32_16x16x32_bf16(cg0, l0, acc, 0, 0, 0); acc = __builtin_amdgcn_mfma_f32_16x16x32_bf16(cg1, l1, acc, 0, 0, 0);
                float hv[4]; unpack4(chq, hv);
                const float s0 = acc[0] + hv[0], s1 = acc[1] + hv[1], s2 = acc[2] + hv[2], s3 = acc[3] + hv[3];
                const u32x2 ph = pack4(s0, s1, s2, s3); float hf[4]; unpack4(ph, hf);
                const u32x2 pl = pack4(s0 - hf[0], s1 - hf[1], s2 - hf[2], s3 - hf[3]);
                const int wo = ((c + 1) & 1) * (16 * 72) + fr * 72 + j * 16 + 4 * fq;
                *(LAS u32x2*)(Shi + wo) = ph; *(LAS u32x2*)(Slo + wo) = pl;
                if (c == 31) *(f32x4*)(a.out + O_WKVP + ((size_t)bh * 64 + q * 16 + fr) * 64 + j * 16 + 4 * fq) = (f32x4){s0, s1, s2, s3};
            }
            LBAR();
          }
        }
    }
}

__device__ void p3c_out(const Args& a) {
    const int tid = threadIdx.x, G = gridDim.x, blk = blockIdx.x, wave = tid >> 6, lane = tid & 63, fr = lane & 15, fq = lane >> 4;
    unsigned char* ws = a.ws;
    const bf16_t* SCN = (const bf16_t*)(ws + OFF_SCNS) - (size_t)MP * 8 * 384; const bf16_t* CHK = (const bf16_t*)(ws + OFF_CHK); const bf16_t* SALL = (const bf16_t*)(ws + OFF_SALL); bf16_t* YC = (bf16_t*)a.out;
    const bf16_t* Z = (const bf16_t*)(ws + OFF_Z); const float* RK = (const float*)(ws + OFF_RK); const float* mu = a.in[10];
    const float* r_k = a.in[17]; const float* ln_w = a.in[18]; const float* ln_b = a.in[19];
    for (int pi = blk; pi < 1024; pi += G) {
        const int unit = pi * 2 + (wave >> 2), it = wave & 3, bh = unit >> 5, c = unit & 31, b = bh >> 3, h = bh & 7;
        const int m = b * TSEQ + c * 64 + it * 16 + fr;
        const bf16_t* chk = CHK + (size_t)unit * 16384; const bf16_t* sall = SALL + (size_t)unit * 4096;
        bf16x8 xq[2];
#pragma unroll
        for (int ks = 0; ks < 2; ++ks) xq[ks] = *(const bf16x8*)(chk + (it * 16 + fr) * 64 + ks * 32 + fq * 8);
        const bool hasprev = (c * 64 + it * 16 + fr) >= 1;
        const bf16_t* zv = Z + (size_t)m * NZ + ZC_S + 1024 + h * 64 + 4 * fq; const bf16_t* zvp = hasprev ? zv - NZ : zv; const float fpv = hasprev ? 1.f : 0.f;
        const float rk = RK[(size_t)unit * 64 + it * 16 + fr];
        bf16_t* yp = YC + (size_t)m * D + 512 + h * 64 + 4 * fq;
        f32x4 acc[4]; u32x2 qy[4], qv[4], qvp[4], qg[4];
#pragma unroll
        for (int jt = 0; jt < 4; ++jt) { qy[jt] = *(const u32x2*)(chk + 4096 + (it * 16 + fr) * 64 + jt * 16 + 4 * fq);
            qv[jt] = *(const u32x2*)(zv + jt * 16); qvp[jt] = *(const u32x2*)(zvp + jt * 16); qg[jt] = *(const u32x2*)(yp + jt * 16); }
#pragma unroll
        for (int jt = 0; jt < 4; ++jt) { acc[jt] = (f32x4){0.f, 0.f, 0.f, 0.f};
#pragma unroll
            for (int ks = 0; ks < 2; ++ks) acc[jt] = __builtin_amdgcn_mfma_f32_16x16x32_bf16(*(const bf16x8*)(sall + (jt * 16 + fr) * 64 + ks * 32 + fq * 8), xq[ks], acc[jt], 0, 0, 0);
        }
        float o[4][4], vv[4][4]; float sm = 0.f;
#pragma unroll
        for (int jt = 0; jt < 4; ++jt) { float yl[4], vc[4], vp[4]; unpack4(qy[jt], yl); unpack4(qv[jt], vc); unpack4(qvp[jt], vp);
            const f32x4 mv = *(const f32x4*)(mu + 1024 + h * 64 + jt * 16 + 4 * fq);
#pragma unroll
            for (int e = 0; e < 4; ++e) { o[jt][e] = acc[jt][e] + yl[e]; sm += o[jt][e]; vv[jt][e] = vc[e] + (vp[e] * fpv - vc[e]) * mv[e]; } }
        sm += __shfl_xor(sm, 16); sm += __shfl_xor(sm, 32);
        const float mean = sm * (1.0f / 64.0f); float var = 0.f;
#pragma unroll
        for (int jt = 0; jt < 4; ++jt)
#pragma unroll
            for (int e = 0; e < 4; ++e) { o[jt][e] -= mean; var += o[jt][e] * o[jt][e]; }
        var += __shfl_xor(var, 16); var += __shfl_xor(var, 32);
        const float rstd = rsqrtf(var * (1.0f / 64.0f) + 64e-5f);
#pragma unroll
        for (int jt = 0; jt < 4; ++jt) { const int ch = h * 64 + jt * 16 + 4 * fq; const f32x4 lw = *(const f32x4*)(ln_w + ch), lb = *(const f32x4*)(ln_b + ch); float gt[4]; unpack4(qg[jt], gt);
            float y[4];
#pragma unroll
            for (int e = 0; e < 4; ++e) { y[e] = (o[jt][e] * rstd * lw[e] + lb[e] + rk * vv[jt][e]) * gt[e];
            }
            *(u32x2*)(yp + jt * 16) = pack4(y[0], y[1], y[2], y[3]); }
    }
    const bf16_t* OS = (const bf16_t*)(ws + OFF_OS);
    const int c = lane * 8, h = lane >> 3, cc = (lane & 7) * 8;
    for (int s = blk * 8 + wave; s < MS; s += G * 8) {
        const int m = MP + s;
        float o[8], r_[8], kp[8], v_[8], g[8];
        const bf16_t* sc = SCN + ((size_t)m * 8 + h) * 384 + cc;
        unpack8(*(const u32x4*)(OS + (size_t)s * 512 + c), o); unpack8(*(const u32x4*)(sc), r_); unpack8(*(const u32x4*)(sc + 128), kp); unpack8(*(const u32x4*)(sc + 192), v_);
        unpack8(*(const u32x4*)(YC + (size_t)m * D + 512 + c), g);
        float sm = 0.f, rk = 0.f;
#pragma unroll
        for (int i = 0; i < 8; ++i) { sm += o[i]; rk += r_[i] * kp[i] * r_k[h * 64 + cc + i]; }
        sm += __shfl_xor(sm, 1); sm += __shfl_xor(sm, 2); sm += __shfl_xor(sm, 4);
        rk += __shfl_xor(rk, 1); rk += __shfl_xor(rk, 2); rk += __shfl_xor(rk, 4);
        const float mean = sm * (1.0f / 64.0f);
        float var = 0.f;
#pragma unroll
        for (int i = 0; i < 8; ++i) { o[i] -= mean; var += o[i] * o[i]; }
        var += __shfl_xor(var, 1); var += __shfl_xor(var, 2); var += __shfl_xor(var, 4);
        const float rstd = rsqrtf(var * (1.0f / 64.0f) + 64e-5f);
        float y[8];
#pragma unroll
        for (int i = 0; i < 8; ++i) y[i] = (o[i] * rstd * ln_w[c + i] + ln_b[c + i] + rk * v_[i]) * g[i];
        *(u32x4*)(YC + (size_t)m * D + 512 + c) = pack8(y);
    }
}

__device__ void p5_out(const Args& a, LAS unsigned char* lds) {
    const int tid = threadIdx.x, G = gridDim.x, blk = blockIdx.x, wave = tid >> 6, lane = tid & 63, fr = lane & 15, fq = lane >> 4;
    unsigned char* ws = a.ws;
    const bf16_t* YC = (const bf16_t*)a.out; const bf16_t* WoutT = (const bf16_t*)(ws + OFF_WOUT); const bf16_t* PB = (const bf16_t*)(ws + OFF_PB); const bf16_t* WppT = (const bf16_t*)(ws + OFF_WPP);
    bf16_t* H1B = (bf16_t*)(ws + OFF_H1B); bf16_t* PP = (bf16_t*)((unsigned char*)a.out + PPD_OFF);
    { pg8::Gemm g{YC, WoutT, MP, D, D}; pg8::StaticOrder S; S.init(MP, D, G, blk); EpiH1 E{a.in[0], H1B}; pg8::gemm_phase<EpiH1, pg8::StaticOrder>(lds, g, S, E, nullptr); }
    for (int t2 = blk; t2 < 256; t2 += G) {
        const int tile = t2 * 2 + (wave >> 2), ks = wave & 3, rt = tile & 7, ct = tile >> 3; const int row = MP + rt * 16 + fr; const size_t o = (size_t)row * D + ct * 16 + 4 * fq;
        f32x4 acc = mini_tile_k<8>(YC + (size_t)row * D + ks * 256, WoutT + (size_t)(ct * 16 + fr) * D + ks * 256, fq);
        f32x4 acp = mini_tile_k<2>(PB + (size_t)row * DP + ks * 64, WppT + (size_t)(ct * 16 + fr) * DP + ks * 64, fq);
        acc = splitk_reduce(lds, acc, wave, lane);
        acp = splitk_reduce(lds, acp, wave, lane);
        if (ks == 0) {
            const f32x4 v = *(const f32x4*)(a.in[1] + (size_t)(row - MP) * D + ct * 16 + 4 * fq) + acc;
            *(u32x2*)(H1B + o) = pack4(v[0], v[1], v[2], v[3]);
            *(u32x2*)(PP + o) = pack4(acp[0], acp[1], acp[2], acp[3]);
        }
    }
}

__device__ void p6_gate(const Args& a, LAS unsigned char* lds) {
    const int tid = threadIdx.x, G = gridDim.x, blk = blockIdx.x, wave = tid >> 6, lane = tid & 63, fr = lane & 15, fq = lane >> 4;
    unsigned char* ws = a.ws;
    const bf16_t* WpgT = (const bf16_t*)(ws + OFF_WPG); const bf16_t* H1B = (const bf16_t*)(ws + OFF_H1B); const bf16_t* PP = (const bf16_t*)((const unsigned char*)a.out + PPD_OFF);
    { pg8::Gemm g{H1B, WpgT, MP, D, D}; pg8::StaticOrder S; S.init(MP, D, G, blk); EpiH2 E{H1B, PP, (bf16_t*)(ws + OFF_H2B)}; pg8::gemm_phase<EpiH2, pg8::StaticOrder>(lds, g, S, E, nullptr); }
    for (int t2 = blk; t2 < 256; t2 += G) {
        const int tile = t2 * 2 + (wave >> 2), ks = wave & 3, rt = tile & 7, ct = tile >> 3; const int row = MP + rt * 16 + fr; const size_t o = (size_t)row * D + ct * 16 + 4 * fq;
        f32x4 g = mini_tile_k<8>(H1B + (size_t)row * D + ks * 256, WpgT + (size_t)(ct * 16 + fr) * D + ks * 256, fq);
        g = splitk_reduce(lds, g, wave, lane);
        if (ks == 0) {
            float h[4], p[4]; unpack4(*(const u32x2*)(H1B + o), h); unpack4(*(const u32x2*)(PP + o), p);
            f32x4 v; v[0] = h[0] + sigmoidf_(g[0]) * p[0]; v[1] = h[1] + sigmoidf_(g[1]) * p[1]; v[2] = h[2] + sigmoidf_(g[2]) * p[2]; v[3] = h[3] + sigmoidf_(g[3]) * p[3];
            *(u32x2*)((bf16_t*)(ws + OFF_H2B) + o) = pack4(v[0], v[1], v[2], v[3]);
        }
    }
}

__device__ void p7_norm(const Args& a) {
    const int tid = threadIdx.x, G = gridDim.x, blk = blockIdx.x, wave = tid >> 6, lane = tid & 63;
    const float* fg = a.in[23]; const bf16_t* H2B = (const bf16_t*)(a.ws + OFF_H2B);
    f32x4 gv[2][2];
#pragma unroll
    for (int i = 0; i < 2; ++i) { gv[i][0] = *(const f32x4*)(fg + i * 512 + lane * 8); gv[i][1] = *(const f32x4*)(fg + i * 512 + lane * 8 + 4); }
    for (int row0 = (blk * 8 + wave) * 4; row0 < MT; row0 += G * 32) {
        u32x4 q[4][2];
#pragma unroll
        for (int r = 0; r < 4; ++r)
#pragma unroll
            for (int i = 0; i < 2; ++i) q[r][i] = *(const u32x4*)(H2B + (size_t)(row0 + r) * D + i * 512 + lane * 8);
#pragma unroll
        for (int r = 0; r < 4; ++r) { float f[2][8]; unpack8(q[r][0], f[0]); unpack8(q[r][1], f[1]); float ss = 0.f;
#pragma unroll
            for (int i = 0; i < 2; ++i)
#pragma unroll
                for (int e = 0; e < 8; ++e) ss += f[i][e] * f[i][e];
#pragma unroll
            for (int o = 32; o >= 1; o >>= 1) ss += __shfl_xor(ss, o);
            const float rs = rsqrtf(ss * (1.0f / D) + 1e-6f);
#pragma unroll
            for (int i = 0; i < 2; ++i) { float* yp = a.out + (size_t)(row0 + r) * D + i * 512 + lane * 8;
                *(f32x4*)(yp) = (f32x4){f[i][0], f[i][1], f[i][2], f[i][3]} * rs * gv[i][0]; *(f32x4*)(yp + 4) = (f32x4){f[i][4], f[i][5], f[i][6], f[i][7]} * rs * gv[i][1]; } }
    }
}

#define XB_TMO      128
#define XB_XCNT(j)  (256  + 64 * (j))
#define XB_XSUB(j)  (1280 + 64 * (j))
#define XB_XGEN(j)  (2304 + 64 * (j))
#define XB_TOP      3328
#define XB_TOPGEN   3392
#define XCD_BAR_WORDS 3456
#define XB_SPIN_CAP (1u << 18)

__device__ __forceinline__ unsigned xb_ld(unsigned* p)              { return __hip_atomic_load(p, __ATOMIC_RELAXED, __HIP_MEMORY_SCOPE_AGENT); }
__device__ __forceinline__ unsigned xb_add(unsigned* p, unsigned v) { return __hip_atomic_fetch_add(p, v, __ATOMIC_RELAXED, __HIP_MEMORY_SCOPE_AGENT); }
__device__ __forceinline__ unsigned xb_xcc_id() { return (unsigned)__builtin_amdgcn_s_getreg((3 << 11) | 20) & 0xFu; }
#define XB_SPIN(cond, bar) do { unsigned _sp = 0; while (cond) { __builtin_amdgcn_s_sleep(1); \
    if ((++_sp & 255u) == 0u) { if (xb_ld(&(bar)[XB_TMO])) break; if (_sp > XB_SPIN_CAP) { atomicAdd(&(bar)[XB_TMO], 1u); break; } } } } while (0)

struct XcdBarrier {
    unsigned* bar; unsigned x;
    volatile LAS unsigned* st;
};

__device__ __forceinline__ XcdBarrier xcd_barrier_post(unsigned* bar, volatile LAS unsigned* st) {
    XcdBarrier b; b.bar = bar; b.x = xb_xcc_id(); b.st = st;
    if (threadIdx.x == 0) (void)xb_add(&bar[XB_XCNT(b.x)], 1u);
    return b;
}
__device__ __forceinline__ void xcd_barrier_complete(unsigned* bar, unsigned x, unsigned& nloc, unsigned& nx) {
    const unsigned G = gridDim.x * gridDim.y * gridDim.z;
    unsigned sum, cnt, mine, sp = 0u;
    for (;;) {
        sum = 0u; cnt = 0u; mine = 0u;
#pragma unroll
        for (unsigned j = 0; j < 16; ++j) { const unsigned c = xb_ld(&bar[XB_XCNT(j)]); sum += c; cnt += (c > 0u) ? 1u : 0u; mine = (j == x) ? c : mine; }
        if (sum == G) break;
        __builtin_amdgcn_s_sleep(1);
        if ((++sp & 255u) == 0u) { if (xb_ld(&bar[XB_TMO])) break; if (sp > XB_SPIN_CAP) { atomicAdd(&bar[XB_TMO], 1u); break; } }
    }
    nloc = mine > 0u ? mine : 1u; nx = cnt > 0u ? cnt : 1u;
}

__device__ __forceinline__ void xcd_barrier(const XcdBarrier& b) {
    asm volatile("s_waitcnt vmcnt(0)" ::: "memory");
    __syncthreads();
    if (threadIdx.x == 0) {
        unsigned* bar = b.bar;
        __builtin_amdgcn_s_waitcnt(0);
        unsigned nloc = b.st[0], nx = b.st[1];
        if (nloc == 0u) { xcd_barrier_complete(bar, b.x, nloc, nx); b.st[0] = nloc; b.st[1] = nx; }
        const unsigned old = xb_add(&bar[XB_XSUB(b.x)], 1u);
        const unsigned gen = old / nloc;
        if (old + 1u == (gen + 1u) * nloc) {
            __builtin_amdgcn_fence(__ATOMIC_RELEASE, "agent");
            asm volatile("s_waitcnt vmcnt(0)" ::: "memory");
            const unsigned og = xb_add(&bar[XB_TOP], 1u);
            const unsigned tg = og / nx;
            if (og + 1u == (tg + 1u) * nx) xb_add(&bar[XB_TOPGEN], 1u);
            else XB_SPIN(xb_ld(&bar[XB_TOPGEN]) == tg, bar);
            __builtin_amdgcn_fence(__ATOMIC_ACQUIRE, "agent");
            xb_add(&bar[XB_XGEN(b.x)], 1u);
            asm volatile("s_waitcnt vmcnt(0)" ::: "memory");
        } else {
            XB_SPIN(xb_ld(&bar[XB_XGEN(b.x)]) == gen, bar);
            __builtin_amdgcn_fence(__ATOMIC_ACQUIRE, "agent");
            asm volatile("s_waitcnt vmcnt(0)" ::: "memory");
        }
    }
    __syncthreads();
}

__global__ void __launch_bounds__(512, 2) fwd(Args a) {
    extern __shared__ __attribute__((aligned(16))) unsigned char lds_raw[];
    LAS unsigned char* lds = (LAS unsigned char*)lds_raw;
    cg::grid_group grid = cg::this_grid();
    volatile LAS unsigned* xst = (volatile LAS unsigned*)(lds + LDS_BYTES - 16);
    if (threadIdx.x == 0) { xst[0] = 0u; xst[1] = 0u; }
    __syncthreads();
    const XcdBarrier xb = xcd_barrier_post((unsigned*)(a.ws + OFF_BAR), xst);
    if (a.ph_hi > 1000) grid.sync();
#define IN(k) (a.ph_lo <= (k) && (k) < a.ph_hi)
#define GSYNC() xcd_barrier(xb)
#define SEAM(k) do { if (IN(k) && IN((k) + 1)) GSYNC(); } while (0)
#ifndef REP_PHASE
#define REP_PHASE -1
#endif
#define REPS(k) ((REP_PHASE == (k)) ? 2 : 1)
    if (IN(0)) for (int r = 0; r < REPS(0); ++r) { if (r) GSYNC(); p0_prep(a, lds); }
    SEAM(0);
    if (IN(1)) for (int r = 0; r < REPS(1); ++r) { if (r) GSYNC(); p1_gemm_in(a, lds); }
    SEAM(1);
    if (IN(2)) for (int r = 0; r < REPS(2); ++r) { if (r) GSYNC(); p2_all(a, lds); }
    if (IN(2) && !IN(3)) {}
    else if (!IN(2) && IN(3)) {}
    if (IN(3)) for (int r = 0; r < REPS(3); ++r) { if (r) GSYNC(); __syncthreads(); p3a_chunks(a, lds); }
    SEAM(3);
    if (IN(4)) for (int r = 0; r < REPS(4); ++r) { if (r) GSYNC(); p3b_seq(a, lds); if (r == 0) p3_sample_step(a, (int)blockIdx.x, (int)gridDim.x); }
    SEAM(4);
    if (IN(5)) p3c_out(a);
    SEAM(5);
    if (IN(6)) p5_out(a, lds);
    SEAM(6);
    if (IN(7)) p6_gate(a, lds);
    SEAM(7);
#if REP_PHASE == 99
    GSYNC(); GSYNC(); GSYNC(); GSYNC();
#endif
    if (IN(8)) p7_norm(a);
}

#ifndef N_LAUNCH_MODE
#define N_LAUNCH_MODE 1
#endif
extern "C" void kernel_launch(void* const* d_in, const int* in_sizes, int n_in, void* d_out, int out_size, void* d_ws, size_t ws_size, hipStream_t stream) {
    static int grid = 0;
    if (grid == 0) {
        if (n_in != 24 || ws_size < WS_END) { fprintf(stderr, "kernel_launch: unexpected n_in %d / ws_size %zu (need %zu)\n", n_in, ws_size, (size_t)WS_END); grid = -1; return; }
        int dev = 0, cus = 0, per_cu = 0;
        (void)hipGetDevice(&dev); (void)hipDeviceGetAttribute(&cus, hipDeviceAttributeMultiprocessorCount, dev);
        if (hipFuncSetAttribute((const void*)fwd, hipFuncAttributeMaxDynamicSharedMemorySize, LDS_BYTES) != hipSuccess) { fprintf(stderr, "kernel_launch: hipFuncSetAttribute failed\n"); grid = -1; return; }
        if (hipOccupancyMaxActiveBlocksPerMultiprocessor(&per_cu, (const void*)fwd, 512, LDS_BYTES) != hipSuccess || per_cu < 1) { fprintf(stderr, "kernel_launch: occupancy query gives %d\n", per_cu); per_cu = 1; }
        (void)hipGetLastError();
        grid = cus;
    }
    if (grid < 0) return;
    Args a{};
    for (int i = 0; i < 24; ++i) a.in[i] = (const float*)d_in[i];
    a.out = (float*)d_out; a.ws = (unsigned char*)d_ws;
    (void)hipMemsetAsync((unsigned char*)d_ws + OFF_BAR, 0, XCD_BAR_WORDS * 4, stream);
    if (N_LAUNCH_MODE == 1) {
        a.ph_lo = 0; a.ph_hi = 9;
        void* args[] = {&a};
        hipError_t e = hipLaunchCooperativeKernel((const void*)fwd, dim3(grid), dim3(512), args, LDS_BYTES, stream);
        if (e != hipSuccess) fprintf(stderr, "kernel_launch: cooperative launch failed: %s (grid %d)\n", hipGetErrorString(e), grid);
    } else {
        for (int ph = 0; ph < 9; ++ph) { a.ph_lo = ph; a.ph_hi = ph + 1; hipLaunchKernelGGL(fwd, dim3(grid), dim3(512), LDS_BYTES, stream, a); }
    }
}
```

```cpp
#include <hip/hip_runtime.h>
#include <hip/hip_cooperative_groups.h>
#include <cstdio>
namespace pg8 {
#define PG8_LAS __attribute__((address_space(3)))
typedef unsigned short bf16_t;
typedef short bf16x8 __attribute__((ext_vector_type(8)));
typedef float f32x4 __attribute__((ext_vector_type(4)));
typedef unsigned u32x4 __attribute__((ext_vector_type(4)));
constexpr int BM = 256, BK = 64, HALF = 128, HTB = HALF * BK * 2  , STAGE_BYTES = 8 * HTB, NXCD = 8, WGM = 8;

__host__ __device__ __forceinline__ int lds_byte(int r, int c) { const int st = (r >> 4) * 2 + (c >> 5), rr = r & 15, cc = c & 31, ob = rr * 64 + cc * 2; return st * 1024 + (ob ^ (((ob >> 9) & 1) << 5)); }
__host__ __device__ __forceinline__ void stage_rc(int b, int& R, int& C) { const int st = b / 1024, sb = b % 1024, swz = sb ^ (((sb >> 9) & 1) << 5); R = (st >> 1) * 16 + swz / 64; C = (st & 1) * 32 + (swz % 64) / 2; }
__host__ __device__ __forceinline__ int perm32(int rho) { const int n = rho >> 4, i = rho & 15; return 8 * (i >> 2) + 4 * n + (i & 3); }

struct Unit { int pm, pn; };
struct Gemm { const bf16_t* A; const bf16_t* Bt; int M, N, K; };

struct StaticOrder {
    int nM, nN, nwg, G, c;
    __host__ __device__ void init(int M, int N, int G_, int c_) { nM = M / BM; nN = N / BM; nwg = nM * nN; G = G_; c = c_; }
    __host__ __device__ bool next(int i, Unit& u) const {
        const long L = (long)i * G + c; if (L >= nwg) return false;
        int wgid = (int)L; { const int q = nwg / NXCD, r = nwg % NXCD, xcd = wgid % NXCD, off = wgid / NXCD; wgid = (xcd < r ? xcd * (q + 1) : r * (q + 1) + (xcd - r) * q) + off; }
        const int nig = WGM * nN, gid = wgid / nig, fm = gid * WGM, gsz = (nM - fm) < WGM ? (nM - fm) : WGM;
        u.pm = fm + ((wgid % nig) % gsz); u.pn = (wgid % nig) / gsz; return true;
    }
    __device__ __forceinline__ void a_ready(const Unit&) const {}
    __device__ __forceinline__ void done(const Unit&) const {}
};
typedef __bf16 bf16v2_t __attribute__((ext_vector_type(2)));
typedef float f32v2_t __attribute__((ext_vector_type(2)));
__device__ __forceinline__ unsigned cvt_pk_bf16(float lo, float hi) { const bf16v2_t r = __builtin_convertvector((f32v2_t){lo, hi}, bf16v2_t); return __builtin_bit_cast(unsigned, r); }
template <class Epi, class Sched, bool STAMP = false>
__device__ __forceinline__ void gemm_phase(PG8_LAS unsigned char* lds, const Gemm g, const Sched& S, const Epi& E, unsigned long long* stamps) {
    const int tid = threadIdx.x, wid = __builtin_amdgcn_readfirstlane(tid >> 6), lane = tid & 63, wr = wid >> 2, wc = wid & 3, fr = lane & 15, fq = lane >> 4;
    const int K = g.K, nt = K / BK;
    int ts_lo = 0, ts_hi = 0, nts = 0; const unsigned long long rt_entry = STAMP ? (unsigned long long)wall_clock64() : 0ull;
#define PG8_STAMP() do { if (STAMP && wid == 0 && nts < 64) { const unsigned long long _c = (unsigned long long)clock64(); \
        ts_lo = (lane == nts) ? (int)(unsigned)_c : ts_lo; ts_hi = (lane == nts) ? (int)(unsigned)(_c >> 32) : ts_hi; ++nts; } } while (0)
    PG8_STAMP();
    unsigned voffA[2], voffB[2];
#pragma unroll
    for (int i = 0; i < 2; ++i) { int R, C; stage_rc(tid * 16 + i * 8192, R, C); const int Rb = Epi::PERM ? ((R & ~31) + perm32(R & 31)) : R;
        voffA[i] = (unsigned)(R * K + C) * 2u; voffB[i] = (unsigned)(Rb * K + C) * 2u; }
    const size_t kstep = (size_t)(BK * 2);
    const size_t hstep = (size_t)HALF * K * 2;
    const size_t tstep = 2 * hstep;
    const unsigned ldsw = (unsigned)wid * 1024u;
    const int aoff = lds_byte(wr * 64 + fr, fq * 8), boff = lds_byte(wc * 32 + fr, fq * 8);
#define PG8_SA(b, h) (((b) * 2 + (h)) * HTB)
#define PG8_SB(b, h) ((4 + (b) * 2 + (h)) * HTB)
#define PG8_STAGE(bufoff, gbase, voff) do { _Pragma("unroll") for (int _i = 0; _i < 2; ++_i) \
        __builtin_amdgcn_global_load_lds((const unsigned*)((const char*)(gbase) + (voff)[_i]), (PG8_LAS unsigned*)(lds + (bufoff) + ldsw + _i * 8192), 16, 0, 0); } while (0)
#define PG8_LDA(dst, b, h) do { _Pragma("unroll") for (int m = 0; m < 4; ++m) _Pragma("unroll") for (int k = 0; k < 2; ++k) dst[m][k] = *(const PG8_LAS bf16x8*)(lds + PG8_SA(b, h) + aoff + m * 2048 + k * 1024); } while (0)
#define PG8_LDB(dst, b, h) do { _Pragma("unroll") for (int n = 0; n < 2; ++n) _Pragma("unroll") for (int k = 0; k < 2; ++k) dst[n][k] = *(const PG8_LAS bf16x8*)(lds + PG8_SB(b, h) + boff + n * 2048 + k * 1024); } while (0)
#define PG8_MMA(ai, bj, At, Bt) do { __builtin_amdgcn_s_setprio(1); _Pragma("unroll") for (int m = 0; m < 4; ++m) _Pragma("unroll") for (int n = 0; n < 2; ++n) _Pragma("unroll") for (int k = 0; k < 2; ++k) \
        acc[ai][bj][m][n] = __builtin_amdgcn_mfma_f32_16x16x32_bf16(Bt[n][k], At[m][k], acc[ai][bj][m][n], 0, 0, 0); __builtin_amdgcn_s_setprio(0); } while (0)
#define PG8_WAIT_V(n) asm volatile("s_waitcnt vmcnt(" #n ")" ::: "memory")
#define PG8_WAIT_L(n) asm volatile("s_waitcnt lgkmcnt(" #n ")" ::: "memory")
#define PG8_BAR __builtin_amdgcn_s_barrier()
#define PG8_SCHED __builtin_amdgcn_sched_barrier(0)
    Unit cur, nxt; int ui = 0;
    if (!S.next(0, cur)) return;
    f32x4 acc[2][2][4][2];
#pragma unroll
    for (int a = 0; a < 2; ++a)
#pragma unroll
        for (int b = 0; b < 2; ++b)
#pragma unroll
            for (int m = 0; m < 4; ++m)
#pragma unroll
                for (int n = 0; n < 2; ++n) acc[a][b][m][n] = (f32x4){0.f, 0.f, 0.f, 0.f};
    bf16x8 At[4][2], B0[2][2], B1[2][2];
    const char* cA = (const char*)g.A + (size_t)cur.pm * tstep; const char* cB = (const char*)g.Bt + (size_t)cur.pn * tstep;
    S.a_ready(cur);
    PG8_STAGE(PG8_SB(0, 0), cB, voffB); PG8_STAGE(PG8_SA(0, 0), cA, voffA); PG8_STAGE(PG8_SB(0, 1), cB + hstep, voffB); PG8_STAGE(PG8_SA(0, 1), cA + hstep, voffA);
    if (wr == 1) PG8_BAR;
    PG8_WAIT_V(4); PG8_BAR;
    PG8_STAGE(PG8_SB(1, 0), cB + kstep, voffB); PG8_STAGE(PG8_SA(1, 0), cA + kstep, voffA); PG8_STAGE(PG8_SB(1, 1), cB + hstep + kstep, voffB);
    PG8_WAIT_V(6); PG8_BAR;
    PG8_STAMP();
    for (;;) {
        const bool has_next = S.next(ui + 1, nxt);
        const char* nA = has_next ? (const char*)g.A + (size_t)nxt.pm * tstep : cA; const char* nB = has_next ? (const char*)g.Bt + (size_t)nxt.pn * tstep : cB;
        for (int t = 0; t < nt; t += 2) {
            const bool last = (t == nt - 2);
            const char* a1 = cA + (size_t)(t + 1) * kstep;
            const char* a2 = last ? nA : cA + (size_t)(t + 2) * kstep; const char* b2 = last ? nB : cB + (size_t)(t + 2) * kstep;
            const char* a3 = a2 + kstep; const char* b3 = b2 + kstep;
            if (last && has_next) S.a_ready(nxt);
            PG8_LDB(B0, 0, 0); PG8_SCHED; PG8_LDA(At, 0, 0); PG8_STAGE(PG8_SA(1, 1), a1 + hstep, voffA);
            PG8_WAIT_L(8); PG8_BAR; PG8_WAIT_L(0); PG8_MMA(0, 0, At, B0); PG8_BAR; PG8_SCHED;
            PG8_LDB(B1, 0, 1); PG8_STAGE(PG8_SB(0, 0), b2, voffB);
            PG8_BAR; PG8_WAIT_L(0); PG8_MMA(0, 1, At, B1); PG8_BAR;
            PG8_LDA(At, 0, 1); PG8_STAGE(PG8_SA(0, 0), a2, voffA);
            PG8_BAR; PG8_WAIT_L(0); PG8_MMA(1, 0, At, B0); PG8_BAR; PG8_SCHED;
            PG8_STAGE(PG8_SB(0, 1), b2 + hstep, voffB);
            PG8_WAIT_V(6); PG8_BAR; PG8_MMA(1, 1, At, B1); PG8_BAR;
            PG8_LDB(B0, 1, 0); PG8_SCHED; PG8_LDA(At, 1, 0); PG8_STAGE(PG8_SA(0, 1), a2 + hstep, voffA);
            PG8_WAIT_L(8); PG8_BAR; PG8_WAIT_L(0); PG8_MMA(0, 0, At, B0); PG8_BAR; PG8_SCHED;
            PG8_LDB(B1, 1, 1); PG8_STAGE(PG8_SB(1, 0), b3, voffB);
            PG8_BAR; PG8_WAIT_L(0); PG8_MMA(0, 1, At, B1); PG8_BAR;
            PG8_LDA(At, 1, 1); PG8_STAGE(PG8_SA(1, 0), a3, voffA);
            PG8_BAR; PG8_WAIT_L(0); PG8_MMA(1, 0, At, B0); PG8_BAR; PG8_SCHED;
            PG8_STAGE(PG8_SB(1, 1), b3 + hstep, voffB);
            PG8_WAIT_V(6); PG8_BAR; PG8_MMA(1, 1, At, B1); PG8_BAR;
        }
        PG8_STAMP();
        if constexpr (!Epi::AFTER_DRAIN) { E(acc, cur, wr, wc, fr, fq); S.done(cur); }
        PG8_STAMP();
        if (!has_next) break;
#pragma unroll
        for (int a = 0; a < 2; ++a)
#pragma unroll
            for (int b = 0; b < 2; ++b)
#pragma unroll
                for (int m = 0; m < 4; ++m)
#pragma unroll
                    for (int n = 0; n < 2; ++n) acc[a][b][m][n] = (f32x4){0.f, 0.f, 0.f, 0.f};
        cur = nxt; cA = nA; cB = nB; ++ui;
    }
    PG8_WAIT_V(0);
    if (wr == 0) PG8_BAR;
    PG8_BAR;
    if constexpr (Epi::AFTER_DRAIN) { E.fused(acc, cur, wr, wc, fr, fq, lds, wid, lane); S.done(cur); }
    PG8_STAMP();
    if (STAMP && wid == 0) { stamps[lane] = lane < nts ? (((unsigned long long)(unsigned)ts_hi << 32) | (unsigned)ts_lo) : 0ull;
        if (lane == 62) stamps[62] = rt_entry; if (lane == 63) stamps[63] = (unsigned long long)wall_clock64(); }
#undef PG8_STAMP
#undef PG8_SA
#undef PG8_SB
#undef PG8_STAGE
#undef PG8_LDA
#undef PG8_LDB
#undef PG8_MMA
#undef PG8_WAIT_V
#undef PG8_WAIT_L
#undef PG8_BAR
#undef PG8_SCHED
}
}

namespace cg = cooperative_groups;
using pg8::bf16_t; using pg8::bf16x8; using pg8::f32x4; using pg8::u32x4; using pg8::Unit; using pg8::cvt_pk_bf16;
typedef unsigned u32x2 __attribute__((ext_vector_type(2)));
#define LAS __attribute__((address_space(3)))
#define LBAR() do { asm volatile("s_waitcnt lgkmcnt(0)" ::: "memory"); __builtin_amdgcn_s_barrier(); asm volatile("" ::: "memory"); } while (0)

constexpr int D = 1024, TSEQ = 2048, NB = 8, MP = NB * TSEQ, MS = 128, MT = MP + MS;
constexpr int RW = 512, NH = 8, SW = 1664, NZ = 4224, NZP = 4352, DP = 256;
constexpr int ZC_S = 2048, ZC_GR = 3712;
constexpr int LDS_BYTES = 159744;

constexpr size_t OFF_WIN = 0;
constexpr size_t OFF_WOUT = OFF_WIN + (size_t)NZP * D * 2;
constexpr size_t OFF_WPG = OFF_WOUT + (size_t)D * D * 2;
constexpr size_t OFF_WPP = OFF_WPG + (size_t)D * D * 2;
constexpr size_t OFF_WUP = OFF_WPP + (size_t)D * DP * 2;
constexpr size_t OFF_AUP = OFF_WUP + (size_t)RW * 64 * 2;
constexpr size_t OFF_RS = OFF_AUP + (size_t)RW * 64 * 2;
constexpr size_t OFF_PB = OFF_RS + (size_t)16640 * 4;
constexpr size_t OFF_Z = OFF_PB + (size_t)MT * DP * 2;
constexpr size_t OFF_SCN = OFF_Z + (size_t)MT * NZ * 2;
constexpr size_t OFF_BAR = OFF_SCN + (size_t)MT * NH * 384 * 2;
constexpr size_t WS_END = OFF_BAR + 16384;
constexpr size_t OFF_H1B = OFF_Z;
constexpr size_t OFF_PPB = OFF_H1B + (size_t)MT * D * 2;
constexpr size_t OFF_H2B = OFF_PPB + (size_t)MT * D * 2;
static_assert(OFF_H2B + (size_t)MT * D * 2 <= OFF_SCN, "overlay");
constexpr size_t PPD_OFF = (size_t)MT * D * 2;
constexpr size_t OFF_CHK = OFF_SCN;
constexpr size_t OFF_SALL = OFF_CHK + (size_t)2048 * 16384 * 2;
constexpr size_t OFF_OS = OFF_SALL + (size_t)2048 * 4096 * 2;
constexpr size_t OFF_SCNS = OFF_OS + (size_t)128 * 512 * 2;
constexpr size_t OFF_RK = OFF_SCNS + (size_t)MS * NH * 384 * 2;
static_assert(OFF_RK + (size_t)2048 * 64 * 4 <= OFF_BAR, "overlay");
constexpr size_t O_Y = 0, O_CONVP = (size_t)MT * D, O_SHIFTP = O_CONVP + 8 * 2 * 512, O_WKVP = O_SHIFTP + 8 * SW,
                 O_CONVS = O_WKVP + 8 * 8 * 64 * 64, O_SHIFTS = O_CONVS + 128 * 2 * 512, O_WKVS = O_SHIFTS + 128 * SW;

struct Args { const float* in[24]; float* out; unsigned char* ws; int ph_lo, ph_hi; };

__device__ __forceinline__ float bf2f(unsigned short b) { return __uint_as_float(((unsigned)b) << 16); }
__device__ __forceinline__ float bflo(unsigned w) { return __uint_as_float(w << 16); }
__device__ __forceinline__ float bfhi(unsigned w) { return __uint_as_float(w & 0xffff0000u); }
__device__ __forceinline__ unsigned short f2bf(float f) { return (unsigned short)(cvt_pk_bf16(f, 0.f) & 0xffffu); }
__device__ __forceinline__ void unpack8(const u32x4 q, float (&f)[8]) {
    f[0] = bflo(q.x); f[1] = bfhi(q.x); f[2] = bflo(q.y); f[3] = bfhi(q.y); f[4] = bflo(q.z); f[5] = bfhi(q.z); f[6] = bflo(q.w); f[7] = bfhi(q.w); }
__device__ __forceinline__ void unpack4(const u32x2 q, float (&f)[4]) { f[0] = bflo(q.x); f[1] = bfhi(q.x); f[2] = bflo(q.y); f[3] = bfhi(q.y); }
__device__ __forceinline__ u32x4 pack8(const float (&f)[8]) { u32x4 q; q.x = cvt_pk_bf16(f[0], f[1]); q.y = cvt_pk_bf16(f[2], f[3]); q.z = cvt_pk_bf16(f[4], f[5]); q.w = cvt_pk_bf16(f[6], f[7]); return q; }
__device__ __forceinline__ u32x2 pack4(float a, float b, float c, float d) { u32x2 q; q.x = cvt_pk_bf16(a, b); q.y = cvt_pk_bf16(c, d); return q; }
__device__ __forceinline__ float sigmoidf_(float x) { return __builtin_amdgcn_rcpf(1.0f + __expf(-x)); }
__device__ __forceinline__ float siluf_(float x) { return x * __builtin_amdgcn_rcpf(1.0f + __expf(-x)); }
template <int CTRL> __device__ __forceinline__ float dppf(float x) { return __int_as_float(__builtin_amdgcn_update_dpp(0, __float_as_int(x), CTRL, 0xf, 0xf, false)); }
__device__ __forceinline__ float rowsum16(float x) { x += dppf<0x128>(x); x += dppf<0x124>(x); x += dppf<0x122>(x); x += dppf<0x121>(x); return x; }

__device__ __forceinline__ f32x4 mini_tile(const bf16_t* arow, const bf16_t* brow, int K, int fq) {
    f32x4 acc = {0.f, 0.f, 0.f, 0.f};
    const bf16_t* ap = arow + fq * 8; const bf16_t* bp = brow + fq * 8;
    for (int k0 = 0; k0 < K; k0 += 256) {
        bf16x8 av[8], bv[8];
#pragma unroll
        for (int j = 0; j < 8; ++j) { av[j] = *(const bf16x8*)(ap + k0 + j * 32); bv[j] = *(const bf16x8*)(bp + k0 + j * 32); }
#pragma unroll
        for (int j = 0; j < 8; ++j) acc = __builtin_amdgcn_mfma_f32_16x16x32_bf16(bv[j], av[j], acc, 0, 0, 0);
    }
    return acc;
}

template <int NSTEP> __device__ __forceinline__ f32x4 mini_tile_k(const bf16_t* arow, const bf16_t* brow, int fq) {
    f32x4 acc = {0.f, 0.f, 0.f, 0.f};
    bf16x8 av[NSTEP], bv[NSTEP];
#pragma unroll
    for (int j = 0; j < NSTEP; ++j) { av[j] = *(const bf16x8*)(arow + fq * 8 + j * 32); bv[j] = *(const bf16x8*)(brow + fq * 8 + j * 32); }
#pragma unroll
    for (int j = 0; j < NSTEP; ++j) acc = __builtin_amdgcn_mfma_f32_16x16x32_bf16(bv[j], av[j], acc, 0, 0, 0);
    return acc;
}
__device__ __forceinline__ f32x4 splitk_reduce(LAS unsigned char* lds, f32x4 acc, int wave, int lane) {
    LAS f32x4* red = (LAS f32x4*)lds;
    __syncthreads();
    red[wave * 64 + lane] = acc;
    __syncthreads();
    if ((wave & 3) == 0) acc = (acc + red[(wave + 1) * 64 + lane]) + (red[(wave + 2) * 64 + lane] + red[(wave + 3) * 64 + lane]);
    return acc;
}

struct EpiZ {
    static constexpr bool PERM = true, AFTER_DRAIN = false;
    bf16_t* Z; const float* rs;
    __device__ __forceinline__ void operator()(const f32x4 (&acc)[2][2][4][2], const Unit& u, int wr, int wc, int fr, int fq) const {
        const int row0 = u.pm * 256 + wr * 64 + fr, col0 = u.pn * 256 + wc * 32 + 8 * fq;
        float sc[2][4];
#pragma unroll
        for (int ai = 0; ai < 2; ++ai)
#pragma unroll
            for (int m = 0; m < 4; ++m) sc[ai][m] = rs[row0 + ai * 128 + m * 16];
#pragma unroll
        for (int ai = 0; ai < 2; ++ai)
#pragma unroll
            for (int m = 0; m < 4; ++m) { const int row = row0 + ai * 128 + m * 16; const float s = sc[ai][m]; bf16_t* rp = Z + (size_t)row * NZ + col0;
#pragma unroll
                for (int bj = 0; bj < 2; ++bj) { if (col0 + bj * 128 < NZ && row < MT) { const f32x4 v0 = acc[ai][bj][m][0] * s, v1 = acc[ai][bj][m][1] * s; u32x4 w;
                    w.x = cvt_pk_bf16(v0[0], v0[1]); w.y = cvt_pk_bf16(v0[2], v0[3]); w.z = cvt_pk_bf16(v1[0], v1[1]); w.w = cvt_pk_bf16(v1[2], v1[3]); *(u32x4*)(rp + bj * 128) = w; } } }
    }
};
struct EpiH1 {
    static constexpr bool PERM = true, AFTER_DRAIN = false;
    const float* x; bf16_t* H1B;
    __device__ __forceinline__ void operator()(const f32x4 (&acc)[2][2][4][2], const Unit& u, int wr, int wc, int fr, int fq) const {
        const int row0 = u.pm * 256 + wr * 64 + fr, col0 = u.pn * 256 + wc * 32 + 8 * fq;
#pragma unroll
        for (int ai = 0; ai < 2; ++ai)
#pragma unroll
            for (int mp = 0; mp < 2; ++mp) {
                f32x4 xv[2][2][2];
#pragma unroll
                for (int mm = 0; mm < 2; ++mm)
#pragma unroll
                    for (int bj = 0; bj < 2; ++bj) { const size_t o = (size_t)(row0 + ai * 128 + (mp * 2 + mm) * 16) * D + col0 + bj * 128; xv[mm][bj][0] = *(const f32x4*)(x + o); xv[mm][bj][1] = *(const f32x4*)(x + o + 4); }
#pragma unroll
                for (int mm = 0; mm < 2; ++mm)
#pragma unroll
                    for (int bj = 0; bj < 2; ++bj) { const int m = mp * 2 + mm; const size_t o = (size_t)(row0 + ai * 128 + m * 16) * D + col0 + bj * 128;
                        const f32x4 v0 = xv[mm][bj][0] + acc[ai][bj][m][0], v1 = xv[mm][bj][1] + acc[ai][bj][m][1]; u32x4 w;
                        w.x = cvt_pk_bf16(v0[0], v0[1]); w.y = cvt_pk_bf16(v0[2], v0[3]); w.z = cvt_pk_bf16(v1[0], v1[1]); w.w = cvt_pk_bf16(v1[2], v1[3]); *(u32x4*)(H1B + o) = w; }
                asm volatile("" ::: "memory"); }
    }
};
struct EpiF32 {
    static constexpr bool PERM = true, AFTER_DRAIN = false;
    bf16_t* C;
    __device__ __forceinline__ void operator()(const f32x4 (&acc)[2][2][4][2], const Unit& u, int wr, int wc, int fr, int fq) const {
        const int row0 = u.pm * 256 + wr * 64 + fr, col0 = u.pn * 256 + wc * 32 + 8 * fq;
#pragma unroll
        for (int ai = 0; ai < 2; ++ai)
#pragma unroll
            for (int m = 0; m < 4; ++m) { const size_t off = (size_t)(row0 + ai * 128 + m * 16) * D + col0;
#pragma unroll
                for (int bj = 0; bj < 2; ++bj) { const f32x4 v0 = acc[ai][bj][m][0], v1 = acc[ai][bj][m][1]; u32x4 w;
                    w.x = cvt_pk_bf16(v0[0], v0[1]); w.y = cvt_pk_bf16(v0[2], v0[3]); w.z = cvt_pk_bf16(v1[0], v1[1]); w.w = cvt_pk_bf16(v1[2], v1[3]); *(u32x4*)(C + off + bj * 128) = w; } }
    }
};
struct EpiH2 {
    static constexpr bool PERM = true, AFTER_DRAIN = false;
    const bf16_t* H1; const bf16_t* PP; bf16_t* out;
    __device__ __forceinline__ void operator()(const f32x4 (&acc)[2][2][4][2], const Unit& u, int wr, int wc, int fr, int fq) const {
        const int row0 = u.pm * 256 + wr * 64 + fr, col0 = u.pn * 256 + wc * 32 + 8 * fq;
#pragma unroll
        for (int ai = 0; ai < 2; ++ai)
#pragma unroll
            for (int mp = 0; mp < 2; ++mp) {
                u32x4 qh[2][2], qp[2][2];
#pragma unroll
                for (int mm = 0; mm < 2; ++mm)
#pragma unroll
                    for (int bj = 0; bj < 2; ++bj) { const size_t o = (size_t)(row0 + ai * 128 + (mp * 2 + mm) * 16) * D + col0 + bj * 128; qh[mm][bj] = *(const u32x4*)(H1 + o); qp[mm][bj] = *(const u32x4*)(PP + o); }
#pragma unroll
                for (int mm = 0; mm < 2; ++mm)
#pragma unroll
                    for (int bj = 0; bj < 2; ++bj) { const int m = mp * 2 + mm; const size_t o = (size_t)(row0 + ai * 128 + m * 16) * D + col0 + bj * 128; float h[8], p[8]; unpack8(qh[mm][bj], h); unpack8(qp[mm][bj], p);
                        const f32x4 g0 = acc[ai][bj][m][0], g1 = acc[ai][bj][m][1]; f32x4 v0, v1;
#pragma unroll
                        for (int e = 0; e < 4; ++e) { v0[e] = h[e] + sigmoidf_(g0[e]) * p[e]; v1[e] = h[4 + e] + sigmoidf_(g1[e]) * p[4 + e]; }
                        u32x4 w; w.x = cvt_pk_bf16(v0[0], v0[1]); w.y = cvt_pk_bf16(v0[2], v0[3]); w.z = cvt_pk_bf16(v1[0], v1[1]); w.w = cvt_pk_bf16(v1[2], v1[3]); *(u32x4*)(out + o) = w; }
                asm volatile("" ::: "memory"); }
    }
};

struct P0Job { const float* src; bf16_t* dst; const float* gsc; int K, N, k0, n0; };
__device__ __forceinline__ P0Job p0_decode(const Args& a, int job) {
    constexpr int NJ_IN = 16 * 68, NJ_SQ = 256, NJ_PP = 64, NJ_LO = 8;
    unsigned char* ws = a.ws; P0Job J; J.gsc = nullptr; int kt, nt; int j = job;
    if (j < NJ_IN) { J.src = a.in[8]; J.dst = (bf16_t*)(ws + OFF_WIN); J.gsc = a.in[7]; J.K = 1024; J.N = NZ; kt = j & 15; nt = j >> 4; }
    else if ((j -= NJ_IN) < NJ_SQ) { J.src = a.in[20]; J.dst = (bf16_t*)(ws + OFF_WOUT); J.K = 1024; J.N = 1024; kt = j & 15; nt = j >> 4; }
    else if ((j -= NJ_SQ) < NJ_SQ) { J.src = a.in[21]; J.dst = (bf16_t*)(ws + OFF_WPG); J.K = 1024; J.N = 1024; kt = j & 15; nt = j >> 4; }
    else if ((j -= NJ_SQ) < NJ_PP) { J.src = a.in[22]; J.dst = (bf16_t*)(ws + OFF_WPP); J.K = 256; J.N = 1024; kt = j & 3; nt = j >> 2; }
    else if ((j -= NJ_PP) < NJ_LO) { J.src = a.in[12]; J.dst = (bf16_t*)(ws + OFF_WUP); J.K = 64; J.N = 512; kt = 0; nt = j; }
    else { j -= NJ_LO; J.src = a.in[14]; J.dst = (bf16_t*)(ws + OFF_AUP); J.K = 64; J.N = 512; kt = 0; nt = j; }
    J.k0 = kt * 64; J.n0 = nt * 64; return J;
}
__device__ void p0_prep(const Args& a, LAS unsigned char* lds) {
    const int tid = threadIdx.x, G = gridDim.x, blk = blockIdx.x, wave = tid >> 6, lane = tid & 63;
    LAS float* tile = (LAS float*)lds;
    unsigned char* ws = a.ws;
    constexpr int NJOBS = 16 * 68 + 2 * 256 + 64 + 2 * 8, MAXJ = 7;
    const int li = tid >> 4, lj = (tid & 15) * 4;
    for (int base = blk; base < NJOBS; base += G * MAXJ) {
        f32x4 v[MAXJ][2];
#pragma unroll
        for (int sl = 0; sl < MAXJ; ++sl) { const int job = base + sl * G;
            if (job < NJOBS) { const P0Job J = p0_decode(a, job);
#pragma unroll
                for (int q = 0; q < 2; ++q) { const int i = li + 32 * q; f32x4 x = {0.f, 0.f, 0.f, 0.f};
                    if (J.n0 + lj < J.N) { x = *(const f32x4*)(J.src + (size_t)(J.k0 + i) * J.N + J.n0 + lj); if (J.gsc) x = x * J.gsc[J.k0 + i]; }
                    v[sl][q] = x; } } }
#pragma unroll
        for (int sl = 0; sl < MAXJ; ++sl) { const int job = base + sl * G;
            if (job < NJOBS) { const P0Job J = p0_decode(a, job);
#pragma unroll
                for (int q = 0; q < 2; ++q) { const int i = li + 32 * q;
#pragma unroll
                    for (int e = 0; e < 4; ++e) tile[i * 65 + lj + e] = v[sl][q][e]; }
                LBAR();
#pragma unroll
                for (int it = 0; it < 4; ++it) { const int item = it * 512 + tid, jj = item >> 5, i2 = item & 31;
                    *(unsigned*)(J.dst + (size_t)(J.n0 + jj) * J.K + J.k0 + 2 * i2) = cvt_pk_bf16(tile[(2 * i2) * 65 + jj], tile[(2 * i2 + 1) * 65 + jj]); }
                LBAR(); } }
    }
    bf16_t* XB = (bf16_t*)a.out; float* RS = (float*)(ws + OFF_RS);
    for (int row0 = (blk * 8 + wave) * 2; row0 < MT; row0 += G * 16) {
        f32x4 v[2][4];
#pragma unroll
        for (int r = 0; r < 2; ++r) { const int row = row0 + r; const float* src = row < MP ? a.in[0] + (size_t)row * D : a.in[1] + (size_t)(row - MP) * D;
#pragma unroll
            for (int i = 0; i < 4; ++i) v[r][i] = *(const f32x4*)(src + i * 256 + lane * 4); }
#pragma unroll
        for (int r = 0; r < 2; ++r) { const int row = row0 + r; float ss = 0.f;
#pragma unroll
            for (int i = 0; i < 4; ++i) { const f32x4 x = v[r][i]; ss += x[0] * x[0] + x[1] * x[1] + x[2] * x[2] + x[3] * x[3];
                *(u32x2*)(XB + (size_t)row * D + i * 256 + lane * 4) = pack4(x[0], x[1], x[2], x[3]); }
#pragma unroll
            for (int o = 32; o >= 1; o >>= 1) ss += __shfl_xor(ss, o);
            if (lane == 0) RS[row] = rsqrtf(ss * (1.0f / D) + 1e-6f); }
    }
    bf16_t* PB = (bf16_t*)(ws + OFF_PB);
    constexpr size_t NP4 = (size_t)MT * DP / 4;
    for (size_t i0 = (size_t)blk * 512 + tid; i0 < NP4; i0 += (size_t)G * 512 * 4) {
        f32x4 v[4];
#pragma unroll
        for (int u = 0; u < 4; ++u) { const size_t i = i0 + (size_t)u * G * 512; const size_t e = i * 4;
            if (i < NP4) v[u] = e < (size_t)MP * DP ? *(const f32x4*)(a.in[2] + e) : *(const f32x4*)(a.in[3] + (e - (size_t)MP * DP)); }
#pragma unroll
        for (int u = 0; u < 4; ++u) { const size_t i = i0 + (size_t)u * G * 512; if (i < NP4) *(u32x2*)(PB + i * 4) = pack4(v[u][0], v[u][1], v[u][2], v[u][3]); }
    }
}

__device__ void p1_gemm_in(const Args& a, LAS unsigned char* lds) {
    const int tid = threadIdx.x, G = gridDim.x, blk = blockIdx.x, wave = tid >> 6, lane = tid & 63, fr = lane & 15, fq = lane >> 4;
    unsigned char* ws = a.ws;
    const bf16_t* XB = (const bf16_t*)a.out; const bf16_t* WinT = (const bf16_t*)(ws + OFF_WIN); const float* RS = (const float*)(ws + OFF_RS); bf16_t* Z = (bf16_t*)(ws + OFF_Z);
    {
        pg8::Gemm g{XB, WinT, MP + 256, NZP, D}; pg8::StaticOrder S; S.init(MP + 256, NZP, G, blk); EpiZ E{Z, RS};
        pg8::gemm_phase<EpiZ, pg8::StaticOrder>(lds, g, S, E, nullptr);
    }
    const bool r256 = (G == 256);
    if (!r256 || blk >= 81) {
        const bf16_t* PB = (const bf16_t*)(ws + OFF_PB); const bf16_t* WppT = (const bf16_t*)(ws + OFF_WPP); bf16_t* PP = (bf16_t*)((unsigned char*)a.out + PPD_OFF);
        pg8::Gemm g{PB, WppT, MP, D, DP}; pg8::StaticOrder S; S.init(MP, D, r256 ? 175 : G, r256 ? blk - 81 : blk); EpiF32 E{PP};
        pg8::gemm_phase<EpiF32, pg8::StaticOrder>(lds, g, S, E, nullptr);
    }
}

template <bool smp> __device__ void p2_tile(const Args& a, LAS unsigned char* lds, int tile) {
    const int tid = threadIdx.x, wave = tid >> 6, lane = tid & 63, fr = lane & 15, fq = lane >> 4;
    unsigned char* ws = a.ws;
    const int ntok = smp ? 8 : 64;
    const int m0 = smp ? MP + (tile - 256) * 8 : tile * 64;
    const int t0 = smp ? 0 : (tile & 31) * 64;
    const int bidx = tile >> 5;
    const bf16_t* __restrict__ Z = (const bf16_t*)(ws + OFF_Z); bf16_t* __restrict__ YC = (bf16_t*)a.out; bf16_t* __restrict__ SCN = (bf16_t*)(ws + OFF_SCNS) - (size_t)MP * 8 * 384;
    const float* state_conv = a.in[4]; const float* state_shift = a.in[5]; const float* conv_w = a.in[9]; const float* mu = a.in[10];
    {
        const int c0 = (tid & 63) * 8;
        float cw0[8], cw1[8], cw2[8];
#pragma unroll
        for (int i = 0; i < 8; ++i) { cw0[i] = conv_w[c0 + i]; cw1[i] = conv_w[512 + c0 + i]; cw2[i] = conv_w[1024 + c0 + i]; }
#pragma unroll 2
        for (int tok = tid >> 6; tok < ntok; tok += 8) {
            const int m = m0 + tok, t = t0 + tok;
            const bf16_t* zr = Z + (size_t)m * NZ;
            float fB[8], fC[8], fH[8], fG[8], u0[8], u1[8], u2[8];
            const u32x4 qB = *(const u32x4*)(zr + c0), qC = *(const u32x4*)(zr + 512 + c0), qH = *(const u32x4*)(zr + 1024 + c0), qG = *(const u32x4*)(zr + 1536 + c0);
            if (smp) {
                const float* sc = state_conv + (size_t)(m - MP) * 1024 + c0;
                const f32x4 x0 = *(const f32x4*)(sc), x1 = *(const f32x4*)(sc + 4), y0 = *(const f32x4*)(sc + 512), y1 = *(const f32x4*)(sc + 516);
#pragma unroll
                for (int i = 0; i < 4; ++i) { u2[i] = x0[i]; u2[4 + i] = x1[i]; u1[i] = y0[i]; u1[4 + i] = y1[i]; }
            } else {
                const bf16_t* z1 = t >= 1 ? zr - NZ : zr; const bf16_t* z2 = t >= 2 ? zr - 2 * NZ : zr;
                const u32x4 qC1 = *(const u32x4*)(z1 + 512 + c0), qH1 = *(const u32x4*)(z1 + 1024 + c0), qC2 = *(const u32x4*)(z2 + 512 + c0), qH2 = *(const u32x4*)(z2 + 1024 + c0);
                float c1[8], h1[8], c2[8], h2[8]; unpack8(qC1, c1); unpack8(qH1, h1); unpack8(qC2, c2); unpack8(qH2, h2);
                const float f1 = t >= 1 ? 1.f : 0.f, f2 = t >= 2 ? 1.f : 0.f;
#pragma unroll
                for (int i = 0; i < 8; ++i) { u1[i] = c1[i] * h1[i] * f1; u2[i] = c2[i] * h2[i] * f2; }
            }
            unpack8(qB, fB); unpack8(qC, fC); unpack8(qH, fH); unpack8(qG, fG);
            float y[8];
#pragma unroll
            for (int i = 0; i < 8; ++i) { u0[i] = fC[i] * fH[i]; const float cv = cw0[i] * u2[i] + cw1[i] * u1[i] + cw2[i] * u0[i]; y[i] = fB[i] * cv * siluf_(fG[i]); }
            *(u32x4*)(YC + (size_t)m * D + c0) = pack8(y);
            { float gr[8]; unpack8(*(const u32x4*)(zr + ZC_GR + c0), gr);
#pragma unroll
              for (int i = 0; i < 8; ++i) gr[i] = siluf_(gr[i]);
              *(u32x4*)(YC + (size_t)m * D + 512 + c0) = pack8(gr); }
            float* co = nullptr;
            if (smp) co = a.out + O_CONVS + (size_t)(m - MP) * 1024 + c0; else if (t == TSEQ - 1) co = a.out + O_CONVP + (size_t)bidx * 1024 + c0;
            if (co) {
                *(f32x4*)(co) = (f32x4){u1[0], u1[1], u1[2], u1[3]}; *(f32x4*)(co + 4) = (f32x4){u1[4], u1[5], u1[6], u1[7]};
                *(f32x4*)(co + 512) = (f32x4){u0[0], u0[1], u0[2], u0[3]}; *(f32x4*)(co + 516) = (f32x4){u0[4], u0[5], u0[6], u0[7]}; }
        }
    }
    LAS bf16_t* Awd = (LAS bf16_t*)lds; LAS bf16_t* Aad = Awd + 64 * 72;
    if (smp) {
        const int j0 = (tid & 15) * 8;
        f32x4 m0v = *(const f32x4*)(mu + 1536 + j0), m1v = *(const f32x4*)(mu + 1536 + j0 + 4);
#pragma unroll 2
        for (int tok = tid >> 4; tok < ntok; tok += 32) {
            const int m = m0 + tok;
            const bf16_t* zr = Z + (size_t)m * NZ + ZC_S + 1536 + j0;
            float cur[8], prev[8], zm[8];
            unpack8(*(const u32x4*)zr, cur);
            if (smp) { const float* sp = state_shift + (size_t)(m - MP) * SW + 1536 + j0; const f32x4 x0 = *(const f32x4*)sp, x1 = *(const f32x4*)(sp + 4);
#pragma unroll
                for (int i = 0; i < 4; ++i) { prev[i] = x0[i]; prev[4 + i] = x1[i]; } }
            else { const bool hp = (t0 + tok) >= 1; unpack8(*(const u32x4*)(hp ? zr - NZ : zr), prev);
                if (!hp) {
#pragma unroll
                    for (int i = 0; i < 8; ++i) prev[i] = 0.f; } }
#pragma unroll
            for (int i = 0; i < 8; ++i) { const float mm = i < 4 ? m0v[i] : m1v[i - 4]; zm[i] = cur[i] + (prev[i] - cur[i]) * mm; }
            if (j0 < 64) {
#pragma unroll
                for (int i = 0; i < 8; ++i) { const float e2 = __expf(2.0f * zm[i]); zm[i] = 1.0f - 2.0f * __builtin_amdgcn_rcpf(e2 + 1.0f); }
                *(LAS u32x4*)(Awd + tok * 72 + j0) = pack8(zm);
            } else *(LAS u32x4*)(Aad + tok * 72 + (j0 - 64)) = pack8(zm);
        }
    }
    __syncthreads();
    if (smp) {
        const int h = wave;
        const bf16_t* WupT = (const bf16_t*)(ws + OFF_WUP); const bf16_t* AupT = (const bf16_t*)(ws + OFF_AUP);
        const float* __restrict__ w0 = a.in[11]; const float* __restrict__ a0p = a.in[13]; const float* __restrict__ k_k = a.in[15]; const float* __restrict__ k_a = a.in[16];
        const int nmt = (ntok + 15) >> 4;
#pragma unroll 1
        for (int mt = 0; mt < nmt; ++mt) {
            u32x2 zc[4][3], zq[4][3];
            {   const int tok_ = (mt * 16 + fr) < ntok ? (mt * 16 + fr) : 0; const bf16_t* zr_ = Z + (size_t)(m0 + tok_) * NZ + ZC_S; const bf16_t* zp_ = ((!smp) && (t0 + tok_ >= 1)) ? zr_ - NZ : zr_;
#pragma unroll
                for (int nt = 0; nt < 4; ++nt) { const int c = h * 64 + nt * 16 + 4 * fq;
                    zc[nt][0] = *(const u32x2*)(zr_ + c); zc[nt][1] = *(const u32x2*)(zr_ + 512 + c); zc[nt][2] = *(const u32x2*)(zr_ + 1024 + c);
                    if (!smp) { zq[nt][0] = *(const u32x2*)(zp_ + c); zq[nt][1] = *(const u32x2*)(zp_ + 512 + c); zq[nt][2] = *(const u32x2*)(zp_ + 1024 + c); } } }
            bf16x8 aw[2], aa[2];
#pragma unroll
            for (int ks = 0; ks < 2; ++ks) { aw[ks] = *(const LAS bf16x8*)(Awd + (mt * 16 + fr) * 72 + ks * 32 + fq * 8); aa[ks] = *(const LAS bf16x8*)(Aad + (mt * 16 + fr) * 72 + ks * 32 + fq * 8); }
            f32x4 accw[4], acca[4];
#pragma unroll
            for (int nt = 0; nt < 4; ++nt) { accw[nt] = (f32x4){0.f, 0.f, 0.f, 0.f}; acca[nt] = (f32x4){0.f, 0.f, 0.f, 0.f};
#pragma unroll
                for (int ks = 0; ks < 2; ++ks) { const size_t bo = (size_t)(h * 64 + nt * 16 + fr) * 64 + ks * 32 + fq * 8;
                    accw[nt] = __builtin_amdgcn_mfma_f32_16x16x32_bf16(*(const bf16x8*)(WupT + bo), aw[ks], accw[nt], 0, 0, 0);
                    acca[nt] = __builtin_amdgcn_mfma_f32_16x16x32_bf16(*(const bf16x8*)(AupT + bo), aa[ks], acca[nt], 0, 0, 0); } }
            const bool valid = (mt * 16 + fr) < ntok;
            const int tok = valid ? (mt * 16 + fr) : 0, m = m0 + tok, t = t0 + tok;
            const bf16_t* zr = Z + (size_t)m * NZ + ZC_S;
            const bool hasprev = (!smp) && (t >= 1);
            const bf16_t* zp = hasprev ? zr - NZ : zr;
            const float fp = hasprev ? 1.f : 0.f;
            bf16_t* so = SCN + ((size_t)m * 8 + h) * 384 + 4 * fq;
            float kk[4][4], av[4][4]; float ss = 0.f;
#pragma unroll
            for (int nt = 0; nt < 4; ++nt) {
                const int c = h * 64 + nt * 16 + 4 * fq;
                float cr[4], ck[4], cv[4], pr[4], pk[4], pv[4];
                unpack4(zc[nt][0], cr); unpack4(zc[nt][1], ck); unpack4(zc[nt][2], cv);
                if (smp) { const float* sp = state_shift + (size_t)(m - MP) * SW + c; const f32x4 x0 = *(const f32x4*)sp, x1 = *(const f32x4*)(sp + 512), x2 = *(const f32x4*)(sp + 1024);
#pragma unroll
                    for (int i = 0; i < 4; ++i) { pr[i] = x0[i]; pk[i] = x1[i]; pv[i] = x2[i]; } }
                else { unpack4(zq[nt][0], pr); unpack4(zq[nt][1], pk); unpack4(zq[nt][2], pv);
#pragma unroll
                    for (int i = 0; i < 4; ++i) { pr[i] *= fp; pk[i] *= fp; pv[i] *= fp; } }
                const f32x4 mr = *(const f32x4*)(mu + c), mk = *(const f32x4*)(mu + 512 + c), mv = *(const f32x4*)(mu + 1024 + c);
                const f32x4 w0v = *(const f32x4*)(w0 + c), a0v = *(const f32x4*)(a0p + c), kkv = *(const f32x4*)(k_k + c), kav = *(const f32x4*)(k_a + c);
                float r_[4], e_[4], kp[4], v_[4];
#pragma unroll
                for (int i = 0; i < 4; ++i) {
                    r_[i] = cr[i] + (pr[i] - cr[i]) * mr[i]; const float k = ck[i] + (pk[i] - ck[i]) * mk[i]; v_[i] = cv[i] + (pv[i] - cv[i]) * mv[i];
                    e_[i] = 0.60653065971f * sigmoidf_(w0v[i] + accw[nt][i]);
                    const float al = sigmoidf_(a0v[i] + acca[nt][i]); av[nt][i] = al;
                    const float kq = k * kkv[i]; kk[nt][i] = kq; ss += kq * kq;
                    kp[i] = k * (1.0f + (al - 1.0f) * kav[i]);
                }
                if (valid) {
                *(u32x2*)(so + 0 * 64 + nt * 16) = pack4(r_[0], r_[1], r_[2], r_[3]);
                *(u32x2*)(so + 1 * 64 + nt * 16) = pack4(e_[0], e_[1], e_[2], e_[3]);
                *(u32x2*)(so + 2 * 64 + nt * 16) = pack4(kp[0], kp[1], kp[2], kp[3]);
                *(u32x2*)(so + 3 * 64 + nt * 16) = pack4(v_[0], v_[1], v_[2], v_[3]); }
            }
            ss += __shfl_xor(ss, 16); ss += __shfl_xor(ss, 32);
            const float inv = 1.0f / fmaxf(sqrtf(ss), 1e-12f);
#pragma unroll
            for (int nt = 0; nt < 4; ++nt) {
                float q[4], b[4];
#pragma unroll
                for (int i = 0; i < 4; ++i) { q[i] = kk[nt][i] * inv; b[i] = q[i] * av[nt][i]; }
                if (valid) {
                *(u32x2*)(so + 4 * 64 + nt * 16) = pack4(q[0], q[1], q[2], q[3]);
                *(u32x2*)(so + 5 * 64 + nt * 16) = pack4(b[0], b[1], b[2], b[3]); }
            }
        }
    }
    if (!smp && (tile & 31) == 31) { for (int j = tid; j < SW; j += 512) a.out[O_SHIFTP + (size_t)bidx * SW + j] = bf2f(Z[(size_t)(m0 + 63) * NZ + ZC_S + j]); }
    __syncthreads();
}
__device__ void p2_all(const Args& a, LAS unsigned char* lds) {
    const int tid = threadIdx.x, G = gridDim.x, blk = blockIdx.x;
    for (int t = blk; t < 272; t += G) { if (t < 256) p2_tile<false>(a, lds, t); else p2_tile<true>(a, lds, t); }
    const bf16_t* Z = (const bf16_t*)(a.ws + OFF_Z);
    for (int idx = blk * 512 + tid; idx < MS * SW; idx += G * 512) { const int sidx = idx / SW, j = idx - sidx * SW; a.out[O_SHIFTS + idx] = bf2f(Z[(size_t)(MP + sidx) * NZ + ZC_S + j]); }
}

constexpr int SLOT = 64 * 72;
__device__ __forceinline__ void mm_nt(const LAS bf16_t* X, const LAS bf16_t* Y, int it, int jt0, int fr, int fq, f32x4 (&acc)[2]) {
    bf16x8 xa[2];
#pragma unroll
    for (int ks = 0; ks < 2; ++ks) xa[ks] = *(const LAS bf16x8*)(X + (it * 16 + fr) * 72 + ks * 32 + fq * 8);
#pragma unroll
    for (int u = 0; u < 2; ++u)
#pragma unroll
        for (int ks = 0; ks < 2; ++ks) acc[u] = __builtin_amdgcn_mfma_f32_16x16x32_bf16(*(const LAS bf16x8*)(Y + ((jt0 + u) * 16 + fr) * 72 + ks * 32 + fq * 8), xa[ks], acc[u], 0, 0, 0);
}
template <int MASK> __device__ __forceinline__ f32x4 mask4(f32x4 v, int i, int j0) {
#pragma unroll
    for (int e = 0; e < 4; ++e) { const int j = j0 + e; const bool keep = MASK == 0 ? true : MASK == 1 ? (j < i) : MASK == 2 ? (j > i) : (j <= i); v[e] = keep ? v[e] : 0.f; }
    return v;
}
__device__ __forceinline__ void st4(LAS bf16_t* dst, int i, int j0, f32x4 v) { *(LAS u32x2*)(dst + i * 72 + j0) = pack4(v[0], v[1], v[2], v[3]); }
__device__ __forceinline__ f32x4 ld4(const LAS bf16_t* src, int i, int j0) { float f[4]; unpack4(*(const LAS u32x2*)(src + i * 72 + j0), f); return (f32x4){f[0], f[1], f[2], f[3]}; }
__device__ __forceinline__ void st4t(LAS bf16_t* dst, int i, int j0, f32x4 v) {
    const unsigned lo = cvt_pk_bf16(v[0], v[1]), hi = cvt_pk_bf16(v[2], v[3]);
    dst[(j0 + 0) * 72 + i] = (bf16_t)(lo & 0xffffu); dst[(j0 + 1) * 72 + i] = (bf16_t)(lo >> 16); dst[(j0 + 2) * 72 + i] = (bf16_t)(hi & 0xffffu); dst[(j0 + 3) * 72 + i] = (bf16_t)(hi >> 16); }
__device__ __forceinline__ void stg4(bf16_t* dst, int i, int j0, f32x4 v) { *(u32x2*)(dst + i * 64 + j0) = pack4(v[0], v[1], v[2], v[3]); }
#define ZACC() do { acc[0] = (f32x4){0.f, 0.f, 0.f, 0.f}; acc[1] = (f32x4){0.f, 0.f, 0.f, 0.f}; } while (0)

__device__ void p3a_chunks(const Args& a, LAS unsigned char* lds) {
    const int tid = threadIdx.x, G = gridDim.x, blk = blockIdx.x, wave = tid >> 6, lane = tid & 63, fr = lane & 15, fq = lane >> 4;
    unsigned char* ws = a.ws;
    const bf16_t* SCN = (const bf16_t*)(ws + OFF_SCNS) - (size_t)MP * 8 * 384;
    bf16_t* CHK = (bf16_t*)(ws + OFF_CHK); const bf16_t* Z = (const bf16_t*)(ws + OFF_Z); float* RK = (float*)(ws + OFF_RK);
    const bf16_t* WupT = (const bf16_t*)(ws + OFF_WUP); const bf16_t* AupT = (const bf16_t*)(ws + OFF_AUP);
    LAS bf16_t* SL = (LAS bf16_t*)lds;
#define S_(n) (SL + (n) * SLOT)
    LAS bf16_t* zraw = S_(8);
    LAS float* tot = (LAS float*)(lds + 17 * SLOT * 2);
    LAS float* pc = tot + 512;
    LAS float* LWf = (LAS float*)(lds + 2 * SLOT * 2);
    LAS float* LAf = (LAS float*)(lds + 4 * SLOT * 2);
    const int it = wave >> 1, jt0 = (wave & 1) * 2, irow = it * 16 + fr;
    u32x4 rg[6];
#define P3A_LOAD(unit_) do { const int bh_ = (unit_) >> 5, c_ = (unit_) & 31; const int mm0 = (bh_ >> 3) * TSEQ + c_ * 64; const int hh = bh_ & 7; \
        _Pragma("unroll") for (int i = 0; i < 6; ++i) { const int p = tid + 512 * i; if (p < 65 * 40) { const int rr = p / 40, sg = p - rr * 40, seg = sg >> 3, o8 = sg & 7; \
            const int col = seg < 3 ? (ZC_S + seg * 512 + hh * 64) : (ZC_S + 1536 + (seg - 3) * 64); const int mrow = (rr == 0 && c_ == 0) ? mm0 : (mm0 - 1 + rr); \
            rg[i] = *(const u32x4*)(Z + (size_t)mrow * NZ + col + o8 * 8); } } } while (0)
    if (blk < 2048) P3A_LOAD(blk);
    int hcur = -1;
    float mur = 0.f, muk = 0.f, muv = 0.f, muwd = 0.f, muad = 0.f, w0k = 0.f, a0k = 0.f, kkk = 0.f, kak = 0.f, rkk = 0.f;
    for (int unit = blk; unit < 2048; unit += G) {
        const int h = (unit >> 5) & 7, c = unit & 31, k = tid & 63, g = tid >> 6;
        if (h != hcur) {
            const float* mu = a.in[10];
            mur = mu[h * 64 + k]; muk = mu[512 + h * 64 + k]; muv = mu[1024 + h * 64 + k]; muwd = mu[1536 + k]; muad = mu[1600 + k];
            w0k = a.in[11][h * 64 + k]; a0k = a.in[13][h * 64 + k]; kkk = a.in[15][h * 64 + k]; kak = a.in[16][h * 64 + k]; rkk = a.in[17][h * 64 + k];
            const int row = tid >> 3, o8 = tid & 7;
            *(LAS u32x4*)(S_(15) + row * 72 + o8 * 8) = *(const u32x4*)(WupT + (size_t)(h * 64 + row) * 64 + o8 * 8);
            *(LAS u32x4*)(S_(16) + row * 72 + o8 * 8) = *(const u32x4*)(AupT + (size_t)(h * 64 + row) * 64 + o8 * 8);
            hcur = h; }
#pragma unroll
        for (int i = 0; i < 6; ++i) { const int p = tid + 512 * i; if (p < 65 * 40) { const int rr = p / 40, sg = p - rr * 40, seg = sg >> 3, o8 = sg & 7; *(LAS u32x4*)(zraw + rr * 320 + seg * 64 + o8 * 8) = rg[i]; } }
        LBAR();
        float r_[8], kx[8], v_[8];
        {
            const float fp0 = (c != 0) ? 1.f : 0.f;
            float zz[9][5];
#pragma unroll
            for (int rr = 0; rr < 9; ++rr) { const LAS bf16_t* zp_ = zraw + (g * 8 + rr) * 320 + k;
#pragma unroll
                for (int sg = 0; sg < 5; ++sg) zz[rr][sg] = bf2f(zp_[sg * 64]); }
            if (g == 0) {
#pragma unroll
                for (int sg = 0; sg < 5; ++sg) zz[0][sg] *= fp0; }
#pragma unroll
            for (int j = 0; j < 8; ++j) { const int t = g * 8 + j;
                const float c0 = zz[j + 1][0], c1 = zz[j + 1][1], c2 = zz[j + 1][2], c3 = zz[j + 1][3], c4 = zz[j + 1][4];
                const float p0 = zz[j][0], p1 = zz[j][1], p2 = zz[j][2], p3 = zz[j][3], p4 = zz[j][4];
                r_[j] = c0 + (p0 - c0) * mur; kx[j] = c1 + (p1 - c1) * muk; v_[j] = c2 + (p2 - c2) * muv;
                const float wd = c3 + (p3 - c3) * muwd, ad = c4 + (p4 - c4) * muad;
                const float e2 = __expf(2.0f * wd);
                S_(0)[t * 72 + k] = f2bf(1.0f - 2.0f * __builtin_amdgcn_rcpf(e2 + 1.0f)); S_(1)[t * 72 + k] = f2bf(ad); }
        }
        LBAR();
        f32x4 acc[2];
        ZACC(); mm_nt(S_(0), S_(15), it, jt0, fr, fq, acc);
#pragma unroll
        for (int u = 0; u < 2; ++u) *(LAS f32x4*)(LWf + irow * 64 + (jt0 + u) * 16 + 4 * fq) = acc[u];
        ZACC(); mm_nt(S_(1), S_(16), it, jt0, fr, fq, acc);
#pragma unroll
        for (int u = 0; u < 2; ++u) *(LAS f32x4*)(LAf + irow * 64 + (jt0 + u) * 16 + 4 * fq) = acc[u];
        LBAR();
        {
            float ev[8], cs[8], qn[8], bbv[8], kpv[8]; float run = 0.f;
#pragma unroll
            for (int j = 0; j < 8; ++j) { const int t = g * 8 + j;
                const float e = 0.60653065971f * sigmoidf_(w0k + LWf[t * 64 + k]); const float al = sigmoidf_(a0k + LAf[t * 64 + k]);
                const float kq = kx[j] * kkk, kp = kx[j] * (1.0f + (al - 1.0f) * kak);
                float ss = kq * kq, rs_ = r_[j] * kp * rkk;
                ss = rowsum16(ss); rs_ = rowsum16(rs_);
                ss += __shfl_xor(ss, 16); rs_ += __shfl_xor(rs_, 16); ss += __shfl_xor(ss, 32); rs_ += __shfl_xor(rs_, 32);
                const float inv = __builtin_amdgcn_rsqf(fmaxf(ss, 1e-24f));
                qn[j] = kq * inv; bbv[j] = qn[j] * al; kpv[j] = kp;
                if (lane == 0) RK[(size_t)unit * 64 + t] = rs_;
                ev[j] = e; run += e; cs[j] = run; }
            tot[g * 64 + k] = run;
            LBAR();
            float off = 0.f;
#pragma unroll
            for (int gg = 0; gg < 7; ++gg) { const float tv = tot[gg * 64 + k]; off += gg < g ? tv : 0.f; }
            float ak[8], bk[8], kk_[8];
#pragma unroll
            for (int j = 0; j < 8; ++j) { const int t = g * 8 + j; const float cum = off + cs[j];
                const float P = __expf(-cum), Pm1 = __expf(ev[j] - cum), iP = __builtin_amdgcn_rcpf(P);
                const float at = -qn[j] * Pm1, bt = bbv[j] * iP, kt = kpv[j] * iP, rt = r_[j] * P;
                S_(0)[t * 72 + k] = f2bf(at); S_(1)[t * 72 + k] = f2bf(bt); S_(2)[t * 72 + k] = f2bf(kt); S_(3)[t * 72 + k] = f2bf(rt);
                ak[j] = at; bk[j] = bt; kk_[j] = kt;
                if (j == 7 && g == 7) pc[k] = P; }
            *(LAS u32x4*)(S_(4) + k * 72 + g * 8) = pack8(ak); *(LAS u32x4*)(S_(5) + k * 72 + g * 8) = pack8(bk);
            *(LAS u32x4*)(S_(6) + k * 72 + g * 8) = pack8(kk_); *(LAS u32x4*)(S_(7) + k * 72 + g * 8) = pack8(v_);
        }
        LBAR();
        { const int nxt = (unit + G < 2048) ? unit + G : unit; P3A_LOAD(nxt); }
        ZACC(); mm_nt(S_(0), S_(1), it, jt0, fr, fq, acc);
#pragma unroll
        for (int u = 0; u < 2; ++u) { const int j0 = (jt0 + u) * 16 + 4 * fq; f32x4 v = mask4<1>(acc[u], irow, j0); st4(S_(11), irow, j0, v); st4t(S_(12), irow, j0, v);
#pragma unroll
            for (int e = 0; e < 4; ++e) v[e] += (j0 + e == irow) ? 1.f : 0.f;
            st4(S_(13), irow, j0, v); }
        ZACC(); mm_nt(S_(0), S_(2), it, jt0, fr, fq, acc);
#pragma unroll
        for (int u = 0; u < 2; ++u) { const int j0 = (jt0 + u) * 16 + 4 * fq; st4(S_(8), irow, j0, mask4<1>(acc[u], irow, j0)); }
        ZACC(); mm_nt(S_(3), S_(1), it, jt0, fr, fq, acc);
#pragma unroll
        for (int u = 0; u < 2; ++u) { const int j0 = (jt0 + u) * 16 + 4 * fq; st4(S_(9), irow, j0, mask4<3>(acc[u], irow, j0)); }
        ZACC(); mm_nt(S_(3), S_(2), it, jt0, fr, fq, acc);
#pragma unroll
        for (int u = 0; u < 2; ++u) { const int j0 = (jt0 + u) * 16 + 4 * fq; st4(S_(10), irow, j0, mask4<3>(acc[u], irow, j0)); }
        LBAR();
        ZACC(); mm_nt(S_(11), S_(12), it, jt0, fr, fq, acc);
#pragma unroll
        for (int u = 0; u < 2; ++u) { st4(S_(1), irow, (jt0 + u) * 16 + 4 * fq, acc[u]); st4t(S_(2), irow, (jt0 + u) * 16 + 4 * fq, acc[u]); }
        ZACC(); mm_nt(S_(7), S_(8), it, jt0, fr, fq, acc);
#pragma unroll
        for (int u = 0; u < 2; ++u) st4(S_(0), irow, (jt0 + u) * 16 + 4 * fq, acc[u]);
        LBAR();
#pragma unroll
        for (int sgi = 0; sgi < 4; ++sgi) {
            const int pa = (sgi & 1) ? 11 : 1, pta = (sgi & 1) ? 12 : 2, pb = (sgi & 1) ? 1 : 11, ptb = (sgi & 1) ? 2 : 12, tla = (sgi & 1) ? 14 : 13, tlb = (sgi & 1) ? 13 : 14;
            ZACC(); mm_nt(S_(tla), S_(pta), it, jt0, fr, fq, acc);
#pragma unroll
            for (int u = 0; u < 2; ++u) { const int j0 = (jt0 + u) * 16 + 4 * fq; st4(S_(tlb), irow, j0, acc[u] + ld4(S_(tla), irow, j0)); }
            ZACC(); mm_nt(S_(pa), S_(pta), it, jt0, fr, fq, acc);
#pragma unroll
            for (int u = 0; u < 2; ++u) { if (sgi < 3) st4(S_(pb), irow, (jt0 + u) * 16 + 4 * fq, acc[u]); st4t(S_(ptb), irow, (jt0 + u) * 16 + 4 * fq, acc[u]); }
            LBAR();
        }
        ZACC(); mm_nt(S_(13), S_(2), it, jt0, fr, fq, acc);
#pragma unroll
        for (int u = 0; u < 2; ++u) { const int j0 = (jt0 + u) * 16 + 4 * fq; st4(S_(14), irow, j0, acc[u] + ld4(S_(13), irow, j0)); }
        LBAR();
        ZACC(); mm_nt(S_(0), S_(14), it, jt0, fr, fq, acc);
#pragma unroll
        for (int u = 0; u < 2; ++u) st4(S_(1), irow, (jt0 + u) * 16 + 4 * fq, acc[u]);
        ZACC(); mm_nt(S_(4), S_(14), it, jt0, fr, fq, acc);
#pragma unroll
        for (int u = 0; u < 2; ++u) st4(S_(2), irow, (jt0 + u) * 16 + 4 * fq, acc[u]);
        LBAR();
        bf16_t* chk = CHK + (size_t)unit * 16384;
        ZACC();
        mm_nt(S_(9), S_(2), it, jt0, fr, fq, acc);
#pragma unroll
        for (int u = 0; u < 2; ++u) { const int j0 = (jt0 + u) * 16 + 4 * fq; stg4(chk, irow, j0, acc[u] + ld4(S_(3), irow, j0)); }
        ZACC();
        mm_nt(S_(9), S_(1), it, jt0, fr, fq, acc);
        mm_nt(S_(10), S_(7), it, jt0, fr, fq, acc);
#pragma unroll
        for (int u = 0; u < 2; ++u) stg4(chk + 4096, irow, (jt0 + u) * 16 + 4 * fq, acc[u]);
        ZACC();
        mm_nt(S_(1), S_(5), it, jt0, fr, fq, acc);
        mm_nt(S_(7), S_(6), it, jt0, fr, fq, acc);
#pragma unroll
        for (int u = 0; u < 2; ++u) { const int j0 = (jt0 + u) * 16 + 4 * fq; const f32x4 pv = *(const LAS f32x4*)(pc + j0); stg4(chk + 8192, irow, j0, acc[u] * pv); }
        ZACC();
        mm_nt(S_(5), S_(2), it, jt0, fr, fq, acc);
        { const float pr = pc[irow];
#pragma unroll
          for (int u = 0; u < 2; ++u) { const int j0 = (jt0 + u) * 16 + 4 * fq; f32x4 v = acc[u];
#pragma unroll
              for (int e = 0; e < 4; ++e) v[e] = (v[e] + ((j0 + e == irow) ? 1.f : 0.f)) * pr;
              stg4(chk + 12288, irow, j0, v); } }
        LBAR();
    }
#undef P3A_LOAD
#undef S_
}

__device__ void p3_sample_step(const Args& a, int blk, int G) {
    const int tid = threadIdx.x;
    unsigned char* ws = a.ws;
    const bf16_t* SCN = (const bf16_t*)(ws + OFF_SCNS) - (size_t)MP * 8 * 384;
    const float* state_wkv = a.in[6]; bf16_t* OS = (bf16_t*)(ws + OFF_OS);
    const int row = tid >> 3, c0 = (tid & 7) * 8;
    constexpr int NI = 4;
    for (int it0 = blk; it0 < MS * NH; it0 += G * NI) {
        u32x4 q[NI][5]; f32x4 sA[NI], sB[NI]; unsigned short vq[NI];
#pragma unroll
        for (int n = 0; n < NI; ++n) { const int itn = (it0 + n * G < MS * NH) ? it0 + n * G : it0; const int s_ = itn >> 3, h = itn & 7, m = MP + s_;
            const bf16_t* sc = SCN + ((size_t)m * 8 + h) * 384; const size_t so = ((size_t)(s_ * 8 + h) * 64 + row) * 64 + c0;
            q[n][0] = *(const u32x4*)(sc + c0); q[n][1] = *(const u32x4*)(sc + 64 + c0); q[n][2] = *(const u32x4*)(sc + 128 + c0); q[n][3] = *(const u32x4*)(sc + 256 + c0); q[n][4] = *(const u32x4*)(sc + 320 + c0);
            vq[n] = sc[192 + row]; sA[n] = *(const f32x4*)(state_wkv + so); sB[n] = *(const f32x4*)(state_wkv + so + 4); }
#pragma unroll
        for (int n = 0; n < NI; ++n) { const int itn = it0 + n * G; if (itn < MS * NH) { const int s_ = itn >> 3, h = itn & 7;
            float r_[8], e_[8], kp[8], kq[8], bb[8];
            unpack8(q[n][0], r_); unpack8(q[n][1], e_); unpack8(q[n][2], kp); unpack8(q[n][3], kq); unpack8(q[n][4], bb);
            const float vv = bf2f(vq[n]);
            const size_t so = ((size_t)(s_ * 8 + h) * 64 + row) * 64 + c0;
            float S[8] = {sA[n][0], sA[n][1], sA[n][2], sA[n][3], sB[n][0], sB[n][1], sB[n][2], sB[n][3]};
            float d = 0.f;
#pragma unroll
            for (int i = 0; i < 8; ++i) d += S[i] * kq[i];
            d += __shfl_xor(d, 1); d += __shfl_xor(d, 2); d += __shfl_xor(d, 4);
            float y = 0.f;
#pragma unroll
            for (int i = 0; i < 8; ++i) { S[i] = S[i] * __expf(-e_[i]) + (-d) * bb[i] + vv * kp[i]; y += S[i] * r_[i]; }
            y += __shfl_xor(y, 1); y += __shfl_xor(y, 2); y += __shfl_xor(y, 4);
            *(f32x4*)(a.out + O_WKVS + so) = (f32x4){S[0], S[1], S[2], S[3]}; *(f32x4*)(a.out + O_WKVS + so + 4) = (f32x4){S[4], S[5], S[6], S[7]};
            if ((tid & 7) == 0) OS[(size_t)s_ * 512 + h * 64 + row] = f2bf(y); } }
    }
}

__device__ void p3b_seq(const Args& a, LAS unsigned char* lds) {
    const int tid = threadIdx.x, G = gridDim.x, blk = blockIdx.x, wave = tid >> 6, lane = tid & 63, fr = lane & 15, fq = lane >> 4;
    unsigned char* ws = a.ws;
    const bf16_t* CHK = (const bf16_t*)(ws + OFF_CHK); bf16_t* SALL = (bf16_t*)(ws + OFF_SALL);
    LAS bf16_t* Shi = (LAS bf16_t*)lds; LAS bf16_t* Slo = Shi + 2 * 16 * 72;
    for (int item = blk; item < 256; item += G) {
        const int xcd_ = item & 7, idx_ = item >> 3;
        const int bh = (G == 256) ? xcd_ * 8 + (idx_ >> 2) : (item >> 2), q = (G == 256) ? (idx_ & 3) : (item & 3), j = wave;
        LBAR();
        for (int i = tid; i < 16 * 72; i += 512) { Shi[i] = 0; Slo[i] = 0; }
        LBAR();
        const bf16_t* chk0 = CHK + (size_t)(bh * 32) * 16384;
        constexpr int PF = 8;
        const size_t goff = 12288 + (size_t)(j * 16 + fr) * 64 + fq * 8, hoff = 8192 + (size_t)(q * 16 + fr) * 64 + j * 16 + 4 * fq;
        bf16x8 GA0[PF], GA1[PF], GB0[PF], GB1[PF]; u32x2 HA[PF], HB[PF];
#define P3B_LOAD(G0, G1, HQ, c0) do { if (wave < 4) { _Pragma("unroll") for (int u = 0; u < PF; ++u) { const bf16_t* cn = chk0 + (size_t)((c0) + u) * 16384; \
            G0[u] = *(const bf16x8*)(cn + goff); G1[u] = *(const bf16x8*)(cn + goff + 32); HQ[u] = *(const u32x2*)(cn + hoff); } } } while (0)
#define P3B_STEPS(G0, G1, HQ, c0) do { _Pragma("unroll") for (int u = 0; u < PF; ++u) { const int c = (c0) + u; \
            if (wave < 4) { \
                const bf16x8 cg0 = G0[u], cg1 = G1[u]; const u32x2 chq = HQ[u]; \
                const LAS bf16_t* sh = Shi + (c & 1) * (16 * 72) + fr * 72 + fq * 8; const LAS bf16_t* sl = Slo + (c & 1) * (16 * 72) + fr * 72 + fq * 8; \
                const bf16x8 h0 = *(const LAS bf16x8*)sh, h1 = *(const LAS bf16x8*)(sh + 32), l0 = *(const LAS bf16x8*)sl, l1 = *(const LAS bf16x8*)(sl + 32); \
                bf16_t* sg = SALL + (size_t)(bh * 32 + c) * 4096 + (q * 16 + fr) * 64 + fq * 8; \
                if (wave == 0) *(bf16x8*)sg = h0; \
                if (wave == 1) *(bf16x8*)(sg + 32) = h1; \
                f32x4 acc = {0.f, 0.f, 0.f, 0.f}; \
                acc = __builtin_amdgcn_mfma_f32_16x16x32_bf16(cg0, h0, acc, 0, 0, 0); acc = __builtin_amdgcn_mfma_f32_16x16x32_bf16(cg1, h1, acc, 0, 0, 0); \
                acc = __builtin_amdgcn_mfma_f32_16x16x32_bf16(cg0, l0, acc, 0, 0, 0); acc = __builtin_amdgcn_mfma_f32_16x16x32_bf16(cg1, l1, acc, 0, 0, 0); \
                float hv[4]; unpack4(chq, hv); \
                const float s0 = acc[0] + hv[0], s1 = acc[1] + hv[1], s2 = acc[2] + hv[2], s3 = acc[3] + hv[3]; \
                const u32x2 ph = pack4(s0, s1, s2, s3); float hf[4]; unpack4(ph, hf); \
                const u32x2 pl = pack4(s0 - hf[0], s1 - hf[1], s2 - hf[2], s3 - hf[3]); \
                const int wo = ((c + 1) & 1) * (16 * 72) + fr * 72 + j * 16 + 4 * fq; \
                *(LAS u32x2*)(Shi + wo) = ph; *(LAS u32x2*)(Slo + wo) = pl; \
                if (c == 31) *(f32x4*)(a.out + O_WKVP + ((size_t)bh * 64 + q * 16 + fr) * 64 + j * 16 + 4 * fq) = (f32x4){s0, s1, s2, s3}; \
            } \
            LBAR(); } } while (0)
        P3B_LOAD(GA0, GA1, HA, 0); P3B_LOAD(GB0, GB1, HB, 8);
        P3B_STEPS(GA0, GA1, HA, 0); P3B_LOAD(GA0, GA1, HA, 16);
        P3B_STEPS(GB0, GB1, HB, 8); P3B_LOAD(GB0, GB1, HB, 24);
        P3B_STEPS(GA0, GA1, HA, 16);
        P3B_STEPS(GB0, GB1, HB, 24);
#undef P3B_LOAD
#undef P3B_STEPS
    }
}

__device__ void p3c_out(const Args& a) {
    const int tid = threadIdx.x, G = gridDim.x, blk = blockIdx.x, wave = tid >> 6, lane = tid & 63, fr = lane & 15, fq = lane >> 4;
    unsigned char* ws = a.ws;
    const bf16_t* SCN = (const bf16_t*)(ws + OFF_SCNS) - (size_t)MP * 8 * 384; const bf16_t* CHK = (const bf16_t*)(ws + OFF_CHK); const bf16_t* SALL = (const bf16_t*)(ws + OFF_SALL); bf16_t* YC = (bf16_t*)a.out;
    const bf16_t* Z = (const bf16_t*)(ws + OFF_Z); const float* RK = (const float*)(ws + OFF_RK); const float* mu = a.in[10];
    const float* r_k = a.in[17]; const float* ln_w = a.in[18]; const float* ln_b = a.in[19];
    for (int pi = blk; pi < 1024; pi += G) {
        const int unit = pi * 2 + (wave >> 2), it = wave & 3, bh = unit >> 5, c = unit & 31, b = bh >> 3, h = bh & 7;
        const int m = b * TSEQ + c * 64 + it * 16 + fr;
        const bf16_t* chk = CHK + (size_t)unit * 16384; const bf16_t* sall = SALL + (size_t)unit * 4096;
        bf16x8 xq[2];
#pragma unroll
        for (int ks = 0; ks < 2; ++ks) xq[ks] = *(const bf16x8*)(chk + (it * 16 + fr) * 64 + ks * 32 + fq * 8);
        const bool hasprev = (c * 64 + it * 16 + fr) >= 1;
        const bf16_t* zv = Z + (size_t)m * NZ + ZC_S + 1024 + h * 64 + 4 * fq; const bf16_t* zvp = hasprev ? zv - NZ : zv; const float fpv = hasprev ? 1.f : 0.f;
        const float rk = RK[(size_t)unit * 64 + it * 16 + fr];
        bf16_t* yp = YC + (size_t)m * D + 512 + h * 64 + 4 * fq;
        f32x4 acc[4]; u32x2 qy[4], qv[4], qvp[4], qg[4];
#pragma unroll
        for (int jt = 0; jt < 4; ++jt) { qy[jt] = *(const u32x2*)(chk + 4096 + (it * 16 + fr) * 64 + jt * 16 + 4 * fq);
            qv[jt] = *(const u32x2*)(zv + jt * 16); qvp[jt] = *(const u32x2*)(zvp + jt * 16); qg[jt] = *(const u32x2*)(yp + jt * 16); }
#pragma unroll
        for (int jt = 0; jt < 4; ++jt) { acc[jt] = (f32x4){0.f, 0.f, 0.f, 0.f};
#pragma unroll
            for (int ks = 0; ks < 2; ++ks) acc[jt] = __builtin_amdgcn_mfma_f32_16x16x32_bf16(*(const bf16x8*)(sall + (jt * 16 + fr) * 64 + ks * 32 + fq * 8), xq[ks], acc[jt], 0, 0, 0);
        }
        float o[4][4], vv[4][4]; float sm = 0.f;
#pragma unroll
        for (int jt = 0; jt < 4; ++jt) { float yl[4], vc[4], vp[4]; unpack4(qy[jt], yl); unpack4(qv[jt], vc); unpack4(qvp[jt], vp);
            const f32x4 mv = *(const f32x4*)(mu + 1024 + h * 64 + jt * 16 + 4 * fq);
#pragma unroll
            for (int e = 0; e < 4; ++e) { o[jt][e] = acc[jt][e] + yl[e]; sm += o[jt][e]; vv[jt][e] = vc[e] + (vp[e] * fpv - vc[e]) * mv[e]; } }
        sm += __shfl_xor(sm, 16); sm += __shfl_xor(sm, 32);
        const float mean = sm * (1.0f / 64.0f); float var = 0.f;
#pragma unroll
        for (int jt = 0; jt < 4; ++jt)
#pragma unroll
            for (int e = 0; e < 4; ++e) { o[jt][e] -= mean; var += o[jt][e] * o[jt][e]; }
        var += __shfl_xor(var, 16); var += __shfl_xor(var, 32);
        const float rstd = rsqrtf(var * (1.0f / 64.0f) + 64e-5f);
#pragma unroll
        for (int jt = 0; jt < 4; ++jt) { const int ch = h * 64 + jt * 16 + 4 * fq; const f32x4 lw = *(const f32x4*)(ln_w + ch), lb = *(const f32x4*)(ln_b + ch); float gt[4]; unpack4(qg[jt], gt);
            float y[4];
#pragma unroll
            for (int e = 0; e < 4; ++e) { y[e] = (o[jt][e] * rstd * lw[e] + lb[e] + rk * vv[jt][e]) * gt[e];
            }
            *(u32x2*)(yp + jt * 16) = pack4(y[0], y[1], y[2], y[3]); }
    }
    const bf16_t* OS = (const bf16_t*)(ws + OFF_OS);
    const int c = lane * 8, h = lane >> 3, cc = (lane & 7) * 8;
    for (int s = blk * 8 + wave; s < MS; s += G * 8) {
        const int m = MP + s;
        float o[8], r_[8], kp[8], v_[8], g[8];
        const bf16_t* sc = SCN + ((size_t)m * 8 + h) * 384 + cc;
        unpack8(*(const u32x4*)(OS + (size_t)s * 512 + c), o); unpack8(*(const u32x4*)(sc), r_); unpack8(*(const u32x4*)(sc + 128), kp); unpack8(*(const u32x4*)(sc + 192), v_);
        unpack8(*(const u32x4*)(YC + (size_t)m * D + 512 + c), g);
        float sm = 0.f, rk = 0.f;
#pragma unroll
        for (int i = 0; i < 8; ++i) { sm += o[i]; rk += r_[i] * kp[i] * r_k[h * 64 + cc + i]; }
        sm += __shfl_xor(sm, 1); sm += __shfl_xor(sm, 2); sm += __shfl_xor(sm, 4);
        rk += __shfl_xor(rk, 1); rk += __shfl_xor(rk, 2); rk += __shfl_xor(rk, 4);
        const float mean = sm * (1.0f / 64.0f);
        float var = 0.f;
#pragma unroll
        for (int i = 0; i < 8; ++i) { o[i] -= mean; var += o[i] * o[i]; }
        var += __shfl_xor(var, 1); var += __shfl_xor(var, 2); var += __shfl_xor(var, 4);
        const float rstd = rsqrtf(var * (1.0f / 64.0f) + 64e-5f);
        float y[8];
#pragma unroll
        for (int i = 0; i < 8; ++i) y[i] = (o[i] * rstd * ln_w[c + i] + ln_b[c + i] + rk * v_[i]) * g[i];
        *(u32x4*)(YC + (size_t)m * D + 512 + c) = pack8(y);
    }
}

__device__ void p5_out(const Args& a, LAS unsigned char* lds) {
    const int tid = threadIdx.x, G = gridDim.x, blk = blockIdx.x, wave = tid >> 6, lane = tid & 63, fr = lane & 15, fq = lane >> 4;
    unsigned char* ws = a.ws;
    const bf16_t* YC = (const bf16_t*)a.out; const bf16_t* WoutT = (const bf16_t*)(ws + OFF_WOUT); const bf16_t* PB = (const bf16_t*)(ws + OFF_PB); const bf16_t* WppT = (const bf16_t*)(ws + OFF_WPP);
    bf16_t* H1B = (bf16_t*)(ws + OFF_H1B); bf16_t* PP = (bf16_t*)((unsigned char*)a.out + PPD_OFF);
    { pg8::Gemm g{YC, WoutT, MP, D, D}; pg8::StaticOrder S; S.init(MP, D, G, blk); EpiH1 E{a.in[0], H1B}; pg8::gemm_phase<EpiH1, pg8::StaticOrder>(lds, g, S, E, nullptr); }
    for (int t2 = blk; t2 < 256; t2 += G) {
        const int tile = t2 * 2 + (wave >> 2), ks = wave & 3, rt = tile & 7, ct = tile >> 3; const int row = MP + rt * 16 + fr; const size_t o = (size_t)row * D + ct * 16 + 4 * fq;
        f32x4 acc = mini_tile_k<8>(YC + (size_t)row * D + ks * 256, WoutT + (size_t)(ct * 16 + fr) * D + ks * 256, fq);
        f32x4 acp = mini_tile_k<2>(PB + (size_t)row * DP + ks * 64, WppT + (size_t)(ct * 16 + fr) * DP + ks * 64, fq);
        acc = splitk_reduce(lds, acc, wave, lane);
        acp = splitk_reduce(lds, acp, wave, lane);
        if (ks == 0) {
            const f32x4 v = *(const f32x4*)(a.in[1] + (size_t)(row - MP) * D + ct * 16 + 4 * fq) + acc;
            *(u32x2*)(H1B + o) = pack4(v[0], v[1], v[2], v[3]);
            *(u32x2*)(PP + o) = pack4(acp[0], acp[1], acp[2], acp[3]);
        }
    }
}

__device__ void p6_gate(const Args& a, LAS unsigned char* lds) {
    const int tid = threadIdx.x, G = gridDim.x, blk = blockIdx.x, wave = tid >> 6, lane = tid & 63, fr = lane & 15, fq = lane >> 4;
    unsigned char* ws = a.ws;
    const bf16_t* WpgT = (const bf16_t*)(ws + OFF_WPG); const bf16_t* H1B = (const bf16_t*)(ws + OFF_H1B); const bf16_t* PP = (const bf16_t*)((const unsigned char*)a.out + PPD_OFF);
    { pg8::Gemm g{H1B, WpgT, MP, D, D}; pg8::StaticOrder S; S.init(MP, D, G, blk); EpiH2 E{H1B, PP, (bf16_t*)(ws + OFF_H2B)}; pg8::gemm_phase<EpiH2, pg8::StaticOrder>(lds, g, S, E, nullptr); }
    for (int t2 = blk; t2 < 256; t2 += G) {
        const int tile = t2 * 2 + (wave >> 2), ks = wave & 3, rt = tile & 7, ct = tile >> 3; const int row = MP + rt * 16 + fr; const size_t o = (size_t)row * D + ct * 16 + 4 * fq;
        f32x4 g = mini_tile_k<8>(H1B + (size_t)row * D + ks * 256, WpgT + (size_t)(ct * 16 + fr) * D + ks * 256, fq);
        g = splitk_reduce(lds, g, wave, lane);
        if (ks == 0) {
            float h[4], p[4]; unpack4(*(const u32x2*)(H1B + o), h); unpack4(*(const u32x2*)(PP + o), p);
            f32x4 v; v[0] = h[0] + sigmoidf_(g[0]) * p[0]; v[1] = h[1] + sigmoidf_(g[1]) * p[1]; v[2] = h[2] + sigmoidf_(g[2]) * p[2]; v[3] = h[3] + sigmoidf_(g[3]) * p[3];
            *(u32x2*)((bf16_t*)(ws + OFF_H2B) + o) = pack4(v[0], v[1], v[2], v[3]);
        }
    }
}

__device__ void p7_norm(const Args& a) {
    const int tid = threadIdx.x, G = gridDim.x, blk = blockIdx.x, wave = tid >> 6, lane = tid & 63;
    const float* fg = a.in[23]; const bf16_t* H2B = (const bf16_t*)(a.ws + OFF_H2B);
    f32x4 gv[2][2];
#pragma unroll
    for (int i = 0; i < 2; ++i) { gv[i][0] = *(const f32x4*)(fg + i * 512 + lane * 8); gv[i][1] = *(const f32x4*)(fg + i * 512 + lane * 8 + 4); }
    for (int row0 = (blk * 8 + wave) * 4; row0 < MT; row0 += G * 32) {
        u32x4 q[4][2];
#pragma unroll
        for (int r = 0; r < 4; ++r)
#pragma unroll
            for (int i = 0; i < 2; ++i) q[r][i] = *(const u32x4*)(H2B + (size_t)(row0 + r) * D + i * 512 + lane * 8);
#pragma unroll
        for (int r = 0; r < 4; ++r) { float f[2][8]; unpack8(q[r][0], f[0]); unpack8(q[r][1], f[1]); float ss = 0.f;
#pragma unroll
            for (int i = 0; i < 2; ++i)
#pragma unroll
                for (int e = 0; e < 8; ++e) ss += f[i][e] * f[i][e];
#pragma unroll
            for (int o = 32; o >= 1; o >>= 1) ss += __shfl_xor(ss, o);
            const float rs = rsqrtf(ss * (1.0f / D) + 1e-6f);
#pragma unroll
            for (int i = 0; i < 2; ++i) { float* yp = a.out + (size_t)(row0 + r) * D + i * 512 + lane * 8;
                *(f32x4*)(yp) = (f32x4){f[i][0], f[i][1], f[i][2], f[i][3]} * rs * gv[i][0]; *(f32x4*)(yp + 4) = (f32x4){f[i][4], f[i][5], f[i][6], f[i][7]} * rs * gv[i][1]; } }
    }
}

#define XB_TMO      128
#define XB_XCNT(j)  (256  + 64 * (j))
#define XB_XSUB(j)  (1280 + 64 * (j))
#define XB_XGEN(j)  (2304 + 64 * (j))
#define XB_TOP      3328
#define XB_TOPGEN   3392
#define XCD_BAR_WORDS 3456
#define XB_SPIN_CAP (1u << 18)

__device__ __forceinline__ unsigned xb_ld(unsigned* p)              { return __hip_atomic_load(p, __ATOMIC_RELAXED, __HIP_MEMORY_SCOPE_AGENT); }
__device__ __forceinline__ unsigned xb_add(unsigned* p, unsigned v) { return __hip_atomic_fetch_add(p, v, __ATOMIC_RELAXED, __HIP_MEMORY_SCOPE_AGENT); }
__device__ __forceinline__ unsigned xb_xcc_id() { return (unsigned)__builtin_amdgcn_s_getreg((3 << 11) | 20) & 0xFu; }
#define XB_SPIN(cond, bar) do { unsigned _sp = 0; while (cond) { __builtin_amdgcn_s_sleep(1); \
    if ((++_sp & 255u) == 0u) { if (xb_ld(&(bar)[XB_TMO])) break; if (_sp > XB_SPIN_CAP) { atomicAdd(&(bar)[XB_TMO], 1u); break; } } } } while (0)

struct XcdBarrier {
    unsigned* bar; unsigned x;
    volatile LAS unsigned* st;
};

__device__ __forceinline__ XcdBarrier xcd_barrier_post(unsigned* bar, volatile LAS unsigned* st) {
    XcdBarrier b; b.bar = bar; b.x = xb_xcc_id(); b.st = st;
    if (threadIdx.x == 0) (void)xb_add(&bar[XB_XCNT(b.x)], 1u);
    return b;
}
__device__ __forceinline__ void xcd_barrier_complete(unsigned* bar, unsigned x, unsigned& nloc, unsigned& nx) {
    const unsigned G = gridDim.x * gridDim.y * gridDim.z;
    unsigned sum, cnt, mine, sp = 0u;
    for (;;) {
        sum = 0u; cnt = 0u; mine = 0u;
#pragma unroll
        for (unsigned j = 0; j < 16; ++j) { const unsigned c = xb_ld(&bar[XB_XCNT(j)]); sum += c; cnt += (c > 0u) ? 1u : 0u; mine = (j == x) ? c : mine; }
        if (sum == G) break;
        __builtin_amdgcn_s_sleep(1);
        if ((++sp & 255u) == 0u) { if (xb_ld(&bar[XB_TMO])) break; if (sp > XB_SPIN_CAP) { atomicAdd(&bar[XB_TMO], 1u); break; } }
    }
    nloc = mine > 0u ? mine : 1u; nx = cnt > 0u ? cnt : 1u;
}

__device__ __forceinline__ void xcd_barrier(const XcdBarrier& b) {
    asm volatile("s_waitcnt vmcnt(0)" ::: "memory");
    __syncthreads();
    if (threadIdx.x == 0) {
        unsigned* bar = b.bar;
        __builtin_amdgcn_s_waitcnt(0);
        unsigned nloc = b.st[0], nx = b.st[1];
        if (nloc == 0u) { xcd_barrier_complete(bar, b.x, nloc, nx); b.st[0] = nloc; b.st[1] = nx; }
        const unsigned old = xb_add(&bar[XB_XSUB(b.x)], 1u);
        const unsigned gen = old / nloc;
        if (old + 1u == (gen + 1u) * nloc) {
            __builtin_amdgcn_fence(__ATOMIC_RELEASE, "agent");
            asm volatile("s_waitcnt vmcnt(0)" ::: "memory");
            const unsigned og = xb_add(&bar[XB_TOP], 1u);
            const unsigned tg = og / nx;
            if (og + 1u == (tg + 1u) * nx) xb_add(&bar[XB_TOPGEN], 1u);
            else XB_SPIN(xb_ld(&bar[XB_TOPGEN]) == tg, bar);
            __builtin_amdgcn_fence(__ATOMIC_ACQUIRE, "agent");
            xb_add(&bar[XB_XGEN(b.x)], 1u);
            asm volatile("s_waitcnt vmcnt(0)" ::: "memory");
        } else {
            XB_SPIN(xb_ld(&bar[XB_XGEN(b.x)]) == gen, bar);
            __builtin_amdgcn_fence(__ATOMIC_ACQUIRE, "agent");
            asm volatile("s_waitcnt vmcnt(0)" ::: "memory");
        }
    }
    __syncthreads();
}

__global__ void __launch_bounds__(512, 2) fwd(Args a) {
    extern __shared__ __attribute__((aligned(16))) unsigned char lds_raw[];
    LAS unsigned char* lds = (LAS unsigned char*)lds_raw;
    cg::grid_group grid = cg::this_grid();
    volatile LAS unsigned* xst = (volatile LAS unsigned*)(lds + LDS_BYTES - 16);
    if (threadIdx.x == 0) { xst[0] = 0u; xst[1] = 0u; }
    __syncthreads();
    const XcdBarrier xb = xcd_barrier_post((unsigned*)(a.ws + OFF_BAR), xst);
    if (a.ph_hi > 1000) grid.sync();
#define IN(k) (a.ph_lo <= (k) && (k) < a.ph_hi)
#define GSYNC() xcd_barrier(xb)
#define SEAM(k) do { if (IN(k) && IN((k) + 1)) GSYNC(); } while (0)
#ifndef REP_PHASE
#define REP_PHASE -1
#endif
#define REPS(k) ((REP_PHASE == (k)) ? 2 : 1)
    if (IN(0)) for (int r = 0; r < REPS(0); ++r) { if (r) GSYNC(); p0_prep(a, lds); }
    SEAM(0);
    if (IN(1)) for (int r = 0; r < REPS(1); ++r) { if (r) GSYNC(); p1_gemm_in(a, lds); }
    SEAM(1);
    if (IN(2)) for (int r = 0; r < REPS(2); ++r) { if (r) GSYNC(); p2_all(a, lds); }
    if (IN(2) && !IN(3)) {}
    else if (!IN(2) && IN(3)) {}
    if (IN(3)) for (int r = 0; r < REPS(3); ++r) { if (r) GSYNC(); __syncthreads(); p3a_chunks(a, lds); }
    SEAM(3);
    if (IN(4)) for (int r = 0; r < REPS(4); ++r) { if (r) GSYNC(); p3b_seq(a, lds); if (r == 0) p3_sample_step(a, (int)blockIdx.x, (int)gridDim.x); }
    SEAM(4);
    if (IN(5)) p3c_out(a);
    SEAM(5);
    if (IN(6)) p5_out(a, lds);
    SEAM(6);
    if (IN(7)) p6_gate(a, lds);
    SEAM(7);
#if REP_PHASE == 99
    GSYNC(); GSYNC(); GSYNC(); GSYNC();
#endif
    if (IN(8)) p7_norm(a);
}

#ifndef N_LAUNCH_MODE
#define N_LAUNCH_MODE 1
#endif
extern "C" void kernel_launch(void* const* d_in, const int* in_sizes, int n_in, void* d_out, int out_size, void* d_ws, size_t ws_size, hipStream_t stream) {
    static int grid = 0;
    if (grid == 0) {
        if (n_in != 24 || ws_size < WS_END) { fprintf(stderr, "kernel_launch: unexpected n_in %d / ws_size %zu (need %zu)\n", n_in, ws_size, (size_t)WS_END); grid = -1; return; }
        int dev = 0, cus = 0, per_cu = 0;
        (void)hipGetDevice(&dev); (void)hipDeviceGetAttribute(&cus, hipDeviceAttributeMultiprocessorCount, dev);
        if (hipFuncSetAttribute((const void*)fwd, hipFuncAttributeMaxDynamicSharedMemorySize, LDS_BYTES) != hipSuccess) { fprintf(stderr, "kernel_launch: hipFuncSetAttribute failed\n"); grid = -1; return; }
        if (hipOccupancyMaxActiveBlocksPerMultiprocessor(&per_cu, (const void*)fwd, 512, LDS_BYTES) != hipSuccess || per_cu < 1) { fprintf(stderr, "kernel_launch: occupancy query gives %d\n", per_cu); per_cu = 1; }
        (void)hipGetLastError();
        grid = cus;
    }
    if (grid < 0) return;
    Args a{};
    for (int i = 0; i < 24; ++i) a.in[i] = (const float*)d_in[i];
    a.out = (float*)d_out; a.ws = (unsigned char*)d_ws;
    (void)hipMemsetAsync((unsigned char*)d_ws + OFF_BAR, 0, XCD_BAR_WORDS * 4, stream);
    if (N_LAUNCH_MODE == 1) {
        a.ph_lo = 0; a.ph_hi = 9;
        void* args[] = {&a};
        hipError_t e = hipLaunchCooperativeKernel((const void*)fwd, dim3(grid), dim3(512), args, LDS_BYTES, stream);
        if (e != hipSuccess) fprintf(stderr, "kernel_launch: cooperative launch failed: %s (grid %d)\n", hipGetErrorString(e), grid);
    } else {
        for (int ph = 0; ph < 9; ++ph) { a.ph_lo = ph; a.ph_hi = ph + 1; hipLaunchKernelGGL(fwd, dim3(grid), dim3(512), LDS_BYTES, stream, a); }
    }
}
```

```cpp
#include <hip/hip_runtime.h>
#include <hip/hip_cooperative_groups.h>
#include <cstdio>
namespace pg8 {
#define PG8_LAS __attribute__((address_space(3)))
typedef unsigned short bf16_t;
typedef short bf16x8 __attribute__((ext_vector_type(8)));
typedef float f32x4 __attribute__((ext_vector_type(4)));
typedef unsigned u32x4 __attribute__((ext_vector_type(4)));
constexpr int BM = 256, BK = 64, HALF = 128, HTB = HALF * BK * 2  , STAGE_BYTES = 8 * HTB, NXCD = 8, WGM = 8;

__host__ __device__ __forceinline__ int lds_byte(int r, int c) { const int st = (r >> 4) * 2 + (c >> 5), rr = r & 15, cc = c & 31, ob = rr * 64 + cc * 2; return st * 1024 + (ob ^ (((ob >> 9) & 1) << 5)); }
__host__ __device__ __forceinline__ void stage_rc(int b, int& R, int& C) { const int st = b / 1024, sb = b % 1024, swz = sb ^ (((sb >> 9) & 1) << 5); R = (st >> 1) * 16 + swz / 64; C = (st & 1) * 32 + (swz % 64) / 2; }
__host__ __device__ __forceinline__ int perm32(int rho) { const int n = rho >> 4, i = rho & 15; return 8 * (i >> 2) + 4 * n + (i & 3); }

struct Unit { int pm, pn; };
struct Gemm { const bf16_t* A; const bf16_t* Bt; int M, N, K; };

struct StaticOrder {
    int nM, nN, nwg, G, c;
    __host__ __device__ void init(int M, int N, int G_, int c_) { nM = M / BM; nN = N / BM; nwg = nM * nN; G = G_; c = c_; }
    __host__ __device__ bool next(int i, Unit& u) const {
        const long L = (long)i * G + c; if (L >= nwg) return false;
        int wgid = (int)L; { const int q = nwg / NXCD, r = nwg % NXCD, xcd = wgid % NXCD, off = wgid / NXCD; wgid = (xcd < r ? xcd * (q + 1) : r * (q + 1) + (xcd - r) * q) + off; }
        const int nig = WGM * nN, gid = wgid / nig, fm = gid * WGM, gsz = (nM - fm) < WGM ? (nM - fm) : WGM;
        u.pm = fm + ((wgid % nig) % gsz); u.pn = (wgid % nig) / gsz; return true;
    }
    __device__ __forceinline__ void a_ready(const Unit&) const {}
    __device__ __forceinline__ void done(const Unit&) const {}
};
typedef __bf16 bf16v2_t __attribute__((ext_vector_type(2)));
typedef float f32v2_t __attribute__((ext_vector_type(2)));
__device__ __forceinline__ unsigned cvt_pk_bf16(float lo, float hi) { const bf16v2_t r = __builtin_convertvector((f32v2_t){lo, hi}, bf16v2_t); return __builtin_bit_cast(unsigned, r); }
template <class Epi, class Sched, bool STAMP = false>
__device__ __forceinline__ void gemm_phase(PG8_LAS unsigned char* lds, const Gemm g, const Sched& S, const Epi& E, unsigned long long* stamps) {
    const int tid = threadIdx.x, wid = __builtin_amdgcn_readfirstlane(tid >> 6), lane = tid & 63, wr = wid >> 2, wc = wid & 3, fr = lane & 15, fq = lane >> 4;
    const int K = g.K, nt = K / BK;
    int ts_lo = 0, ts_hi = 0, nts = 0; const unsigned long long rt_entry = STAMP ? (unsigned long long)wall_clock64() : 0ull;
#define PG8_STAMP() do { if (STAMP && wid == 0 && nts < 64) { const unsigned long long _c = (unsigned long long)clock64(); \
        ts_lo = (lane == nts) ? (int)(unsigned)_c : ts_lo; ts_hi = (lane == nts) ? (int)(unsigned)(_c >> 32) : ts_hi; ++nts; } } while (0)
    PG8_STAMP();
    unsigned voffA[2], voffB[2];
#pragma unroll
    for (int i = 0; i < 2; ++i) { int R, C; stage_rc(tid * 16 + i * 8192, R, C); const int Rb = Epi::PERM ? ((R & ~31) + perm32(R & 31)) : R;
        voffA[i] = (unsigned)(R * K + C) * 2u; voffB[i] = (unsigned)(Rb * K + C) * 2u; }
    const size_t kstep = (size_t)(BK * 2);
    const size_t hstep = (size_t)HALF * K * 2;
    const size_t tstep = 2 * hstep;
    const unsigned ldsw = (unsigned)wid * 1024u;
    const int aoff = lds_byte(wr * 64 + fr, fq * 8), boff = lds_byte(wc * 32 + fr, fq * 8);
#define PG8_SA(b, h) (((b) * 2 + (h)) * HTB)
#define PG8_SB(b, h) ((4 + (b) * 2 + (h)) * HTB)
#define PG8_STAGE(bufoff, gbase, voff) do { _Pragma("unroll") for (int _i = 0; _i < 2; ++_i) \
        __builtin_amdgcn_global_load_lds((const unsigned*)((const char*)(gbase) + (voff)[_i]), (PG8_LAS unsigned*)(lds + (bufoff) + ldsw + _i * 8192), 16, 0, 0); } while (0)
#define PG8_LDA(dst, b, h) do { _Pragma("unroll") for (int m = 0; m < 4; ++m) _Pragma("unroll") for (int k = 0; k < 2; ++k) dst[m][k] = *(const PG8_LAS bf16x8*)(lds + PG8_SA(b, h) + aoff + m * 2048 + k * 1024); } while (0)
#define PG8_LDB(dst, b, h) do { _Pragma("unroll") for (int n = 0; n < 2; ++n) _Pragma("unroll") for (int k = 0; k < 2; ++k) dst[n][k] = *(const PG8_LAS bf16x8*)(lds + PG8_SB(b, h) + boff + n * 2048 + k * 1024); } while (0)
#define PG8_MMA(ai, bj, At, Bt) do { __builtin_amdgcn_s_setprio(1); _Pragma("unroll") for (int m = 0; m < 4; ++m) _Pragma("unroll") for (int n = 0; n < 2; ++n) _Pragma("unroll") for (int k = 0; k < 2; ++k) \
        acc[ai][bj][m][n] = __builtin_amdgcn_mfma_f32_16x16x32_bf16(Bt[n][k], At[m][k], acc[ai][bj][m][n], 0, 0, 0); __builtin_amdgcn_s_setprio(0); } while (0)
#define PG8_WAIT_V(n) asm volatile("s_waitcnt vmcnt(" #n ")" ::: "memory")
#define PG8_WAIT_L(n) asm volatile("s_waitcnt lgkmcnt(" #n ")" ::: "memory")
#define PG8_BAR __builtin_amdgcn_s_barrier()
#define PG8_SCHED __builtin_amdgcn_sched_barrier(0)
    Unit cur, nxt; int ui = 0;
    if (!S.next(0, cur)) return;
    f32x4 acc[2][2][4][2];
#pragma unroll
    for (int a = 0; a < 2; ++a)
#pragma unroll
        for (int b = 0; b < 2; ++b)
#pragma unroll
            for (int m = 0; m < 4; ++m)
#pragma unroll
                for (int n = 0; n < 2; ++n) acc[a][b][m][n] = (f32x4){0.f, 0.f, 0.f, 0.f};
    bf16x8 At[4][2], B0[2][2], B1[2][2];
    const char* cA = (const char*)g.A + (size_t)cur.pm * tstep; const char* cB = (const char*)g.Bt + (size_t)cur.pn * tstep;
    S.a_ready(cur);
    PG8_STAGE(PG8_SB(0, 0), cB, voffB); PG8_STAGE(PG8_SA(0, 0), cA, voffA); PG8_STAGE(PG8_SB(0, 1), cB + hstep, voffB); PG8_STAGE(PG8_SA(0, 1), cA + hstep, voffA);
    if (wr == 1) PG8_BAR;
    PG8_WAIT_V(4); PG8_BAR;
    PG8_STAGE(PG8_SB(1, 0), cB + kstep, voffB); PG8_STAGE(PG8_SA(1, 0), cA + kstep, voffA); PG8_STAGE(PG8_SB(1, 1), cB + hstep + kstep, voffB);
    PG8_WAIT_V(6); PG8_BAR;
    PG8_STAMP();
    for (;;) {
        const bool has_next = S.next(ui + 1, nxt);
        const char* nA = has_next ? (const char*)g.A + (size_t)nxt.pm * tstep : cA; const char* nB = has_next ? (const char*)g.Bt + (size_t)nxt.pn * tstep : cB;
        for (int t = 0; t < nt; t += 2) {
            const bool last = (t == nt - 2);
            const char* a1 = cA + (size_t)(t + 1) * kstep;
            const char* a2 = last ? nA : cA + (size_t)(t + 2) * kstep; const char* b2 = last ? nB : cB + (size_t)(t + 2) * kstep;
            const char* a3 = a2 + kstep; const char* b3 = b2 + kstep;
            if (last && has_next) S.a_ready(nxt);
            PG8_LDB(B0, 0, 0); PG8_SCHED; PG8_LDA(At, 0, 0); PG8_STAGE(PG8_SA(1, 1), a1 + hstep, voffA);
            PG8_WAIT_L(8); PG8_BAR; PG8_WAIT_L(0); PG8_MMA(0, 0, At, B0); PG8_BAR; PG8_SCHED;
            PG8_LDB(B1, 0, 1); PG8_STAGE(PG8_SB(0, 0), b2, voffB);
            PG8_BAR; PG8_WAIT_L(0); PG8_MMA(0, 1, At, B1); PG8_BAR;
            PG8_LDA(At, 0, 1); PG8_STAGE(PG8_SA(0, 0), a2, voffA);
            PG8_BAR; PG8_WAIT_L(0); PG8_MMA(1, 0, At, B0); PG8_BAR; PG8_SCHED;
            PG8_STAGE(PG8_SB(0, 1), b2 + hstep, voffB);
            PG8_WAIT_V(6); PG8_BAR; PG8_MMA(1, 1, At, B1); PG8_BAR;
            PG8_LDB(B0, 1, 0); PG8_SCHED; PG8_LDA(At, 1, 0); PG8_STAGE(PG8_SA(0, 1), a2 + hstep, voffA);
            PG8_WAIT_L(8); PG8_BAR; PG8_WAIT_L(0); PG8_MMA(0, 0, At, B0); PG8_BAR; PG8_SCHED;
            PG8_LDB(B1, 1, 1); PG8_STAGE(PG8_SB(1, 0), b3, voffB);
            PG8_BAR; PG8_WAIT_L(0); PG8_MMA(0, 1, At, B1); PG8_BAR;
            PG8_LDA(At, 1, 1); PG8_STAGE(PG8_SA(1, 0), a3, voffA);
            PG8_BAR; PG8_WAIT_L(0); PG8_MMA(1, 0, At, B0); PG8_BAR; PG8_SCHED;
            PG8_STAGE(PG8_SB(1, 1), b3 + hstep, voffB);
            PG8_WAIT_V(6); PG8_BAR; PG8_MMA(1, 1, At, B1); PG8_BAR;
        }
        PG8_STAMP();
        if constexpr (!Epi::AFTER_DRAIN) { E(acc, cur, wr, wc, fr, fq); S.done(cur); }
        PG8_STAMP();
        if (!has_next) break;
#pragma unroll
        for (int a = 0; a < 2; ++a)
#pragma unroll
            for (int b = 0; b < 2; ++b)
#pragma unroll
                for (int m = 0; m < 4; ++m)
#pragma unroll
                    for (int n = 0; n < 2; ++n) acc[a][b][m][n] = (f32x4){0.f, 0.f, 0.f, 0.f};
        cur = nxt; cA = nA; cB = nB; ++ui;
    }
    PG8_WAIT_V(0);
    if (wr == 0) PG8_BAR;
    PG8_BAR;
    if constexpr (Epi::AFTER_DRAIN) { E.fused(acc, cur, wr, wc, fr, fq, lds, wid, lane); S.done(cur); }
    PG8_STAMP();
    if (STAMP && wid == 0) { stamps[lane] = lane < nts ? (((unsigned long long)(unsigned)ts_hi << 32) | (unsigned)ts_lo) : 0ull;
        if (lane == 62) stamps[62] = rt_entry; if (lane == 63) stamps[63] = (unsigned long long)wall_clock64(); }
#undef PG8_STAMP
#undef PG8_SA
#undef PG8_SB
#undef PG8_STAGE
#undef PG8_LDA
#undef PG8_LDB
#undef PG8_MMA
#undef PG8_WAIT_V
#undef PG8_WAIT_L
#undef PG8_BAR
#undef PG8_SCHED
}
}

namespace cg = cooperative_groups;
using pg8::bf16_t; using pg8::bf16x8; using pg8::f32x4; using pg8::u32x4; using pg8::Unit; using pg8::cvt_pk_bf16;
typedef unsigned u32x2 __attribute__((ext_vector_type(2)));
#define LAS __attribute__((address_space(3)))
#define LBAR() do { asm volatile("s_waitcnt lgkmcnt(0)" ::: "memory"); __builtin_amdgcn_s_barrier(); asm volatile("" ::: "memory"); } while (0)

constexpr int D = 1024, TSEQ = 2048, NB = 8, MP = NB * TSEQ, MS = 128, MT = MP + MS;
constexpr int RW = 512, NH = 8, SW = 1664, NZ = 4224, NZP = 4352, DP = 256;
constexpr int ZC_S = 2048, ZC_GR = 3712;
constexpr int LDS_BYTES = 159744;

constexpr size_t OFF_WIN = 0;
constexpr size_t OFF_WOUT = OFF_WIN + (size_t)NZP * D * 2;
constexpr size_t OFF_WPG = OFF_WOUT + (size_t)D * D * 2;
constexpr size_t OFF_WPP = OFF_WPG + (size_t)D * D * 2;
constexpr size_t OFF_WUP = OFF_WPP + (size_t)D * DP * 2;
constexpr size_t OFF_AUP = OFF_WUP + (size_t)RW * 64 * 2;
constexpr size_t OFF_RS = OFF_AUP + (size_t)RW * 64 * 2;
constexpr size_t OFF_PB = OFF_RS + (size_t)16640 * 4;
constexpr size_t OFF_Z = OFF_PB + (size_t)MT * DP * 2;
constexpr size_t OFF_SCN = OFF_Z + (size_t)MT * NZ * 2;
constexpr size_t OFF_BAR = OFF_SCN + (size_t)MT * NH * 384 * 2;
constexpr size_t WS_END = OFF_BAR + 16384;
constexpr size_t OFF_H1B = OFF_Z;
constexpr size_t OFF_PPB = OFF_H1B + (size_t)MT * D * 2;
constexpr size_t OFF_H2B = OFF_PPB + (size_t)MT * D * 2;
static_assert(OFF_H2B + (size_t)MT * D * 2 <= OFF_SCN, "overlay");
constexpr size_t PPD_OFF = (size_t)MT * D * 2;
constexpr size_t OFF_CHK = OFF_SCN;
constexpr size_t OFF_SALL = OFF_CHK + (size_t)2048 * 16384 * 2;
constexpr size_t OFF_OS = OFF_SALL + (size_t)2048 * 4096 * 2;
constexpr size_t OFF_SCNS = OFF_OS + (size_t)128 * 512 * 2;
constexpr size_t OFF_RK = OFF_SCNS + (size_t)MS * NH * 384 * 2;
static_assert(OFF_RK + (size_t)2048 * 64 * 4 <= OFF_BAR, "overlay");
constexpr size_t O_Y = 0, O_CONVP = (size_t)MT * D, O_SHIFTP = O_CONVP + 8 * 2 * 512, O_WKVP = O_SHIFTP + 8 * SW,
                 O_CONVS = O_WKVP + 8 * 8 * 64 * 64, O_SHIFTS = O_CONVS + 128 * 2 * 512, O_WKVS = O_SHIFTS + 128 * SW;

struct Args { const float* in[24]; float* out; unsigned char* ws; int ph_lo, ph_hi; };

__device__ __forceinline__ float bf2f(unsigned short b) { return __uint_as_float(((unsigned)b) << 16); }
__device__ __forceinline__ float bflo(unsigned w) { return __uint_as_float(w << 16); }
__device__ __forceinline__ float bfhi(unsigned w) { return __uint_as_float(w & 0xffff0000u); }
__device__ __forceinline__ unsigned short f2bf(float f) { return (unsigned short)(cvt_pk_bf16(f, 0.f) & 0xffffu); }
__device__ __forceinline__ void unpack8(const u32x4 q, float (&f)[8]) {
    f[0] = bflo(q.x); f[1] = bfhi(q.x); f[2] = bflo(q.y); f[3] = bfhi(q.y); f[4] = bflo(q.z); f[5] = bfhi(q.z); f[6] = bflo(q.w); f[7] = bfhi(q.w); }
__device__ __forceinline__ void unpack4(const u32x2 q, float (&f)[4]) { f[0] = bflo(q.x); f[1] = bfhi(q.x); f[2] = bflo(q.y); f[3] = bfhi(q.y); }
__device__ __forceinline__ u32x4 pack8(const float (&f)[8]) { u32x4 q; q.x = cvt_pk_bf16(f[0], f[1]); q.y = cvt_pk_bf16(f[2], f[3]); q.z = cvt_pk_bf16(f[4], f[5]); q.w = cvt_pk_bf16(f[6], f[7]); return q; }
__device__ __forceinline__ u32x2 pack4(float a, float b, float c, float d) { u32x2 q; q.x = cvt_pk_bf16(a, b); q.y = cvt_pk_bf16(c, d); return q; }
__device__ __forceinline__ float sigmoidf_(float x) { return __builtin_amdgcn_rcpf(1.0f + __expf(-x)); }
__device__ __forceinline__ float siluf_(float x) { return x * __builtin_amdgcn_rcpf(1.0f + __expf(-x)); }
template <int CTRL> __device__ __forceinline__ float dppf(float x) { return __int_as_float(__builtin_amdgcn_update_dpp(0, __float_as_int(x), CTRL, 0xf, 0xf, false)); }
__device__ __forceinline__ float rowsum16(float x) { x += dppf<0x128>(x); x += dppf<0x124>(x); x += dppf<0x122>(x); x += dppf<0x121>(x); return x; }

__device__ __forceinline__ f32x4 mini_tile(const bf16_t* arow, const bf16_t* brow, int K, int fq) {
    f32x4 acc = {0.f, 0.f, 0.f, 0.f};
    const bf16_t* ap = arow + fq * 8; const bf16_t* bp = brow + fq * 8;
    for (int k0 = 0; k0 < K; k0 += 256) {
        bf16x8 av[8], bv[8];
#pragma unroll
        for (int j = 0; j < 8; ++j) { av[j] = *(const bf16x8*)(ap + k0 + j * 32); bv[j] = *(const bf16x8*)(bp + k0 + j * 32); }
#pragma unroll
        for (int j = 0; j < 8; ++j) acc = __builtin_amdgcn_mfma_f32_16x16x32_bf16(bv[j], av[j], acc, 0, 0, 0);
    }
    return acc;
}

template <int NSTEP> __device__ __forceinline__ f32x4 mini_tile_k(const bf16_t* arow, const bf16_t* brow, int fq) {
    f32x4 acc = {0.f, 0.f, 0.f, 0.f};
    bf16x8 av[NSTEP], bv[NSTEP];
#pragma unroll
    for (int j = 0; j < NSTEP; ++j) { av[j] = *(const bf16x8*)(arow + fq * 8 + j * 32); bv[j] = *(const bf16x8*)(brow + fq * 8 + j * 32); }
#pragma unroll
    for (int j = 0; j < NSTEP; ++j) acc = __builtin_amdgcn_mfma_f32_16x16x32_bf16(bv[j], av[j], acc, 0, 0, 0);
    return acc;
}
__device__ __forceinline__ f32x4 splitk_reduce(LAS unsigned char* lds, f32x4 acc, int wave, int lane) {
    LAS f32x4* red = (LAS f32x4*)lds;
    __syncthreads();
    red[wave * 64 + lane] = acc;
    __syncthreads();
    if ((wave & 3) == 0) acc = (acc + red[(wave + 1) * 64 + lane]) + (red[(wave + 2) * 64 + lane] + red[(wave + 3) * 64 + lane]);
    return acc;
}

struct EpiZ {
    static constexpr bool PERM = true, AFTER_DRAIN = false;
    bf16_t* Z; const float* rs;
    __device__ __forceinline__ void operator()(const f32x4 (&acc)[2][2][4][2], const Unit& u, int wr, int wc, int fr, int fq) const {
        const int row0 = u.pm * 256 + wr * 64 + fr, col0 = u.pn * 256 + wc * 32 + 8 * fq;
        float sc[2][4];
#pragma unroll
        for (int ai = 0; ai < 2; ++ai)
#pragma unroll
            for (int m = 0; m < 4; ++m) sc[ai][m] = rs[row0 + ai * 128 + m * 16];
#pragma unroll
        for (int ai = 0; ai < 2; ++ai)
#pragma unroll
            for (int m = 0; m < 4; ++m) { const int row = row0 + ai * 128 + m * 16; const float s = sc[ai][m]; bf16_t* rp = Z + (size_t)row * NZ + col0;
#pragma unroll
                for (int bj = 0; bj < 2; ++bj) { if (col0 + bj * 128 < NZ && row < MT) { const f32x4 v0 = acc[ai][bj][m][0] * s, v1 = acc[ai][bj][m][1] * s; u32x4 w;
                    w.x = cvt_pk_bf16(v0[0], v0[1]); w.y = cvt_pk_bf16(v0[2], v0[3]); w.z = cvt_pk_bf16(v1[0], v1[1]); w.w = cvt_pk_bf16(v1[2], v1[3]); *(u32x4*)(rp + bj * 128) = w; } } }
    }
};
struct EpiH1 {
    static constexpr bool PERM = true, AFTER_DRAIN = false;
    const float* x; bf16_t* H1B;
    __device__ __forceinline__ void operator()(const f32x4 (&acc)[2][2][4][2], const Unit& u, int wr, int wc, int fr, int fq) const {
        const int row0 = u.pm * 256 + wr * 64 + fr, col0 = u.pn * 256 + wc * 32 + 8 * fq;
#pragma unroll
        for (int ai = 0; ai < 2; ++ai)
#pragma unroll
            for (int mp = 0; mp < 2; ++mp) {
                f32x4 xv[2][2][2];
#pragma unroll
                for (int mm = 0; mm < 2; ++mm)
#pragma unroll
                    for (int bj = 0; bj < 2; ++bj) { const size_t o = (size_t)(row0 + ai * 128 + (mp * 2 + mm) * 16) * D + col0 + bj * 128; xv[mm][bj][0] = *(const f32x4*)(x + o); xv[mm][bj][1] = *(const f32x4*)(x + o + 4); }
#pragma unroll
                for (int mm = 0; mm < 2; ++mm)
#pragma unroll
                    for (int bj = 0; bj < 2; ++bj) { const int m = mp * 2 + mm; const size_t o = (size_t)(row0 + ai * 128 + m * 16) * D + col0 + bj * 128;
                        const f32x4 v0 = xv[mm][bj][0] + acc[ai][bj][m][0], v1 = xv[mm][bj][1] + acc[ai][bj][m][1]; u32x4 w;
                        w.x = cvt_pk_bf16(v0[0], v0[1]); w.y = cvt_pk_bf16(v0[2], v0[3]); w.z = cvt_pk_bf16(v1[0], v1[1]); w.w = cvt_pk_bf16(v1[2], v1[3]); *(u32x4*)(H1B + o) = w; }
                asm volatile("" ::: "memory"); }
    }
};
struct EpiF32 {
    static constexpr bool PERM = true, AFTER_DRAIN = false;
    bf16_t* C;
    __device__ __forceinline__ void operator()(const f32x4 (&acc)[2][2][4][2], const Unit& u, int wr, int wc, int fr, int fq) const {
        const int row0 = u.pm * 256 + wr * 64 + fr, col0 = u.pn * 256 + wc * 32 + 8 * fq;
#pragma unroll
        for (int ai = 0; ai < 2; ++ai)
#pragma unroll
            for (int m = 0; m < 4; ++m) { const size_t off = (size_t)(row0 + ai * 128 + m * 16) * D + col0;
#pragma unroll
                for (int bj = 0; bj < 2; ++bj) { const f32x4 v0 = acc[ai][bj][m][0], v1 = acc[ai][bj][m][1]; u32x4 w;
                    w.x = cvt_pk_bf16(v0[0], v0[1]); w.y = cvt_pk_bf16(v0[2], v0[3]); w.z = cvt_pk_bf16(v1[0], v1[1]); w.w = cvt_pk_bf16(v1[2], v1[3]); *(u32x4*)(C + off + bj * 128) = w; } }
    }
};
struct EpiH2 {
    static constexpr bool PERM = true, AFTER_DRAIN = false;
    const bf16_t* H1; const bf16_t* PP; bf16_t* out;
    __device__ __forceinline__ void operator()(const f32x4 (&acc)[2][2][4][2], const Unit& u, int wr, int wc, int fr, int fq) const {
        const int row0 = u.pm * 256 + wr * 64 + fr, col0 = u.pn * 256 + wc * 32 + 8 * fq;
#pragma unroll
        for (int ai = 0; ai < 2; ++ai)
#pragma unroll
            for (int mp = 0; mp < 2; ++mp) {
                u32x4 qh[2][2], qp[2][2];
#pragma unroll
                for (int mm = 0; mm < 2; ++mm)
#pragma unroll
                    for (int bj = 0; bj < 2; ++bj) { const size_t o = (size_t)(row0 + ai * 128 + (mp * 2 + mm) * 16) * D + col0 + bj * 128; qh[mm][bj] = *(const u32x4*)(H1 + o); qp[mm][bj] = *(const u32x4*)(PP + o); }
#pragma unroll
                for (int mm = 0; mm < 2; ++mm)
#pragma unroll
                    for (int bj = 0; bj < 2; ++bj) { const int m = mp * 2 + mm; const size_t o = (size_t)(row0 + ai * 128 + m * 16) * D + col0 + bj * 128; float h[8], p[8]; unpack8(qh[mm][bj], h); unpack8(qp[mm][bj], p);
                        const f32x4 g0 = acc[ai][bj][m][0], g1 = acc[ai][bj][m][1]; f32x4 v0, v1;
#pragma unroll
                        for (int e = 0; e < 4; ++e) { v0[e] = h[e] + sigmoidf_(g0[e]) * p[e]; v1[e] = h[4 + e] + sigmoidf_(g1[e]) * p[4 + e]; }
                        u32x4 w; w.x = cvt_pk_bf16(v0[0], v0[1]); w.y = cvt_pk_bf16(v0[2], v0[3]); w.z = cvt_pk_bf16(v1[0], v1[1]); w.w = cvt_pk_bf16(v1[2], v1[3]); *(u32x4*)(out + o) = w; }
                asm volatile("" ::: "memory"); }
    }
};

struct P0Job { const float* src; bf16_t* dst; const float* gsc; int K, N, k0, n0; };
__device__ __forceinline__ P0Job p0_decode(const Args& a, int job) {
    constexpr int NJ_IN = 16 * 68, NJ_SQ = 256, NJ_PP = 64, NJ_LO = 8;
    unsigned char* ws = a.ws; P0Job J; J.gsc = nullptr; int kt, nt; int j = job;
    if (j < NJ_IN) { J.src = a.in[8]; J.dst = (bf16_t*)(ws + OFF_WIN); J.gsc = a.in[7]; J.K = 1024; J.N = NZ; kt = j & 15; nt = j >> 4; }
    else if ((j -= NJ_IN) < NJ_SQ) { J.src = a.in[20]; J.dst = (bf16_t*)(ws + OFF_WOUT); J.K = 1024; J.N = 1024; kt = j & 15; nt = j >> 4; }
    else if ((j -= NJ_SQ) < NJ_SQ) { J.src = a.in[21]; J.dst = (bf16_t*)(ws + OFF_WPG); J.K = 1024; J.N = 1024; kt = j & 15; nt = j >> 4; }
    else if ((j -= NJ_SQ) < NJ_PP) { J.src = a.in[22]; J.dst = (bf16_t*)(ws + OFF_WPP); J.K = 256; J.N = 1024; kt = j & 3; nt = j >> 2; }
    else if ((j -= NJ_PP) < NJ_LO) { J.src = a.in[12]; J.dst = (bf16_t*)(ws + OFF_WUP); J.K = 64; J.N = 512; kt = 0; nt = j; }
    else { j -= NJ_LO; J.src = a.in[14]; J.dst = (bf16_t*)(ws + OFF_AUP); J.K = 64; J.N = 512; kt = 0; nt = j; }
    J.k0 = kt * 64; J.n0 = nt * 64; return J;
}
__device__ void p0_prep(const Args& a, LAS unsigned char* lds) {
    const int tid = threadIdx.x, G = gridDim.x, blk = blockIdx.x, wave = tid >> 6, lane = tid & 63;
    LAS float* tile = (LAS float*)lds;
    unsigned char* ws = a.ws;
    constexpr int NJOBS = 16 * 68 + 2 * 256 + 64 + 2 * 8, MAXJ = 7;
    const int li = tid >> 4, lj = (tid & 15) * 4;
    for (int base = blk; base < NJOBS; base += G * MAXJ) {
        f32x4 v[MAXJ][2];
#pragma unroll
        for (int sl = 0; sl < MAXJ; ++sl) { const int job = base + sl * G;
            if (job < NJOBS) { const P0Job J = p0_decode(a, job);
#pragma unroll
                for (int q = 0; q < 2; ++q) { const int i = li + 32 * q; f32x4 x = {0.f, 0.f, 0.f, 0.f};
                    if (J.n0 + lj < J.N) { x = *(const f32x4*)(J.src + (size_t)(J.k0 + i) * J.N + J.n0 + lj); if (J.gsc) x = x * J.gsc[J.k0 + i]; }
                    v[sl][q] = x; } } }
#pragma unroll
        for (int sl = 0; sl < MAXJ; ++sl) { const int job = base + sl * G;
            if (job < NJOBS) { const P0Job J = p0_decode(a, job);
#pragma unroll
                for (int q = 0; q < 2; ++q) { const int i = li + 32 * q;
#pragma unroll
                    for (int e = 0; e < 4; ++e) tile[i * 65 + lj + e] = v[sl][q][e]; }
                LBAR();
#pragma unroll
                for (int it = 0; it < 4; ++it) { const int item = it * 512 + tid, jj = item >> 5, i2 = item & 31;
                    *(unsigned*)(J.dst + (size_t)(J.n0 + jj) * J.K + J.k0 + 2 * i2) = cvt_pk_bf16(tile[(2 * i2) * 65 + jj], tile[(2 * i2 + 1) * 65 + jj]); }
                LBAR(); } }
    }
    bf16_t* XB = (bf16_t*)a.out; float* RS = (float*)(ws + OFF_RS);
    for (int row0 = (blk * 8 + wave) * 2; row0 < MT; row0 += G * 16) {
        f32x4 v[2][4];
#pragma unroll
        for (int r = 0; r < 2; ++r) { const int row = row0 + r; const float* src = row < MP ? a.in[0] + (size_t)row * D : a.in[1] + (size_t)(row - MP) * D;
#pragma unroll
            for (int i = 0; i < 4; ++i) v[r][i] = *(const f32x4*)(src + i * 256 + lane * 4); }
#pragma unroll
        for (int r = 0; r < 2; ++r) { const int row = row0 + r; float ss = 0.f;
#pragma unroll
            for (int i = 0; i < 4; ++i) { const f32x4 x = v[r][i]; ss += x[0] * x[0] + x[1] * x[1] + x[2] * x[2] + x[3] * x[3];
                *(u32x2*)(XB + (size_t)row * D + i * 256 + lane * 4) = pack4(x[0], x[1], x[2], x[3]); }
#pragma unroll
            for (int o = 32; o >= 1; o >>= 1) ss += __shfl_xor(ss, o);
            if (lane == 0) RS[row] = rsqrtf(ss * (1.0f / D) + 1e-6f); }
    }
    bf16_t* PB = (bf16_t*)(ws + OFF_PB);
    constexpr size_t NP4 = (size_t)MT * DP / 4;
    for (size_t i0 = (size_t)blk * 512 + tid; i0 < NP4; i0 += (size_t)G * 512 * 4) {
        f32x4 v[4];
#pragma unroll
        for (int u = 0; u < 4; ++u) { const size_t i = i0 + (size_t)u * G * 512; const size_t e = i * 4;
            if (i < NP4) v[u] = e < (size_t)MP * DP ? *(const f32x4*)(a.in[2] + e) : *(const f32x4*)(a.in[3] + (e - (size_t)MP * DP)); }
#pragma unroll
        for (int u = 0; u < 4; ++u) { const size_t i = i0 + (size_t)u * G * 512; if (i < NP4) *(u32x2*)(PB + i * 4) = pack4(v[u][0], v[u][1], v[u][2], v[u][3]); }
    }
}

__device__ void p1_gemm_in(const Args& a, LAS unsigned char* lds) {
    const int tid = threadIdx.x, G = gridDim.x, blk = blockIdx.x, wave = tid >> 6, lane = tid & 63, fr = lane & 15, fq = lane >> 4;
    unsigned char* ws = a.ws;
    const bf16_t* XB = (const bf16_t*)a.out; const bf16_t* WinT = (const bf16_t*)(ws + OFF_WIN); const float* RS = (const float*)(ws + OFF_RS); bf16_t* Z = (bf16_t*)(ws + OFF_Z);
    {
        pg8::Gemm g{XB, WinT, MP + 256, NZP, D}; pg8::StaticOrder S; S.init(MP + 256, NZP, G, blk); EpiZ E{Z, RS};
        pg8::gemm_phase<EpiZ, pg8::StaticOrder>(lds, g, S, E, nullptr);
    }
    const bool r256 = (G == 256);
    if (!r256 || blk >= 81) {
        const bf16_t* PB = (const bf16_t*)(ws + OFF_PB); const bf16_t* WppT = (const bf16_t*)(ws + OFF_WPP); bf16_t* PP = (bf16_t*)((unsigned char*)a.out + PPD_OFF);
        pg8::Gemm g{PB, WppT, MP, D, DP}; pg8::StaticOrder S; S.init(MP, D, r256 ? 175 : G, r256 ? blk - 81 : blk); EpiF32 E{PP};
        pg8::gemm_phase<EpiF32, pg8::StaticOrder>(lds, g, S, E, nullptr);
    }
}

template <bool smp> __device__ void p2_tile(const Args& a, LAS unsigned char* lds, int tile) {
    const int tid = threadIdx.x, wave = tid >> 6, lane = tid & 63, fr = lane & 15, fq = lane >> 4;
    unsigned char* ws = a.ws;
    const int ntok = smp ? 8 : 64;
    const int m0 = smp ? MP + (tile - 256) * 8 : tile * 64;
    const int t0 = smp ? 0 : (tile & 31) * 64;
    const int bidx = tile >> 5;
    const bf16_t* __restrict__ Z = (const bf16_t*)(ws + OFF_Z); bf16_t* __restrict__ YC = (bf16_t*)a.out; bf16_t* __restrict__ SCN = (bf16_t*)(ws + OFF_SCNS) - (size_t)MP * 8 * 384;
    const float* state_conv = a.in[4]; const float* state_shift = a.in[5]; const float* conv_w = a.in[9]; const float* mu = a.in[10];
    {
        const int c0 = (tid & 63) * 8;
        float cw0[8], cw1[8], cw2[8];
#pragma unroll
        for (int i = 0; i < 8; ++i) { cw0[i] = conv_w[c0 + i]; cw1[i] = conv_w[512 + c0 + i]; cw2[i] = conv_w[1024 + c0 + i]; }
#pragma unroll 2
        for (int tok = tid >> 6; tok < ntok; tok += 8) {
            const int m = m0 + tok, t = t0 + tok;
            const bf16_t* zr = Z + (size_t)m * NZ;
            float fB[8], fC[8], fH[8], fG[8], u0[8], u1[8], u2[8];
            const u32x4 qB = *(const u32x4*)(zr + c0), qC = *(const u32x4*)(zr + 512 + c0), qH = *(const u32x4*)(zr + 1024 + c0), qG = *(const u32x4*)(zr + 1536 + c0);
            if (smp) {
                const float* sc = state_conv + (size_t)(m - MP) * 1024 + c0;
                const f32x4 x0 = *(const f32x4*)(sc), x1 = *(const f32x4*)(sc + 4), y0 = *(const f32x4*)(sc + 512), y1 = *(const f32x4*)(sc + 516);
#pragma unroll
                for (int i = 0; i < 4; ++i) { u2[i] = x0[i]; u2[4 + i] = x1[i]; u1[i] = y0[i]; u1[4 + i] = y1[i]; }
            } else {
                const bf16_t* z1 = t >= 1 ? zr - NZ : zr; const bf16_t* z2 = t >= 2 ? zr - 2 * NZ : zr;
                const u32x4 qC1 = *(const u32x4*)(z1 + 512 + c0), qH1 = *(const u32x4*)(z1 + 1024 + c0), qC2 = *(const u32x4*)(z2 + 512 + c0), qH2 = *(const u32x4*)(z2 + 1024 + c0);
                float c1[8], h1[8], c2[8], h2[8]; unpack8(qC1, c1); unpack8(qH1, h1); unpack8(qC2, c2); unpack8(qH2, h2);
                const float f1 = t >= 1 ? 1.f : 0.f, f2 = t >= 2 ? 1.f : 0.f;
#pragma unroll
                for (int i = 0; i < 8; ++i) { u1[i] = c1[i] * h1[i] * f1; u2[i] = c2[i] * h2[i] * f2; }
            }
            unpack8(qB, fB); unpack8(qC, fC); unpack8(qH, fH); unpack8(qG, fG);
            float y[8];
#pragma unroll
            for (int i = 0; i < 8; ++i) { u0[i] = fC[i] * fH[i]; const float cv = cw0[i] * u2[i] + cw1[i] * u1[i] + cw2[i] * u0[i]; y[i] = fB[i] * cv * siluf_(fG[i]); }
            *(u32x4*)(YC + (size_t)m * D + c0) = pack8(y);
            { float gr[8]; unpack8(*(const u32x4*)(zr + ZC_GR + c0), gr);
#pragma unroll
              for (int i = 0; i < 8; ++i) gr[i] = siluf_(gr[i]);
              *(u32x4*)(YC + (size_t)m * D + 512 + c0) = pack8(gr); }
            float* co = nullptr;
            if (smp) co = a.out + O_CONVS + (size_t)(m - MP) * 1024 + c0; else if (t == TSEQ - 1) co = a.out + O_CONVP + (size_t)bidx * 1024 + c0;
            if (co) {
                *(f32x4*)(co) = (f32x4){u1[0], u1[1], u1[2], u1[3]}; *(f32x4*)(co + 4) = (f32x4){u1[4], u1[5], u1[6], u1[7]};
                *(f32x4*)(co + 512) = (f32x4){u0[0], u0[1], u0[2], u0[3]}; *(f32x4*)(co + 516) = (f32x4){u0[4], u0[5], u0[6], u0[7]}; }
        }
    }
    LAS bf16_t* Awd = (LAS bf16_t*)lds; LAS bf16_t* Aad = Awd + 64 * 72;
    if (smp) {
        const int j0 = (tid & 15) * 8;
        f32x4 m0v = *(const f32x4*)(mu + 1536 + j0), m1v = *(const f32x4*)(mu + 1536 + j0 + 4);
#pragma unroll 2
        for (int tok = tid >> 4; tok < ntok; tok += 32) {
            const int m = m0 + tok;
            const bf16_t* zr = Z + (size_t)m * NZ + ZC_S + 1536 + j0;
            float cur[8], prev[8], zm[8];
            unpack8(*(const u32x4*)zr, cur);
            if (smp) { const float* sp = state_shift + (size_t)(m - MP) * SW + 1536 + j0; const f32x4 x0 = *(const f32x4*)sp, x1 = *(const f32x4*)(sp + 4);
#pragma unroll
                for (int i = 0; i < 4; ++i) { prev[i] = x0[i]; prev[4 + i] = x1[i]; } }
            else { const bool hp = (t0 + tok) >= 1; unpack8(*(const u32x4*)(hp ? zr - NZ : zr), prev);
                if (!hp) {
#pragma unroll
                    for (int i = 0; i < 8; ++i) prev[i] = 0.f; } }
#pragma unroll
            for (int i = 0; i < 8; ++i) { const float mm = i < 4 ? m0v[i] : m1v[i - 4]; zm[i] = cur[i] + (prev[i] - cur[i]) * mm; }
            if (j0 < 64) {
#pragma unroll
                for (int i = 0; i < 8; ++i) { const float e2 = __expf(2.0f * zm[i]); zm[i] = 1.0f - 2.0f * __builtin_amdgcn_rcpf(e2 + 1.0f); }
                *(LAS u32x4*)(Awd + tok * 72 + j0) = pack8(zm);
            } else *(LAS u32x4*)(Aad + tok * 72 + (j0 - 64)) = pack8(zm);
        }
    }
    __syncthreads();
    if (smp) {
        const int h = wave;
        const bf16_t* WupT = (const bf16_t*)(ws + OFF_WUP); const bf16_t* AupT = (const bf16_t*)(ws + OFF_AUP);
        const float* __restrict__ w0 = a.in[11]; const float* __restrict__ a0p = a.in[13]; const float* __restrict__ k_k = a.in[15]; const float* __restrict__ k_a = a.in[16];
        const int nmt = (ntok + 15) >> 4;
#pragma unroll 1
        for (int mt = 0; mt < nmt; ++mt) {
            u32x2 zc[4][3], zq[4][3];
            {   const int tok_ = (mt * 16 + fr) < ntok ? (mt * 16 + fr) : 0; const bf16_t* zr_ = Z + (size_t)(m0 + tok_) * NZ + ZC_S; const bf16_t* zp_ = ((!smp) && (t0 + tok_ >= 1)) ? zr_ - NZ : zr_;
#pragma unroll
                for (int nt = 0; nt < 4; ++nt) { const int c = h * 64 + nt * 16 + 4 * fq;
                    zc[nt][0] = *(const u32x2*)(zr_ + c); zc[nt][1] = *(const u32x2*)(zr_ + 512 + c); zc[nt][2] = *(const u32x2*)(zr_ + 1024 + c);
                    if (!smp) { zq[nt][0] = *(const u32x2*)(zp_ + c); zq[nt][1] = *(const u32x2*)(zp_ + 512 + c); zq[nt][2] = *(const u32x2*)(zp_ + 1024 + c); } } }
            bf16x8 aw[2], aa[2];
#pragma unroll
            for (int ks = 0; ks < 2; ++ks) { aw[ks] = *(const LAS bf16x8*)(Awd + (mt * 16 + fr) * 72 + ks * 32 + fq * 8); aa[ks] = *(const LAS bf16x8*)(Aad + (mt * 16 + fr) * 72 + ks * 32 + fq * 8); }
            f32x4 accw[4], acca[4];
#pragma unroll
            for (int nt = 0; nt < 4; ++nt) { accw[nt] = (f32x4){0.f, 0.f, 0.f, 0.f}; acca[nt] = (f32x4){0.f, 0.f, 0.f, 0.f};
#pragma unroll
                for (int ks = 0; ks < 2; ++ks) { const size_t bo = (size_t)(h * 64 + nt * 16 + fr) * 64 + ks * 32 + fq * 8;
                    accw[nt] = __builtin_amdgcn_mfma_f32_16x16x32_bf16(*(const bf16x8*)(WupT + bo), aw[ks], accw[nt], 0, 0, 0);
                    acca[nt] = __builtin_amdgcn_mfma_f32_16x16x32_bf16(*(const bf16x8*)(AupT + bo), aa[ks], acca[nt], 0, 0, 0); } }
            const bool valid = (mt * 16 + fr) < ntok;
            const int tok = valid ? (mt * 16 + fr) : 0, m = m0 + tok, t = t0 + tok;
            const bf16_t* zr = Z + (size_t)m * NZ + ZC_S;
            const bool hasprev = (!smp) && (t >= 1);
            const bf16_t* zp = hasprev ? zr - NZ : zr;
            const float fp = hasprev ? 1.f : 0.f;
            bf16_t* so = SCN + ((size_t)m * 8 + h) * 384 + 4 * fq;
            float kk[4][4], av[4][4]; float ss = 0.f;
#pragma unroll
            for (int nt = 0; nt < 4; ++nt) {
                const int c = h * 64 + nt * 16 + 4 * fq;
                float cr[4], ck[4], cv[4], pr[4], pk[4], pv[4];
                unpack4(zc[nt][0], cr); unpack4(zc[nt][1], ck); unpack4(zc[nt][2], cv);
                if (smp) { const float* sp = state_shift + (size_t)(m - MP) * SW + c; const f32x4 x0 = *(const f32x4*)sp, x1 = *(const f32x4*)(sp + 512), x2 = *(const f32x4*)(sp + 1024);
#pragma unroll
                    for (int i = 0; i < 4; ++i) { pr[i] = x0[i]; pk[i] = x1[i]; pv[i] = x2[i]; } }
                else { unpack4(zq[nt][0], pr); unpack4(zq[nt][1], pk); unpack4(zq[nt][2], pv);
#pragma unroll
                    for (int i = 0; i < 4; ++i) { pr[i] *= fp; pk[i] *= fp; pv[i] *= fp; } }
                const f32x4 mr = *(const f32x4*)(mu + c), mk = *(const f32x4*)(mu + 512 + c), mv = *(const f32x4*)(mu + 1024 + c);
                const f32x4 w0v = *(const f32x4*)(w0 + c), a0v = *(const f32x4*)(a0p + c), kkv = *(const f32x4*)(k_k + c), kav = *(const f32x4*)(k_a + c);
                float r_[4], e_[4], kp[4], v_[4];
#pragma unroll
                for (int i = 0; i < 4; ++i) {
                    r_[i] = cr[i] + (pr[i] - cr[i]) * mr[i]; const float k = ck[i] + (pk[i] - ck[i]) * mk[i]; v_[i] = cv[i] + (pv[i] - cv[i]) * mv[i];
                    e_[i] = 0.60653065971f * sigmoidf_(w0v[i] + accw[nt][i]);
                    const float al = sigmoidf_(a0v[i] + acca[nt][i]); av[nt][i] = al;
                    const float kq = k * kkv[i]; kk[nt][i] = kq; ss += kq * kq;
                    kp[i] = k * (1.0f + (al - 1.0f) * kav[i]);
                }
                if (valid) {
                *(u32x2*)(so + 0 * 64 + nt * 16) = pack4(r_[0], r_[1], r_[2], r_[3]);
                *(u32x2*)(so + 1 * 64 + nt * 16) = pack4(e_[0], e_[1], e_[2], e_[3]);
                *(u32x2*)(so + 2 * 64 + nt * 16) = pack4(kp[0], kp[1], kp[2], kp[3]);
                *(u32x2*)(so + 3 * 64 + nt * 16) = pack4(v_[0], v_[1], v_[2], v_[3]); }
            }
            ss += __shfl_xor(ss, 16); ss += __shfl_xor(ss, 32);
            const float inv = 1.0f / fmaxf(sqrtf(ss), 1e-12f);
#pragma unroll
            for (int nt = 0; nt < 4; ++nt) {
                float q[4], b[4];
#pragma unroll
                for (int i = 0; i < 4; ++i) { q[i] = kk[nt][i] * inv; b[i] = q[i] * av[nt][i]; }
                if (valid) {
                *(u32x2*)(so + 4 * 64 + nt * 16) = pack4(q[0], q[1], q[2], q[3]);
                *(u32x2*)(so + 5 * 64 + nt * 16) = pack4(b[0], b[1], b[2], b[3]); }
            }
        }
    }
    if (!smp && (tile & 31) == 31) { for (int j = tid; j < SW; j += 512) a.out[O_SHIFTP + (size_t)bidx * SW + j] = bf2f(Z[(size_t)(m0 + 63) * NZ + ZC_S + j]); }
    __syncthreads();
}
__device__ void p2_all(const Args& a, LAS unsigned char* lds) {
    const int tid = threadIdx.x, G = gridDim.x, blk = blockIdx.x;
    for (int t = blk; t < 272; t += G) { if (t < 256) p2_tile<false>(a, lds, t); else p2_tile<true>(a, lds, t); }
    const bf16_t* Z = (const bf16_t*)(a.ws + OFF_Z);
    for (int idx = blk * 512 + tid; idx < MS * SW; idx += G * 512) { const int sidx = idx / SW, j = idx - sidx * SW; a.out[O_SHIFTS + idx] = bf2f(Z[(size_t)(MP + sidx) * NZ + ZC_S + j]); }
}

constexpr int SLOT = 64 * 72;
__device__ __forceinline__ void mm_nt(const LAS bf16_t* X, const LAS bf16_t* Y, int it, int jt0, int fr, int fq, f32x4 (&acc)[2]) {
    bf16x8 xa[2];
#pragma unroll
    for (int ks = 0; ks < 2; ++ks) xa[ks] = *(const LAS bf16x8*)(X + (it * 16 + fr) * 72 + ks * 32 + fq * 8);
#pragma unroll
    for (int u = 0; u < 2; ++u)
#pragma unroll
        for (int ks = 0; ks < 2; ++ks) acc[u] = __builtin_amdgcn_mfma_f32_16x16x32_bf16(*(const LAS bf16x8*)(Y + ((jt0 + u) * 16 + fr) * 72 + ks * 32 + fq * 8), xa[ks], acc[u], 0, 0, 0);
}
template <int MASK> __device__ __forceinline__ f32x4 mask4(f32x4 v, int i, int j0) {
#pragma unroll
    for (int e = 0; e < 4; ++e) { const int j = j0 + e; const bool keep = MASK == 0 ? true : MASK == 1 ? (j < i) : MASK == 2 ? (j > i) : (j <= i); v[e] = keep ? v[e] : 0.f; }
    return v;
}
__device__ __forceinline__ void st4(LAS bf16_t* dst, int i, int j0, f32x4 v) { *(LAS u32x2*)(dst + i * 72 + j0) = pack4(v[0], v[1], v[2], v[3]); }
__device__ __forceinline__ f32x4 ld4(const LAS bf16_t* src, int i, int j0) { float f[4]; unpack4(*(const LAS u32x2*)(src + i * 72 + j0), f); return (f32x4){f[0], f[1], f[2], f[3]}; }
__device__ __forceinline__ void st4t(LAS bf16_t* dst, int i, int j0, f32x4 v) {
    const unsigned lo = cvt_pk_bf16(v[0], v[1]), hi = cvt_pk_bf16(v[2], v[3]);
    dst[(j0 + 0) * 72 + i] = (bf16_t)(lo & 0xffffu); dst[(j0 + 1) * 72 + i] = (bf16_t)(lo >> 16); dst[(j0 + 2) * 72 + i] = (bf16_t)(hi & 0xffffu); dst[(j0 + 3) * 72 + i] = (bf16_t)(hi >> 16); }
__device__ __forceinline__ void stg4(bf16_t* dst, int i, int j0, f32x4 v) { *(u32x2*)(dst + i * 64 + j0) = pack4(v[0], v[1], v[2], v[3]); }
#define ZACC() do { acc[0] = (f32x4){0.f, 0.f, 0.f, 0.f}; acc[1] = (f32x4){0.f, 0.f, 0.f, 0.f}; } while (0)

__device__ void p3a_chunks(const Args& a, LAS unsigned char* lds) {
    const int tid = threadIdx.x, G = gridDim.x, blk = blockIdx.x, wave = tid >> 6, lane = tid & 63, fr = lane & 15, fq = lane >> 4;
    unsigned char* ws = a.ws;
    const bf16_t* SCN = (const bf16_t*)(ws + OFF_SCNS) - (size_t)MP * 8 * 384;
    bf16_t* CHK = (bf16_t*)(ws + OFF_CHK); const bf16_t* Z = (const bf16_t*)(ws + OFF_Z); float* RK = (float*)(ws + OFF_RK);
    const bf16_t* WupT = (const bf16_t*)(ws + OFF_WUP); const bf16_t* AupT = (const bf16_t*)(ws + OFF_AUP);
    LAS bf16_t* SL = (LAS bf16_t*)lds;
#define S_(n) (SL + (n) * SLOT)
    LAS bf16_t* zraw = S_(8);
    LAS float* tot = (LAS float*)(lds + 17 * SLOT * 2);
    LAS float* pc = tot + 512;
    LAS float* LWf = (LAS float*)(lds + 2 * SLOT * 2);
    LAS float* LAf = (LAS float*)(lds + 4 * SLOT * 2);
    const int it = wave >> 1, jt0 = (wave & 1) * 2, irow = it * 16 + fr;
    u32x4 rg[6];
#define P3A_LOAD(unit_) do { const int bh_ = (unit_) >> 5, c_ = (unit_) & 31; const int mm0 = (bh_ >> 3) * TSEQ + c_ * 64; const int hh = bh_ & 7; \
        _Pragma("unroll") for (int i = 0; i < 6; ++i) { const int p = tid + 512 * i; if (p < 65 * 40) { const int rr = p / 40, sg = p - rr * 40, seg = sg >> 3, o8 = sg & 7; \
            const int col = seg < 3 ? (ZC_S + seg * 512 + hh * 64) : (ZC_S + 1536 + (seg - 3) * 64); const int mrow = (rr == 0 && c_ == 0) ? mm0 : (mm0 - 1 + rr); \
            rg[i] = *(const u32x4*)(Z + (size_t)mrow * NZ + col + o8 * 8); } } } while (0)
    if (blk < 2048) P3A_LOAD(blk);
    int hcur = -1;
    float mur = 0.f, muk = 0.f, muv = 0.f, muwd = 0.f, muad = 0.f, w0k = 0.f, a0k = 0.f, kkk = 0.f, kak = 0.f, rkk = 0.f;
    for (int unit = blk; unit < 2048; unit += G) {
        const int h = (unit >> 5) & 7, c = unit & 31, k = tid & 63, g = tid >> 6;
        if (h != hcur) {
            const float* mu = a.in[10];
            mur = mu[h * 64 + k]; muk = mu[512 + h * 64 + k]; muv = mu[1024 + h * 64 + k]; muwd = mu[1536 + k]; muad = mu[1600 + k];
            w0k = a.in[11][h * 64 + k]; a0k = a.in[13][h * 64 + k]; kkk = a.in[15][h * 64 + k]; kak = a.in[16][h * 64 + k]; rkk = a.in[17][h * 64 + k];
            const int row = tid >> 3, o8 = tid & 7;
            *(LAS u32x4*)(S_(15) + row * 72 + o8 * 8) = *(const u32x4*)(WupT + (size_t)(h * 64 + row) * 64 + o8 * 8);
            *(LAS u32x4*)(S_(16) + row * 72 + o8 * 8) = *(const u32x4*)(AupT + (size_t)(h * 64 + row) * 64 + o8 * 8);
            hcur = h; }
#pragma unroll
        for (int i = 0; i < 6; ++i) { const int p = tid + 512 * i; if (p < 65 * 40) { const int rr = p / 40, sg = p - rr * 40, seg = sg >> 3, o8 = sg & 7; *(LAS u32x4*)(zraw + rr * 320 + seg * 64 + o8 * 8) = rg[i]; } }
        LBAR();
        float r_[8], kx[8], v_[8];
        {
            const float fp0 = (c != 0) ? 1.f : 0.f;
            float zz[9][5];
#pragma unroll
            for (int rr = 0; rr < 9; ++rr) { const LAS bf16_t* zp_ = zraw + (g * 8 + rr) * 320 + k;
#pragma unroll
                for (int sg = 0; sg < 5; ++sg) zz[rr][sg] = bf2f(zp_[sg * 64]); }
            if (g == 0) {
#pragma unroll
                for (int sg = 0; sg < 5; ++sg) zz[0][sg] *= fp0; }
#pragma unroll
            for (int j = 0; j < 8; ++j) { const int t = g * 8 + j;
                const float c0 = zz[j + 1][0], c1 = zz[j + 1][1], c2 = zz[j + 1][2], c3 = zz[j + 1][3], c4 = zz[j + 1][4];
                const float p0 = zz[j][0], p1 = zz[j][1], p2 = zz[j][2], p3 = zz[j][3], p4 = zz[j][4];
                r_[j] = c0 + (p0 - c0) * mur; kx[j] = c1 + (p1 - c1) * muk; v_[j] = c2 + (p2 - c2) * muv;
                const float wd = c3 + (p3 - c3) * muwd, ad = c4 + (p4 - c4) * muad;
                const float e2 = __expf(2.0f * wd);
                S_(0)[t * 72 + k] = f2bf(1.0f - 2.0f * __builtin_amdgcn_rcpf(e2 + 1.0f)); S_(1)[t * 72 + k] = f2bf(ad); }
        }
        LBAR();
        f32x4 acc[2];
        ZACC(); mm_nt(S_(0), S_(15), it, jt0, fr, fq, acc);
#pragma unroll
        for (int u = 0; u < 2; ++u) *(LAS f32x4*)(LWf + irow * 64 + (jt0 + u) * 16 + 4 * fq) = acc[u];
        ZACC(); mm_nt(S_(1), S_(16), it, jt0, fr, fq, acc);
#pragma unroll
        for (int u = 0; u < 2; ++u) *(LAS f32x4*)(LAf + irow * 64 + (jt0 + u) * 16 + 4 * fq) = acc[u];
        LBAR();
        {
            float ev[8], cs[8], qn[8], bbv[8], kpv[8]; float run = 0.f;
#pragma unroll
            for (int j = 0; j < 8; ++j) { const int t = g * 8 + j;
                const float e = 0.60653065971f * sigmoidf_(w0k + LWf[t * 64 + k]); const float al = sigmoidf_(a0k + LAf[t * 64 + k]);
                const float kq = kx[j] * kkk, kp = kx[j] * (1.0f + (al - 1.0f) * kak);
                float ss = kq * kq, rs_ = r_[j] * kp * rkk;
                ss = rowsum16(ss); rs_ = rowsum16(rs_);
                ss += __shfl_xor(ss, 16); rs_ += __shfl_xor(rs_, 16); ss += __shfl_xor(ss, 32); rs_ += __shfl_xor(rs_, 32);
                const float inv = __builtin_amdgcn_rsqf(fmaxf(ss, 1e-24f));
                qn[j] = kq * inv; bbv[j] = qn[j] * al; kpv[j] = kp;
                if (lane == 0) RK[(size_t)unit * 64 + t] = rs_;
                ev[j] = e; run += e; cs[j] = run; }
            tot[g * 64 + k] = run;
            LBAR();
            float off = 0.f;
#pragma unroll
            for (int gg = 0; gg < 7; ++gg) { const float tv = tot[gg * 64 + k]; off += gg < g ? tv : 0.f; }
            float ak[8], bk[8], kk_[8];
#pragma unroll
            for (int j = 0; j < 8; ++j) { const int t = g * 8 + j; const float cum = off + cs[j];
                const float P = __expf(-cum), Pm1 = __expf(ev[j] - cum), iP = __builtin_amdgcn_rcpf(P);
                const float at = -qn[j] * Pm1, bt = bbv[j] * iP, kt = kpv[j] * iP, rt = r_[j] * P;
                S_(0)[t * 72 + k] = f2bf(at); S_(1)[t * 72 + k] = f2bf(bt); S_(2)[t * 72 + k] = f2bf(kt); S_(3)[t * 72 + k] = f2bf(rt);
                ak[j] = at; bk[j] = bt; kk_[j] = kt;
                if (j == 7 && g == 7) pc[k] = P; }
            *(LAS u32x4*)(S_(4) + k * 72 + g * 8) = pack8(ak); *(LAS u32x4*)(S_(5) + k * 72 + g * 8) = pack8(bk);
            *(LAS u32x4*)(S_(6) + k * 72 + g * 8) = pack8(kk_); *(LAS u32x4*)(S_(7) + k * 72 + g * 8) = pack8(v_);
        }
        LBAR();
        { const int nxt = (unit + G < 2048) ? unit + G : unit; P3A_LOAD(nxt); }
        ZACC(); mm_nt(S_(0), S_(1), it, jt0, fr, fq, acc);
#pragma unroll
        for (int u = 0; u < 2; ++u) { const int j0 = (jt0 + u) * 16 + 4 * fq; f32x4 v = mask4<1>(acc[u], irow, j0); st4(S_(11), irow, j0, v); st4t(S_(12), irow, j0, v);
#pragma unroll
            for (int e = 0; e < 4; ++e) v[e] += (j0 + e == irow) ? 1.f : 0.f;
            st4(S_(13), irow, j0, v); }
        ZACC(); mm_nt(S_(0), S_(2), it, jt0, fr, fq, acc);
#pragma unroll
        for (int u = 0; u < 2; ++u) { const int j0 = (jt0 + u) * 16 + 4 * fq; st4(S_(8), irow, j0, mask4<1>(acc[u], irow, j0)); }
        ZACC(); mm_nt(S_(3), S_(1), it, jt0, fr, fq, acc);
#pragma unroll
        for (int u = 0; u < 2; ++u) { const int j0 = (jt0 + u) * 16 + 4 * fq; st4(S_(9), irow, j0, mask4<3>(acc[u], irow, j0)); }
        ZACC(); mm_nt(S_(3), S_(2), it, jt0, fr, fq, acc);
#pragma unroll
        for (int u = 0; u < 2; ++u) { const int j0 = (jt0 + u) * 16 + 4 * fq; st4(S_(10), irow, j0, mask4<3>(acc[u], irow, j0)); }
        LBAR();
        ZACC(); mm_nt(S_(11), S_(12), it, jt0, fr, fq, acc);
#pragma unroll
        for (int u = 0; u < 2; ++u) { st4(S_(1), irow, (jt0 + u) * 16 + 4 * fq, acc[u]); st4t(S_(2), irow, (jt0 + u) * 16 + 4 * fq, acc[u]); }
        ZACC(); mm_nt(S_(7), S_(8), it, jt0, fr, fq, acc);
#pragma unroll
        for (int u = 0; u < 2; ++u) st4(S_(0), irow, (jt0 + u) * 16 + 4 * fq, acc[u]);
        LBAR();
#pragma unroll
        for (int sgi = 0; sgi < 4; ++sgi) {
            const int pa = (sgi & 1) ? 11 : 1, pta = (sgi & 1) ? 12 : 2, pb = (sgi & 1) ? 1 : 11, ptb = (sgi & 1) ? 2 : 12, tla = (sgi & 1) ? 14 : 13, tlb = (sgi & 1) ? 13 : 14;
            ZACC(); mm_nt(S_(tla), S_(pta), it, jt0, fr, fq, acc);
#pragma unroll
            for (int u = 0; u < 2; ++u) { const int j0 = (jt0 + u) * 16 + 4 * fq; st4(S_(tlb), irow, j0, acc[u] + ld4(S_(tla), irow, j0)); }
            ZACC(); mm_nt(S_(pa), S_(pta), it, jt0, fr, fq, acc);
#pragma unroll
            for (int u = 0; u < 2; ++u) { if (sgi < 3) st4(S_(pb), irow, (jt0 + u) * 16 + 4 * fq, acc[u]); st4t(S_(ptb), irow, (jt0 + u) * 16 + 4 * fq, acc[u]); }
            LBAR();
        }
        ZACC(); mm_nt(S_(13), S_(2), it, jt0, fr, fq, acc);
#pragma unroll
        for (int u = 0; u < 2; ++u) { const int j0 = (jt0 + u) * 16 + 4 * fq; st4(S_(14), irow, j0, acc[u] + ld4(S_(13), irow, j0)); }
        LBAR();
        ZACC(); mm_nt(S_(0), S_(14), it, jt0, fr, fq, acc);
#pragma unroll
        for (int u = 0; u < 2; ++u) st4(S_(1), irow, (jt0 + u) * 16 + 4 * fq, acc[u]);
        ZACC(); mm_nt(S_(4), S_(14), it, jt0, fr, fq, acc);
#pragma unroll
        for (int u = 0; u < 2; ++u) st4(S_(2), irow, (jt0 + u) * 16 + 4 * fq, acc[u]);
        LBAR();
        bf16_t* chk = CHK + (size_t)unit * 16384;
        ZACC();
        mm_nt(S_(9), S_(2), it, jt0, fr, fq, acc);
#pragma unroll
        for (int u = 0; u < 2; ++u) { const int j0 = (jt0 + u) * 16 + 4 * fq; stg4(chk, irow, j0, acc[u] + ld4(S_(3), irow, j0)); }
        ZACC();
        mm_nt(S_(9), S_(1), it, jt0, fr, fq, acc);
        mm_nt(S_(10), S_(7), it, jt0, fr, fq, acc);
#pragma unroll
        for (int u = 0; u < 2; ++u) stg4(chk + 4096, irow, (jt0 + u) * 16 + 4 * fq, acc[u]);
        ZACC();
        mm_nt(S_(1), S_(5), it, jt0, fr, fq, acc);
        mm_nt(S_(7), S_(6), it, jt0, fr, fq, acc);
#pragma unroll
        for (int u = 0; u < 2; ++u) { const int j0 = (jt0 + u) * 16 + 4 * fq; const f32x4 pv = *(const LAS f32x4*)(pc + j0); stg4(chk + 8192, irow, j0, acc[u] * pv); }
        ZACC();
        mm_nt(S_(5), S_(2), it, jt0, fr, fq, acc);
        { const float pr = pc[irow];
#pragma unroll
          for (int u = 0; u < 2; ++u) { const int j0 = (jt0 + u) * 16 + 4 * fq; f32x4 v = acc[u];
#pragma unroll
              for (int e = 0; e < 4; ++e) v[e] = (v[e] + ((j0 + e == irow) ? 1.f : 0.f)) * pr;
              stg4(chk + 12288, irow, j0, v); } }
        LBAR();
    }
#undef P3A_LOAD
#undef S_
}

__device__ void p3_sample_step(const Args& a, int blk, int G) {
    const int tid = threadIdx.x;
    unsigned char* ws = a.ws;
    const bf16_t* SCN = (const bf16_t*)(ws + OFF_SCNS) - (size_t)MP * 8 * 384;
    const float* state_wkv = a.in[6]; bf16_t* OS = (bf16_t*)(ws + OFF_OS);
    const int row = tid >> 3, c0 = (tid & 7) * 8;
    constexpr int NI = 4;
    for (int it0 = blk; it0 < MS * NH; it0 += G * NI) {
        u32x4 q[NI][5]; f32x4 sA[NI], sB[NI]; unsigned short vq[NI];
#pragma unroll
        for (int n = 0; n < NI; ++n) { const int itn = (it0 + n * G < MS * NH) ? it0 + n * G : it0; const int s_ = itn >> 3, h = itn & 7, m = MP + s_;
            const bf16_t* sc = SCN + ((size_t)m * 8 + h) * 384; const size_t so = ((size_t)(s_ * 8 + h) * 64 + row) * 64 + c0;
            q[n][0] = *(const u32x4*)(sc + c0); q[n][1] = *(const u32x4*)(sc + 64 + c0); q[n][2] = *(const u32x4*)(sc + 128 + c0); q[n][3] = *(const u32x4*)(sc + 256 + c0); q[n][4] = *(const u32x4*)(sc + 320 + c0);
            vq[n] = sc[192 + row]; sA[n] = *(const f32x4*)(state_wkv + so); sB[n] = *(const f32x4*)(state_wkv + so + 4); }
#pragma unroll
        for (int n = 0; n < NI; ++n) { const int itn = it0 + n * G; if (itn < MS * NH) { const int s_ = itn >> 3, h = itn & 7;
            float r_[8], e_[8], kp[8], kq[8], bb[8];
            unpack8(q[n][0], r_); unpack8(q[n][1], e_); unpack8(q[n][2], kp); unpack8(q[n][3], kq); unpack8(q[n][4], bb);
            const float vv = bf2f(vq[n]);
            const size_t so = ((size_t)(s_ * 8 + h) * 64 + row) * 64 + c0;
            float S[8] = {sA[n][0], sA[n][1], sA[n][2], sA[n][3], sB[n][0], sB[n][1], sB[n][2], sB[n][3]};
            float d = 0.f;
#pragma unroll
            for (int i = 0; i < 8; ++i) d += S[i] * kq[i];
            d += __shfl_xor(d, 1); d += __shfl_xor(d, 2); d += __shfl_xor(d, 4);
            float y = 0.f;
#pragma unroll
            for (int i = 0; i < 8; ++i) { S[i] = S[i] * __expf(-e_[i]) + (-d) * bb[i] + vv * kp[i]; y += S[i] * r_[i]; }
            y += __shfl_xor(y, 1); y += __shfl_xor(y, 2); y += __shfl_xor(y, 4);
            *(f32x4*)(a.out + O_WKVS + so) = (f32x4){S[0], S[1], S[2], S[3]}; *(f32x4*)(a.out + O_WKVS + so + 4) = (f32x4){S[4], S[5], S[6], S[7]};
            if ((tid & 7) == 0) OS[(size_t)s_ * 512 + h * 64 + row] = f2bf(y); } }
    }
}

__device__ void p3b_seq(const Args& a, LAS unsigned char* lds) {
    const int tid = threadIdx.x, G = gridDim.x, blk = blockIdx.x, wave = tid >> 6, lane = tid & 63, fr = lane & 15, fq = lane >> 4;
    unsigned char* ws = a.ws;
    const bf16_t* CHK = (const bf16_t*)(ws + OFF_CHK); bf16_t* SALL = (bf16_t*)(ws + OFF_SALL);
    LAS bf16_t* Shi = (LAS bf16_t*)lds; LAS bf16_t* Slo = Shi + 2 * 16 * 72;
    for (int item = blk; item < 256; item += G) {
        const int xcd_ = item & 7, idx_ = item >> 3;
        const int bh = (G == 256) ? xcd_ * 8 + (idx_ >> 2) : (item >> 2), q = (G == 256) ? (idx_ & 3) : (item & 3), j = wave;
        LBAR();
        for (int i = tid; i < 16 * 72; i += 512) { Shi[i] = 0; Slo[i] = 0; }
        LBAR();
        const bf16_t* chk0 = CHK + (size_t)(bh * 32) * 16384;
        constexpr int PF = 8;
        const size_t goff = 12288 + (size_t)(j * 16 + fr) * 64 + fq * 8, hoff = 8192 + (size_t)(q * 16 + fr) * 64 + j * 16 + 4 * fq;
        bf16x8 GA0[PF], GA1[PF], GB0[PF], GB1[PF]; u32x2 HA[PF], HB[PF];
#define P3B_LOAD(G0, G1, HQ, c0) do { if (wave < 4) { _Pragma("unroll") for (int u = 0; u < PF; ++u) { const bf16_t* cn = chk0 + (size_t)((c0) + u) * 16384; \
            G0[u] = *(const bf16x8*)(cn + goff); G1[u] = *(const bf16x8*)(cn + goff + 32); HQ[u] = *(const u32x2*)(cn + hoff); } } } while (0)
#define P3B_STEPS(G0, G1, HQ, c0) do { _Pragma("unroll") for (int u = 0; u < PF; ++u) { const int c = (c0) + u; \
            if (wave < 4) { \
                const bf16x8 cg0 = G0[u], cg1 = G1[u]; const u32x2 chq = HQ[u]; \
                const LAS bf16_t* sh = Shi + (c & 1) * (16 * 72) + fr * 72 + fq * 8; const LAS bf16_t* sl = Slo + (c & 1) * (16 * 72) + fr * 72 + fq * 8; \
                const bf16x8 h0 = *(const LAS bf16x8*)sh, h1 = *(const LAS bf16x8*)(sh + 32), l0 = *(const LAS bf16x8*)sl, l1 = *(const LAS bf16x8*)(sl + 32); \
                bf16_t* sg = SALL + (size_t)(bh * 32 + c) * 4096 + (q * 16 + fr) * 64 + fq * 8; \
                if (wave == 0) *(bf16x8*)sg = h0; \
                if (wave == 1) *(bf16x8*)(sg + 32) = h1; \
                f32x4 acc = {0.f, 0.f, 0.f, 0.f}; \
                acc = __builtin_amdgcn_mfma_f32_16x16x32_bf16(cg0, h0, acc, 0, 0, 0); acc = __builtin_amdgcn_mfma_f32_16x16x32_bf16(cg1, h1, acc, 0, 0, 0); \
                acc = __builtin_amdgcn_mfma_f32_16x16x32_bf16(cg0, l0, acc, 0, 0, 0); acc = __builtin_amdgcn_mfma_f32_16x16x32_bf16(cg1, l1, acc, 0, 0, 0); \
                float hv[4]; unpack4(chq, hv); \
                const float s0 = acc[0] + hv[0], s1 = acc[1] + hv[1], s2 = acc[2] + hv[2], s3 = acc[3] + hv[3]; \
                const u32x2 ph = pack4(s0, s1, s2, s3); float hf[4]; unpack4(ph, hf); \
                const u32x2 pl = pack4(s0 - hf[0], s1 - hf[1], s2 - hf[2], s3 - hf[3]); \
                const int wo = ((c + 1) & 1) * (16 * 72) + fr * 72 + j * 16 + 4 * fq; \
                *(LAS u32x2*)(Shi + wo) = ph; *(LAS u32x2*)(Slo + wo) = pl; \
                if (c == 31) *(f32x4*)(a.out + O_WKVP + ((size_t)bh * 64 + q * 16 + fr) * 64 + j * 16 + 4 * fq) = (f32x4){s0, s1, s2, s3}; \
            } \
            LBAR(); } } while (0)
        P3B_LOAD(GA0, GA1, HA, 0); P3B_LOAD(GB0, GB1, HB, 8);
        P3B_STEPS(GA0, GA1, HA, 0); P3B_LOAD(GA0, GA1, HA, 16);
        P3B_STEPS(GB0, GB1, HB, 8); P3B_LOAD(GB0, GB1, HB, 24);
        P3B_STEPS(GA0, GA1, HA, 16);
        P3B_STEPS(GB0, GB1, HB, 24);
#undef P3B_LOAD
#undef P3B_STEPS
    }
}

__device__ void p3c_out(const Args& a) {
    const int tid = threadIdx.x, G = gridDim.x, blk = blockIdx.x, wave = tid >> 6, lane = tid & 63, fr = lane & 15, fq = lane >> 4;
    unsigned char* ws = a.ws;
    const bf16_t* SCN = (const bf16_t*)(ws + OFF_SCNS) - (size_t)MP * 8 * 384; const bf16_t* CHK = (const bf16_t*)(ws + OFF_CHK); const bf16_t* SALL = (const bf16_t*)(ws + OFF_SALL); bf16_t* YC = (bf16_t*)a.out;
    const bf16_t* Z = (const bf16_t*)(ws + OFF_Z); const float* RK = (const float*)(ws + OFF_RK); const float* mu = a.in[10];
    const float* r_k = a.in[17]; const float* ln_w = a.in[18]; const float* ln_b = a.in[19];
    for (int pi = blk; pi < 1024; pi += G) {
        const int unit = pi * 2 + (wave >> 2), it = wave & 3, bh = unit >> 5, c = unit & 31, b = bh >> 3, h = bh & 7;
        const int m = b * TSEQ + c * 64 + it * 16 + fr;
        const bf16_t* chk = CHK + (size_t)unit * 16384; const bf16_t* sall = SALL + (size_t)unit * 4096;
        bf16x8 xq[2];
#pragma unroll
        for (int ks = 0; ks < 2; ++ks) xq[ks] = *(const bf16x8*)(chk + (it * 16 + fr) * 64 + ks * 32 + fq * 8);
        const bool hasprev = (c * 64 + it * 16 + fr) >= 1;
        const bf16_t* zv = Z + (size_t)m * NZ + ZC_S + 1024 + h * 64 + 8 * fq; const bf16_t* zvp = hasprev ? zv - NZ : zv; const float fpv = hasprev ? 1.f : 0.f;
        const float rk = RK[(size_t)unit * 64 + it * 16 + fr];
        bf16_t* yp = YC + (size_t)m * D + 512 + h * 64 + 8 * fq;
        f32x4 acc[4]; u32x4 qy[2], qv[2], qvp[2], qg[2];
#pragma unroll
        for (int P = 0; P < 2; ++P) { qy[P] = *(const u32x4*)(chk + 4096 + (it * 16 + fr) * 64 + 32 * P + 8 * fq);
            qv[P] = *(const u32x4*)(zv + 32 * P); qvp[P] = *(const u32x4*)(zvp + 32 * P); qg[P] = *(const u32x4*)(yp + 32 * P); }
#pragma unroll
        for (int jt = 0; jt < 4; ++jt) { acc[jt] = (f32x4){0.f, 0.f, 0.f, 0.f}; const int srow = 32 * (jt >> 1) + 8 * (fr >> 2) + 4 * (jt & 1) + (fr & 3);
#pragma unroll
            for (int ks = 0; ks < 2; ++ks) acc[jt] = __builtin_amdgcn_mfma_f32_16x16x32_bf16(*(const bf16x8*)(sall + srow * 64 + ks * 32 + fq * 8), xq[ks], acc[jt], 0, 0, 0);
        }
        float o[2][8], vv[2][8]; float sm = 0.f;
#pragma unroll
        for (int P = 0; P < 2; ++P) { float yl[8], vc[8], vp[8]; unpack8(qy[P], yl); unpack8(qv[P], vc); unpack8(qvp[P], vp);
            const float* mvp = mu + 1024 + h * 64 + 32 * P + 8 * fq; const f32x4 mv0 = *(const f32x4*)mvp, mv1 = *(const f32x4*)(mvp + 4);
#pragma unroll
            for (int i = 0; i < 8; ++i) { const float mvi = i < 4 ? mv0[i & 3] : mv1[i & 3]; o[P][i] = acc[2 * P + (i >> 2)][i & 3] + yl[i]; sm += o[P][i]; vv[P][i] = vc[i] + (vp[i] * fpv - vc[i]) * mvi; } }
        sm += __shfl_xor(sm, 16); sm += __shfl_xor(sm, 32);
        const float mean = sm * (1.0f / 64.0f); float var = 0.f;
#pragma unroll
        for (int P = 0; P < 2; ++P)
#pragma unroll
            for (int i = 0; i < 8; ++i) { o[P][i] -= mean; var += o[P][i] * o[P][i]; }
        var += __shfl_xor(var, 16); var += __shfl_xor(var, 32);
        const float rstd = rsqrtf(var * (1.0f / 64.0f) + 64e-5f);
#pragma unroll
        for (int P = 0; P < 2; ++P) { const int ch = h * 64 + 32 * P + 8 * fq; const f32x4 lw0 = *(const f32x4*)(ln_w + ch), lw1 = *(const f32x4*)(ln_w + ch + 4), lb0 = *(const f32x4*)(ln_b + ch), lb1 = *(const f32x4*)(ln_b + ch + 4);
            float gt[8], y[8]; unpack8(qg[P], gt);
#pragma unroll
            for (int i = 0; i < 8; ++i) { const float lwi = i < 4 ? lw0[i & 3] : lw1[i & 3], lbi = i < 4 ? lb0[i & 3] : lb1[i & 3]; y[i] = (o[P][i] * rstd * lwi + lbi + rk * vv[P][i]) * gt[i]; }
            *(u32x4*)(yp + 32 * P) = pack8(y); }
    }
    const bf16_t* OS = (const bf16_t*)(ws + OFF_OS);
    const int c = lane * 8, h = lane >> 3, cc = (lane & 7) * 8;
    for (int s = blk * 8 + wave; s < MS; s += G * 8) {
        const int m = MP + s;
        float o[8], r_[8], kp[8], v_[8], g[8];
        const bf16_t* sc = SCN + ((size_t)m * 8 + h) * 384 + cc;
        unpack8(*(const u32x4*)(OS + (size_t)s * 512 + c), o); unpack8(*(const u32x4*)(sc), r_); unpack8(*(const u32x4*)(sc + 128), kp); unpack8(*(const u32x4*)(sc + 192), v_);
        unpack8(*(const u32x4*)(YC + (size_t)m * D + 512 + c), g);
        float sm = 0.f, rk = 0.f;
#pragma unroll
        for (int i = 0; i < 8; ++i) { sm += o[i]; rk += r_[i] * kp[i] * r_k[h * 64 + cc + i]; }
        sm += __shfl_xor(sm, 1); sm += __shfl_xor(sm, 2); sm += __shfl_xor(sm, 4);
        rk += __shfl_xor(rk, 1); rk += __shfl_xor(rk, 2); rk += __shfl_xor(rk, 4);
        const float mean = sm * (1.0f / 64.0f);
        float var = 0.f;
#pragma unroll
        for (int i = 0; i < 8; ++i) { o[i] -= mean; var += o[i] * o[i]; }
        var += __shfl_xor(var, 1); var += __shfl_xor(var, 2); var += __shfl_xor(var, 4);
        const float rstd = rsqrtf(var * (1.0f / 64.0f) + 64e-5f);
        float y[8];
#pragma unroll
        for (int i = 0; i < 8; ++i) y[i] = (o[i] * rstd * ln_w[c + i] + ln_b[c + i] + rk * v_[i]) * g[i];
        *(u32x4*)(YC + (size_t)m * D + 512 + c) = pack8(y);
    }
}

__device__ void p5_out(const Args& a, LAS unsigned char* lds) {
    const int tid = threadIdx.x, G = gridDim.x, blk = blockIdx.x, wave = tid >> 6, lane = tid & 63, fr = lane & 15, fq = lane >> 4;
    unsigned char* ws = a.ws;
    const bf16_t* YC = (const bf16_t*)a.out; const bf16_t* WoutT = (const bf16_t*)(ws + OFF_WOUT); const bf16_t* PB = (const bf16_t*)(ws + OFF_PB); const bf16_t* WppT = (const bf16_t*)(ws + OFF_WPP);
    bf16_t* H1B = (bf16_t*)(ws + OFF_H1B); bf16_t* PP = (bf16_t*)((unsigned char*)a.out + PPD_OFF);
    { pg8::Gemm g{YC, WoutT, MP, D, D}; pg8::StaticOrder S; S.init(MP, D, G, blk); EpiH1 E{a.in[0], H1B}; pg8::gemm_phase<EpiH1, pg8::StaticOrder>(lds, g, S, E, nullptr); }
    for (int t2 = blk; t2 < 256; t2 += G) {
        const int tile = t2 * 2 + (wave >> 2), ks = wave & 3, rt = tile & 7, ct = tile >> 3; const int row = MP + rt * 16 + fr; const size_t o = (size_t)row * D + ct * 16 + 4 * fq;
        f32x4 acc = mini_tile_k<8>(YC + (size_t)row * D + ks * 256, WoutT + (size_t)(ct * 16 + fr) * D + ks * 256, fq);
        f32x4 acp = mini_tile_k<2>(PB + (size_t)row * DP + ks * 64, WppT + (size_t)(ct * 16 + fr) * DP + ks * 64, fq);
        acc = splitk_reduce(lds, acc, wave, lane);
        acp = splitk_reduce(lds, acp, wave, lane);
        if (ks == 0) {
            const f32x4 v = *(const f32x4*)(a.in[1] + (size_t)(row - MP) * D + ct * 16 + 4 * fq) + acc;
            *(u32x2*)(H1B + o) = pack4(v[0], v[1], v[2], v[3]);
            *(u32x2*)(PP + o) = pack4(acp[0], acp[1], acp[2], acp[3]);
        }
    }
}

__device__ void p6_gate(const Args& a, LAS unsigned char* lds) {
    const int tid = threadIdx.x, G = gridDim.x, blk = blockIdx.x, wave = tid >> 6, lane = tid & 63, fr = lane & 15, fq = lane >> 4;
    unsigned char* ws = a.ws;
    const bf16_t* WpgT = (const bf16_t*)(ws + OFF_WPG); const bf16_t* H1B = (const bf16_t*)(ws + OFF_H1B); const bf16_t* PP = (const bf16_t*)((const unsigned char*)a.out + PPD_OFF);
    { pg8::Gemm g{H1B, WpgT, MP, D, D}; pg8::StaticOrder S; S.init(MP, D, G, blk); EpiH2 E{H1B, PP, (bf16_t*)(ws + OFF_H2B)}; pg8::gemm_phase<EpiH2, pg8::StaticOrder>(lds, g, S, E, nullptr); }
    for (int t2 = blk; t2 < 256; t2 += G) {
        const int tile = t2 * 2 + (wave >> 2), ks = wave & 3, rt = tile & 7, ct = tile >> 3; const int row = MP + rt * 16 + fr; const size_t o = (size_t)row * D + ct * 16 + 4 * fq;
        f32x4 g = mini_tile_k<8>(H1B + (size_t)row * D + ks * 256, WpgT + (size_t)(ct * 16 + fr) * D + ks * 256, fq);
        g = splitk_reduce(lds, g, wave, lane);
        if (ks == 0) {
            float h[4], p[4]; unpack4(*(const u32x2*)(H1B + o), h); unpack4(*(const u32x2*)(PP + o), p);
            f32x4 v; v[0] = h[0] + sigmoidf_(g[0]) * p[0]; v[1] = h[1] + sigmoidf_(g[1]) * p[1]; v[2] = h[2] + sigmoidf_(g[2]) * p[2]; v[3] = h[3] + sigmoidf_(g[3]) * p[3];
            *(u32x2*)((bf16_t*)(ws + OFF_H2B) + o) = pack4(v[0], v[1], v[2], v[3]);
        }
    }
}

__device__ void p7_norm(const Args& a) {
    const int tid = threadIdx.x, G = gridDim.x, blk = blockIdx.x, wave = tid >> 6, lane = tid & 63;
    const float* fg = a.in[23]; const bf16_t* H2B = (const bf16_t*)(a.ws + OFF_H2B);
    f32x4 gv[2][2];
#pragma unroll
    for (int i = 0; i < 2; ++i) { gv[i][0] = *(const f32x4*)(fg + i * 512 + lane * 8); gv[i][1] = *(const f32x4*)(fg + i * 512 + lane * 8 + 4); }
    for (int row0 = (blk * 8 + wave) * 4; row0 < MT; row0 += G * 32) {
        u32x4 q[4][2];
#pragma unroll
        for (int r = 0; r < 4; ++r)
#pragma unroll
            for (int i = 0; i < 2; ++i) q[r][i] = *(const u32x4*)(H2B + (size_t)(row0 + r) * D + i * 512 + lane * 8);
#pragma unroll
        for (int r = 0; r < 4; ++r) { float f[2][8]; unpack8(q[r][0], f[0]); unpack8(q[r][1], f[1]); float ss = 0.f;
#pragma unroll
            for (int i = 0; i < 2; ++i)
#pragma unroll
                for (int e = 0; e < 8; ++e) ss += f[i][e] * f[i][e];
#pragma unroll
            for (int o = 32; o >= 1; o >>= 1) ss += __shfl_xor(ss, o);
            const float rs = rsqrtf(ss * (1.0f / D) + 1e-6f);
#pragma unroll
            for (int i = 0; i < 2; ++i) { float* yp = a.out + (size_t)(row0 + r) * D + i * 512 + lane * 8;
                *(f32x4*)(yp) = (f32x4){f[i][0], f[i][1], f[i][2], f[i][3]} * rs * gv[i][0]; *(f32x4*)(yp + 4) = (f32x4){f[i][4], f[i][5], f[i][6], f[i][7]} * rs * gv[i][1]; } }
    }
}

#define XB_TMO      128
#define XB_XCNT(j)  (256  + 64 * (j))
#define XB_XSUB(j)  (1280 + 64 * (j))
#define XB_XGEN(j)  (2304 + 64 * (j))
#define XB_TOP      3328
#define XB_TOPGEN   3392
#define XCD_BAR_WORDS 3456
#define XB_SPIN_CAP (1u << 18)

__device__ __forceinline__ unsigned xb_ld(unsigned* p)              { return __hip_atomic_load(p, __ATOMIC_RELAXED, __HIP_MEMORY_SCOPE_AGENT); }
__device__ __forceinline__ unsigned xb_add(unsigned* p, unsigned v) { return __hip_atomic_fetch_add(p, v, __ATOMIC_RELAXED, __HIP_MEMORY_SCOPE_AGENT); }
__device__ __forceinline__ unsigned xb_xcc_id() { return (unsigned)__builtin_amdgcn_s_getreg((3 << 11) | 20) & 0xFu; }
#define XB_SPIN(cond, bar) do { unsigned _sp = 0; while (cond) { __builtin_amdgcn_s_sleep(1); \
    if ((++_sp & 255u) == 0u) { if (xb_ld(&(bar)[XB_TMO])) break; if (_sp > XB_SPIN_CAP) { atomicAdd(&(bar)[XB_TMO], 1u); break; } } } } while (0)

struct XcdBarrier {
    unsigned* bar; unsigned x;
    volatile LAS unsigned* st;
};

__device__ __forceinline__ XcdBarrier xcd_barrier_post(unsigned* bar, volatile LAS unsigned* st) {
    XcdBarrier b; b.bar = bar; b.x = xb_xcc_id(); b.st = st;
    if (threadIdx.x == 0) (void)xb_add(&bar[XB_XCNT(b.x)], 1u);
    return b;
}
__device__ __forceinline__ void xcd_barrier_complete(unsigned* bar, unsigned x, unsigned& nloc, unsigned& nx) {
    const unsigned G = gridDim.x * gridDim.y * gridDim.z;
    unsigned sum, cnt, mine, sp = 0u;
    for (;;) {
        sum = 0u; cnt = 0u; mine = 0u;
#pragma unroll
        for (unsigned j = 0; j < 16; ++j) { const unsigned c = xb_ld(&bar[XB_XCNT(j)]); sum += c; cnt += (c > 0u) ? 1u : 0u; mine = (j == x) ? c : mine; }
        if (sum == G) break;
        __builtin_amdgcn_s_sleep(1);
        if ((++sp & 255u) == 0u) { if (xb_ld(&bar[XB_TMO])) break; if (sp > XB_SPIN_CAP) { atomicAdd(&bar[XB_TMO], 1u); break; } }
    }
    nloc = mine > 0u ? mine : 1u; nx = cnt > 0u ? cnt : 1u;
}

__device__ __forceinline__ void xcd_barrier(const XcdBarrier& b) {
    asm volatile("s_waitcnt vmcnt(0)" ::: "memory");
    __syncthreads();
    if (threadIdx.x == 0) {
        unsigned* bar = b.bar;
        __builtin_amdgcn_s_waitcnt(0);
        unsigned nloc = b.st[0], nx = b.st[1];
        if (nloc == 0u) { xcd_barrier_complete(bar, b.x, nloc, nx); b.st[0] = nloc; b.st[1] = nx; }
        const unsigned old = xb_add(&bar[XB_XSUB(b.x)], 1u);
        const unsigned gen = old / nloc;
        if (old + 1u == (gen + 1u) * nloc) {
            __builtin_amdgcn_fence(__ATOMIC_RELEASE, "agent");
            asm volatile("s_waitcnt vmcnt(0)" ::: "memory");
            const unsigned og = xb_add(&bar[XB_TOP], 1u);
            const unsigned tg = og / nx;
            if (og + 1u == (tg + 1u) * nx) xb_add(&bar[XB_TOPGEN], 1u);
            else XB_SPIN(xb_ld(&bar[XB_TOPGEN]) == tg, bar);
            __builtin_amdgcn_fence(__ATOMIC_ACQUIRE, "agent");
            xb_add(&bar[XB_XGEN(b.x)], 1u);
            asm volatile("s_waitcnt vmcnt(0)" ::: "memory");
        } else {
            XB_SPIN(xb_ld(&bar[XB_XGEN(b.x)]) == gen, bar);
            __builtin_amdgcn_fence(__ATOMIC_ACQUIRE, "agent");
            asm volatile("s_waitcnt vmcnt(0)" ::: "memory");
        }
    }
    __syncthreads();
}

__global__ void __launch_bounds__(512, 2) fwd(Args a) {
    extern __shared__ __attribute__((aligned(16))) unsigned char lds_raw[];
    LAS unsigned char* lds = (LAS unsigned char*)lds_raw;
    cg::grid_group grid = cg::this_grid();
    volatile LAS unsigned* xst = (volatile LAS unsigned*)(lds + LDS_BYTES - 16);
    if (threadIdx.x == 0) { xst[0] = 0u; xst[1] = 0u; }
    __syncthreads();
    const XcdBarrier xb = xcd_barrier_post((unsigned*)(a.ws + OFF_BAR), xst);
    if (a.ph_hi > 1000) grid.sync();
#define IN(k) (a.ph_lo <= (k) && (k) < a.ph_hi)
#define GSYNC() xcd_barrier(xb)
#define SEAM(k) do { if (IN(k) && IN((k) + 1)) GSYNC(); } while (0)
#ifndef REP_PHASE
#define REP_PHASE -1
#endif
#define REPS(k) ((REP_PHASE == (k)) ? 2 : 1)
    if (IN(0)) for (int r = 0; r < REPS(0); ++r) { if (r) GSYNC(); p0_prep(a, lds); }
    SEAM(0);
    if (IN(1)) for (int r = 0; r < REPS(1); ++r) { if (r) GSYNC(); p1_gemm_in(a, lds); }
    SEAM(1);
    if (IN(2)) for (int r = 0; r < REPS(2); ++r) { if (r) GSYNC(); p2_all(a, lds); }
    if (IN(2) && !IN(3)) {}
    else if (!IN(2) && IN(3)) {}
    if (IN(3)) for (int r = 0; r < REPS(3); ++r) { if (r) GSYNC(); __syncthreads(); p3a_chunks(a, lds); }
    SEAM(3);
    if (IN(4)) for (int r = 0; r < REPS(4); ++r) { if (r) GSYNC(); p3b_seq(a, lds); if (r == 0) p3_sample_step(a, (int)blockIdx.x, (int)gridDim.x); }
    SEAM(4);
    if (IN(5)) p3c_out(a);
    SEAM(5);
    if (IN(6)) p5_out(a, lds);
    SEAM(6);
    if (IN(7)) p6_gate(a, lds);
    SEAM(7);
#if REP_PHASE == 99
    GSYNC(); GSYNC(); GSYNC(); GSYNC();
#endif
    if (IN(8)) p7_norm(a);
}

#ifndef N_LAUNCH_MODE
#define N_LAUNCH_MODE 1
#endif
extern "C" void kernel_launch(void* const* d_in, const int* in_sizes, int n_in, void* d_out, int out_size, void* d_ws, size_t ws_size, hipStream_t stream) {
    static int grid = 0;
    if (grid == 0) {
        if (n_in != 24 || ws_size < WS_END) { fprintf(stderr, "kernel_launch: unexpected n_in %d / ws_size %zu (need %zu)\n", n_in, ws_size, (size_t)WS_END); grid = -1; return; }
        int dev = 0, cus = 0, per_cu = 0;
        (void)hipGetDevice(&dev); (void)hipDeviceGetAttribute(&cus, hipDeviceAttributeMultiprocessorCount, dev);
        if (hipFuncSetAttribute((const void*)fwd, hipFuncAttributeMaxDynamicSharedMemorySize, LDS_BYTES) != hipSuccess) { fprintf(stderr, "kernel_launch: hipFuncSetAttribute failed\n"); grid = -1; return; }
        if (hipOccupancyMaxActiveBlocksPerMultiprocessor(&per_cu, (const void*)fwd, 512, LDS_BYTES) != hipSuccess || per_cu < 1) { fprintf(stderr, "kernel_launch: occupancy query gives %d\n", per_cu); per_cu = 1; }
        (void)hipGetLastError();
        grid = cus;
    }
    if (grid < 0) return;
    Args a{};
    for (int i = 0; i < 24; ++i) a.in[i] = (const float*)d_in[i];
    a.out = (float*)d_out; a.ws = (unsigned char*)d_ws;
    (void)hipMemsetAsync((unsigned char*)d_ws + OFF_BAR, 0, XCD_BAR_WORDS * 4, stream);
    if (N_LAUNCH_MODE == 1) {
        a.ph_lo = 0; a.ph_hi = 9;
        void* args[] = {&a};
        hipError_t e = hipLaunchCooperativeKernel((const void*)fwd, dim3(grid), dim3(512), args, LDS_BYTES, stream);
        if (e != hipSuccess) fprintf(stderr, "kernel_launch: cooperative launch failed: %s (grid %d)\n", hipGetErrorString(e), grid);
    } else {
        for (int ph = 0; ph < 9; ++ph) { a.ph_lo = ph; a.ph_hi = ph + 1; hipLaunchKernelGGL(fwd, dim3(grid), dim3(512), LDS_BYTES, stream, a); }
    }
}
```

```cpp
#include <hip/hip_runtime.h>
#include <hip/hip_cooperative_groups.h>
#include <cstdio>
namespace pg8 {
#define PG8_LAS __attribute__((address_space(3)))
typedef unsigned short bf16_t;
typedef short bf16x8 __attribute__((ext_vector_type(8)));
typedef float f32x4 __attribute__((ext_vector_type(4)));
typedef unsigned u32x4 __attribute__((ext_vector_type(4)));
constexpr int BM = 256, BK = 64, HALF = 128, HTB = HALF * BK * 2  , STAGE_BYTES = 8 * HTB, NXCD = 8, WGM = 8;

__host__ __device__ __forceinline__ int lds_byte(int r, int c) { const int st = (r >> 4) * 2 + (c >> 5), rr = r & 15, cc = c & 31, ob = rr * 64 + cc * 2; return st * 1024 + (ob ^ (((ob >> 9) & 1) << 5)); }
__host__ __device__ __forceinline__ void stage_rc(int b, int& R, int& C) { const int st = b / 1024, sb = b % 1024, swz = sb ^ (((sb >> 9) & 1) << 5); R = (st >> 1) * 16 + swz / 64; C = (st & 1) * 32 + (swz % 64) / 2; }
__host__ __device__ __forceinline__ int perm32(int rho) { const int n = rho >> 4, i = rho & 15; return 8 * (i >> 2) + 4 * n + (i & 3); }

struct Unit { int pm, pn; };
struct Gemm { const bf16_t* A; const bf16_t* Bt; int M, N, K; };

struct StaticOrder {
    int nM, nN, nwg, G, c;
    __host__ __device__ void init(int M, int N, int G_, int c_) { nM = M / BM; nN = N / BM; nwg = nM * nN; G = G_; c = c_; }
    __host__ __device__ bool next(int i, Unit& u) const {
        const long L = (long)i * G + c; if (L >= nwg) return false;
        int wgid = (int)L; { const int q = nwg / NXCD, r = nwg % NXCD, xcd = wgid % NXCD, off = wgid / NXCD; wgid = (xcd < r ? xcd * (q + 1) : r * (q + 1) + (xcd - r) * q) + off; }
        const int nig = WGM * nN, gid = wgid / nig, fm = gid * WGM, gsz = (nM - fm) < WGM ? (nM - fm) : WGM;
        u.pm = fm + ((wgid % nig) % gsz); u.pn = (wgid % nig) / gsz; return true;
    }
    __device__ __forceinline__ void a_ready(const Unit&) const {}
    __device__ __forceinline__ void done(const Unit&) const {}
};
typedef __bf16 bf16v2_t __attribute__((ext_vector_type(2)));
typedef float f32v2_t __attribute__((ext_vector_type(2)));
__device__ __forceinline__ unsigned cvt_pk_bf16(float lo, float hi) { const bf16v2_t r = __builtin_convertvector((f32v2_t){lo, hi}, bf16v2_t); return __builtin_bit_cast(unsigned, r); }
template <class Epi, class Sched, bool STAMP = false>
__device__ __forceinline__ void gemm_phase(PG8_LAS unsigned char* lds, const Gemm g, const Sched& S, const Epi& E, unsigned long long* stamps) {
    const int tid = threadIdx.x, wid = __builtin_amdgcn_readfirstlane(tid >> 6), lane = tid & 63, wr = wid >> 2, wc = wid & 3, fr = lane & 15, fq = lane >> 4;
    const int K = g.K, nt = K / BK;
    int ts_lo = 0, ts_hi = 0, nts = 0; const unsigned long long rt_entry = STAMP ? (unsigned long long)wall_clock64() : 0ull;
#define PG8_STAMP() do { if (STAMP && wid == 0 && nts < 64) { const unsigned long long _c = (unsigned long long)clock64(); \
        ts_lo = (lane == nts) ? (int)(unsigned)_c : ts_lo; ts_hi = (lane == nts) ? (int)(unsigned)(_c >> 32) : ts_hi; ++nts; } } while (0)
    PG8_STAMP();
    unsigned voffA[2], voffB[2];
#pragma unroll
    for (int i = 0; i < 2; ++i) { int R, C; stage_rc(tid * 16 + i * 8192, R, C); const int Rb = Epi::PERM ? ((R & ~31) + perm32(R & 31)) : R;
        voffA[i] = (unsigned)(R * K + C) * 2u; voffB[i] = (unsigned)(Rb * K + C) * 2u; }
    const size_t kstep = (size_t)(BK * 2);
    const size_t hstep = (size_t)HALF * K * 2;
    const size_t tstep = 2 * hstep;
    const unsigned ldsw = (unsigned)wid * 1024u;
    const int aoff = lds_byte(wr * 64 + fr, fq * 8), boff = lds_byte(wc * 32 + fr, fq * 8);
#define PG8_SA(b, h) (((b) * 2 + (h)) * HTB)
#define PG8_SB(b, h) ((4 + (b) * 2 + (h)) * HTB)
#define PG8_STAGE(bufoff, gbase, voff) do { _Pragma("unroll") for (int _i = 0; _i < 2; ++_i) \
        __builtin_amdgcn_global_load_lds((const unsigned*)((const char*)(gbase) + (voff)[_i]), (PG8_LAS unsigned*)(lds + (bufoff) + ldsw + _i * 8192), 16, 0, 0); } while (0)
#define PG8_LDA(dst, b, h) do { _Pragma("unroll") for (int m = 0; m < 4; ++m) _Pragma("unroll") for (int k = 0; k < 2; ++k) dst[m][k] = *(const PG8_LAS bf16x8*)(lds + PG8_SA(b, h) + aoff + m * 2048 + k * 1024); } while (0)
#define PG8_LDB(dst, b, h) do { _Pragma("unroll") for (int n = 0; n < 2; ++n) _Pragma("unroll") for (int k = 0; k < 2; ++k) dst[n][k] = *(const PG8_LAS bf16x8*)(lds + PG8_SB(b, h) + boff + n * 2048 + k * 1024); } while (0)
#define PG8_MMA(ai, bj, At, Bt) do { __builtin_amdgcn_s_setprio(1); _Pragma("unroll") for (int m = 0; m < 4; ++m) _Pragma("unroll") for (int n = 0; n < 2; ++n) _Pragma("unroll") for (int k = 0; k < 2; ++k) \
        acc[ai][bj][m][n] = __builtin_amdgcn_mfma_f32_16x16x32_bf16(Bt[n][k], At[m][k], acc[ai][bj][m][n], 0, 0, 0); __builtin_amdgcn_s_setprio(0); } while (0)
#define PG8_WAIT_V(n) asm volatile("s_waitcnt vmcnt(" #n ")" ::: "memory")
#define PG8_WAIT_L(n) asm volatile("s_waitcnt lgkmcnt(" #n ")" ::: "memory")
#define PG8_BAR __builtin_amdgcn_s_barrier()
#define PG8_SCHED __builtin_amdgcn_sched_barrier(0)
    Unit cur, nxt; int ui = 0;
    if (!S.next(0, cur)) return;
    f32x4 acc[2][2][4][2];
#pragma unroll
    for (int a = 0; a < 2; ++a)
#pragma unroll
        for (int b = 0; b < 2; ++b)
#pragma unroll
            for (int m = 0; m < 4; ++m)
#pragma unroll
                for (int n = 0; n < 2; ++n) acc[a][b][m][n] = (f32x4){0.f, 0.f, 0.f, 0.f};
    bf16x8 At[4][2], B0[2][2], B1[2][2];
    const char* cA = (const char*)g.A + (size_t)cur.pm * tstep; const char* cB = (const char*)g.Bt + (size_t)cur.pn * tstep;
    S.a_ready(cur);
    PG8_STAGE(PG8_SB(0, 0), cB, voffB); PG8_STAGE(PG8_SA(0, 0), cA, voffA); PG8_STAGE(PG8_SB(0, 1), cB + hstep, voffB); PG8_STAGE(PG8_SA(0, 1), cA + hstep, voffA);
    if (wr == 1) PG8_BAR;
    PG8_WAIT_V(4); PG8_BAR;
    PG8_STAGE(PG8_SB(1, 0), cB + kstep, voffB); PG8_STAGE(PG8_SA(1, 0), cA + kstep, voffA); PG8_STAGE(PG8_SB(1, 1), cB + hstep + kstep, voffB);
    PG8_WAIT_V(6); PG8_BAR;
    PG8_STAMP();
    for (;;) {
        const bool has_next = S.next(ui + 1, nxt);
        const char* nA = has_next ? (const char*)g.A + (size_t)nxt.pm * tstep : cA; const char* nB = has_next ? (const char*)g.Bt + (size_t)nxt.pn * tstep : cB;
        for (int t = 0; t < nt; t += 2) {
            const bool last = (t == nt - 2);
            const char* a1 = cA + (size_t)(t + 1) * kstep;
            const char* a2 = last ? nA : cA + (size_t)(t + 2) * kstep; const char* b2 = last ? nB : cB + (size_t)(t + 2) * kstep;
            const char* a3 = a2 + kstep; const char* b3 = b2 + kstep;
            if (last && has_next) S.a_ready(nxt);
            PG8_LDB(B0, 0, 0); PG8_SCHED; PG8_LDA(At, 0, 0); PG8_STAGE(PG8_SA(1, 1), a1 + hstep, voffA);
            PG8_WAIT_L(8); PG8_BAR; PG8_WAIT_L(0); PG8_MMA(0, 0, At, B0); PG8_BAR; PG8_SCHED;
            PG8_LDB(B1, 0, 1); PG8_STAGE(PG8_SB(0, 0), b2, voffB);
            PG8_BAR; PG8_WAIT_L(0); PG8_MMA(0, 1, At, B1); PG8_BAR;
            PG8_LDA(At, 0, 1); PG8_STAGE(PG8_SA(0, 0), a2, voffA);
            PG8_BAR; PG8_WAIT_L(0); PG8_MMA(1, 0, At, B0); PG8_BAR; PG8_SCHED;
            PG8_STAGE(PG8_SB(0, 1), b2 + hstep, voffB);
            PG8_WAIT_V(6); PG8_BAR; PG8_MMA(1, 1, At, B1); PG8_BAR;
            PG8_LDB(B0, 1, 0); PG8_SCHED; PG8_LDA(At, 1, 0); PG8_STAGE(PG8_SA(0, 1), a2 + hstep, voffA);
            PG8_WAIT_L(8); PG8_BAR; PG8_WAIT_L(0); PG8_MMA(0, 0, At, B0); PG8_BAR; PG8_SCHED;
            PG8_LDB(B1, 1, 1); PG8_STAGE(PG8_SB(1, 0), b3, voffB);
            PG8_BAR; PG8_WAIT_L(0); PG8_MMA(0, 1, At, B1); PG8_BAR;
            PG8_LDA(At, 1, 1); PG8_STAGE(PG8_SA(1, 0), a3, voffA);
            PG8_BAR; PG8_WAIT_L(0); PG8_MMA(1, 0, At, B0); PG8_BAR; PG8_SCHED;
            PG8_STAGE(PG8_SB(1, 1), b3 + hstep, voffB);
            PG8_WAIT_V(6); PG8_BAR; PG8_MMA(1, 1, At, B1); PG8_BAR;
        }
        PG8_STAMP();
        if constexpr (!Epi::AFTER_DRAIN) { E(acc, cur, wr, wc, fr, fq); S.done(cur); }
        PG8_STAMP();
        if (!has_next) break;
#pragma unroll
        for (int a = 0; a < 2; ++a)
#pragma unroll
            for (int b = 0; b < 2; ++b)
#pragma unroll
                for (int m = 0; m < 4; ++m)
#pragma unroll
                    for (int n = 0; n < 2; ++n) acc[a][b][m][n] = (f32x4){0.f, 0.f, 0.f, 0.f};
        cur = nxt; cA = nA; cB = nB; ++ui;
    }
    PG8_WAIT_V(0);
    if (wr == 0) PG8_BAR;
    PG8_BAR;
    if constexpr (Epi::AFTER_DRAIN) { E.fused(acc, cur, wr, wc, fr, fq, lds, wid, lane); S.done(cur); }
    PG8_STAMP();
    if (STAMP && wid == 0) { stamps[lane] = lane < nts ? (((unsigned long long)(unsigned)ts_hi << 32) | (unsigned)ts_lo) : 0ull;
        if (lane == 62) stamps[62] = rt_entry; if (lane == 63) stamps[63] = (unsigned long long)wall_clock64(); }
#undef PG8_STAMP
#undef PG8_SA
#undef PG8_SB
#undef PG8_STAGE
#undef PG8_LDA
#undef PG8_LDB
#undef PG8_MMA
#undef PG8_WAIT_V
#undef PG8_WAIT_L
#undef PG8_BAR
#undef PG8_SCHED
}
}

namespace cg = cooperative_groups;
using pg8::bf16_t; using pg8::bf16x8; using pg8::f32x4; using pg8::u32x4; using pg8::Unit; using pg8::cvt_pk_bf16;
typedef unsigned u32x2 __attribute__((ext_vector_type(2)));
#define LAS __attribute__((address_space(3)))
#define LBAR() do { asm volatile("s_waitcnt lgkmcnt(0)" ::: "memory"); __builtin_amdgcn_s_barrier(); asm volatile("" ::: "memory"); } while (0)

constexpr int D = 1024, TSEQ = 2048, NB = 8, MP = NB * TSEQ, MS = 128, MT = MP + MS;
constexpr int RW = 512, NH = 8, SW = 1664, NZ = 4224, NZP = 4352, DP = 256;
constexpr int ZC_S = 2048, ZC_GR = 3712;
constexpr int LDS_BYTES = 159744;

constexpr size_t OFF_WIN = 0;
constexpr size_t OFF_WOUT = OFF_WIN + (size_t)NZP * D * 2;
constexpr size_t OFF_WPG = OFF_WOUT + (size_t)D * D * 2;
constexpr size_t OFF_WPP = OFF_WPG + (size_t)D * D * 2;
constexpr size_t OFF_WUP = OFF_WPP + (size_t)D * DP * 2;
constexpr size_t OFF_AUP = OFF_WUP + (size_t)RW * 64 * 2;
constexpr size_t OFF_RS = OFF_AUP + (size_t)RW * 64 * 2;
constexpr size_t OFF_PB = OFF_RS + (size_t)16640 * 4;
constexpr size_t OFF_Z = OFF_PB + (size_t)MT * DP * 2;
constexpr size_t OFF_SCN = OFF_Z + (size_t)MT * NZ * 2;
constexpr size_t OFF_BAR = OFF_SCN + (size_t)MT * NH * 384 * 2;
constexpr size_t WS_END = OFF_BAR + 16384;
constexpr size_t OFF_H1B = OFF_Z;
constexpr size_t OFF_PPB = OFF_H1B + (size_t)MT * D * 2;
constexpr size_t OFF_H2B = OFF_PPB + (size_t)MT * D * 2;
static_assert(OFF_H2B + (size_t)MT * D * 2 <= OFF_SCN, "overlay");
constexpr size_t PPD_OFF = (size_t)MT * D * 2;
constexpr size_t OFF_CHK = OFF_SCN;
constexpr size_t OFF_SALL = OFF_CHK + (size_t)2048 * 16384 * 2;
constexpr size_t OFF_OS = OFF_SALL + (size_t)2048 * 4096 * 2;
constexpr size_t OFF_SCNS = OFF_OS + (size_t)128 * 512 * 2;
constexpr size_t OFF_RK = OFF_SCNS + (size_t)MS * NH * 384 * 2;
static_assert(OFF_RK + (size_t)2048 * 64 * 4 <= OFF_BAR, "overlay");
constexpr size_t O_Y = 0, O_CONVP = (size_t)MT * D, O_SHIFTP = O_CONVP + 8 * 2 * 512, O_WKVP = O_SHIFTP + 8 * SW,
                 O_CONVS = O_WKVP + 8 * 8 * 64 * 64, O_SHIFTS = O_CONVS + 128 * 2 * 512, O_WKVS = O_SHIFTS + 128 * SW;

struct Args { const float* in[24]; float* out; unsigned char* ws; int ph_lo, ph_hi; };

__device__ __forceinline__ float bf2f(unsigned short b) { return __uint_as_float(((unsigned)b) << 16); }
__device__ __forceinline__ float bflo(unsigned w) { return __uint_as_float(w << 16); }
__device__ __forceinline__ float bfhi(unsigned w) { return __uint_as_float(w & 0xffff0000u); }
__device__ __forceinline__ unsigned short f2bf(float f) { return (unsigned short)(cvt_pk_bf16(f, 0.f) & 0xffffu); }
__device__ __forceinline__ void unpack8(const u32x4 q, float (&f)[8]) {
    f[0] = bflo(q.x); f[1] = bfhi(q.x); f[2] = bflo(q.y); f[3] = bfhi(q.y); f[4] = bflo(q.z); f[5] = bfhi(q.z); f[6] = bflo(q.w); f[7] = bfhi(q.w); }
__device__ __forceinline__ void unpack4(const u32x2 q, float (&f)[4]) { f[0] = bflo(q.x); f[1] = bfhi(q.x); f[2] = bflo(q.y); f[3] = bfhi(q.y); }
__device__ __forceinline__ u32x4 pack8(const float (&f)[8]) { u32x4 q; q.x = cvt_pk_bf16(f[0], f[1]); q.y = cvt_pk_bf16(f[2], f[3]); q.z = cvt_pk_bf16(f[4], f[5]); q.w = cvt_pk_bf16(f[6], f[7]); return q; }
__device__ __forceinline__ u32x2 pack4(float a, float b, float c, float d) { u32x2 q; q.x = cvt_pk_bf16(a, b); q.y = cvt_pk_bf16(c, d); return q; }
__device__ __forceinline__ float sigmoidf_(float x) { return __builtin_amdgcn_rcpf(1.0f + __expf(-x)); }
__device__ __forceinline__ float siluf_(float x) { return x * __builtin_amdgcn_rcpf(1.0f + __expf(-x)); }
template <int CTRL> __device__ __forceinline__ float dppf(float x) { return __int_as_float(__builtin_amdgcn_update_dpp(0, __float_as_int(x), CTRL, 0xf, 0xf, false)); }
__device__ __forceinline__ float rowsum16(float x) { x += dppf<0x128>(x); x += dppf<0x124>(x); x += dppf<0x122>(x); x += dppf<0x121>(x); return x; }

__device__ __forceinline__ f32x4 mini_tile(const bf16_t* arow, const bf16_t* brow, int K, int fq) {
    f32x4 acc = {0.f, 0.f, 0.f, 0.f};
    const bf16_t* ap = arow + fq * 8; const bf16_t* bp = brow + fq * 8;
    for (int k0 = 0; k0 < K; k0 += 256) {
        bf16x8 av[8], bv[8];
#pragma unroll
        for (int j = 0; j < 8; ++j) { av[j] = *(const bf16x8*)(ap + k0 + j * 32); bv[j] = *(const bf16x8*)(bp + k0 + j * 32); }
#pragma unroll
        for (int j = 0; j < 8; ++j) acc = __builtin_amdgcn_mfma_f32_16x16x32_bf16(bv[j], av[j], acc, 0, 0, 0);
    }
    return acc;
}

template <int NSTEP> __device__ __forceinline__ f32x4 mini_tile_k(const bf16_t* arow, const bf16_t* brow, int fq) {
    f32x4 acc = {0.f, 0.f, 0.f, 0.f};
    bf16x8 av[NSTEP], bv[NSTEP];
#pragma unroll
    for (int j = 0; j < NSTEP; ++j) { av[j] = *(const bf16x8*)(arow + fq * 8 + j * 32); bv[j] = *(const bf16x8*)(brow + fq * 8 + j * 32); }
#pragma unroll
    for (int j = 0; j < NSTEP; ++j) acc = __builtin_amdgcn_mfma_f32_16x16x32_bf16(bv[j], av[j], acc, 0, 0, 0);
    return acc;
}
__device__ __forceinline__ f32x4 splitk_reduce(LAS unsigned char* lds, f32x4 acc, int wave, int lane) {
    LAS f32x4* red = (LAS f32x4*)lds;
    __syncthreads();
    red[wave * 64 + lane] = acc;
    __syncthreads();
    if ((wave & 3) == 0) acc = (acc + red[(wave + 1) * 64 + lane]) + (red[(wave + 2) * 64 + lane] + red[(wave + 3) * 64 + lane]);
    return acc;
}

struct EpiZ {
    static constexpr bool PERM = true, AFTER_DRAIN = false;
    bf16_t* Z; const float* rs;
    __device__ __forceinline__ void operator()(const f32x4 (&acc)[2][2][4][2], const Unit& u, int wr, int wc, int fr, int fq) const {
        const int row0 = u.pm * 256 + wr * 64 + fr, col0 = u.pn * 256 + wc * 32 + 8 * fq;
        float sc[2][4];
#pragma unroll
        for (int ai = 0; ai < 2; ++ai)
#pragma unroll
            for (int m = 0; m < 4; ++m) sc[ai][m] = rs[row0 + ai * 128 + m * 16];
#pragma unroll
        for (int ai = 0; ai < 2; ++ai)
#pragma unroll
            for (int m = 0; m < 4; ++m) { const int row = row0 + ai * 128 + m * 16; const float s = sc[ai][m]; bf16_t* rp = Z + (size_t)row * NZ + col0;
#pragma unroll
                for (int bj = 0; bj < 2; ++bj) { if (col0 + bj * 128 < NZ && row < MT) { const f32x4 v0 = acc[ai][bj][m][0] * s, v1 = acc[ai][bj][m][1] * s; u32x4 w;
                    w.x = cvt_pk_bf16(v0[0], v0[1]); w.y = cvt_pk_bf16(v0[2], v0[3]); w.z = cvt_pk_bf16(v1[0], v1[1]); w.w = cvt_pk_bf16(v1[2], v1[3]); *(u32x4*)(rp + bj * 128) = w; } } }
    }
};
struct EpiH1 {
    static constexpr bool PERM = true, AFTER_DRAIN = false;
    const float* x; bf16_t* H1B;
    __device__ __forceinline__ void operator()(const f32x4 (&acc)[2][2][4][2], const Unit& u, int wr, int wc, int fr, int fq) const {
        const int row0 = u.pm * 256 + wr * 64 + fr, col0 = u.pn * 256 + wc * 32 + 8 * fq;
#pragma unroll
        for (int ai = 0; ai < 2; ++ai)
#pragma unroll
            for (int mp = 0; mp < 2; ++mp) {
                f32x4 xv[2][2][2];
#pragma unroll
                for (int mm = 0; mm < 2; ++mm)
#pragma unroll
                    for (int bj = 0; bj < 2; ++bj) { const size_t o = (size_t)(row0 + ai * 128 + (mp * 2 + mm) * 16) * D + col0 + bj * 128; xv[mm][bj][0] = *(const f32x4*)(x + o); xv[mm][bj][1] = *(const f32x4*)(x + o + 4); }
#pragma unroll
                for (int mm = 0; mm < 2; ++mm)
#pragma unroll
                    for (int bj = 0; bj < 2; ++bj) { const int m = mp * 2 + mm; const size_t o = (size_t)(row0 + ai * 128 + m * 16) * D + col0 + bj * 128;
                        const f32x4 v0 = xv[mm][bj][0] + acc[ai][bj][m][0], v1 = xv[mm][bj][1] + acc[ai][bj][m][1]; u32x4 w;
                        w.x = cvt_pk_bf16(v0[0], v0[1]); w.y = cvt_pk_bf16(v0[2], v0[3]); w.z = cvt_pk_bf16(v1[0], v1[1]); w.w = cvt_pk_bf16(v1[2], v1[3]); *(u32x4*)(H1B + o) = w; }
                asm volatile("" ::: "memory"); }
    }
};
struct EpiF32 {
    static constexpr bool PERM = true, AFTER_DRAIN = false;
    bf16_t* C;
    __device__ __forceinline__ void operator()(const f32x4 (&acc)[2][2][4][2], const Unit& u, int wr, int wc, int fr, int fq) const {
        const int row0 = u.pm * 256 + wr * 64 + fr, col0 = u.pn * 256 + wc * 32 + 8 * fq;
#pragma unroll
        for (int ai = 0; ai < 2; ++ai)
#pragma unroll
            for (int m = 0; m < 4; ++m) { const size_t off = (size_t)(row0 + ai * 128 + m * 16) * D + col0;
#pragma unroll
                for (int bj = 0; bj < 2; ++bj) { const f32x4 v0 = acc[ai][bj][m][0], v1 = acc[ai][bj][m][1]; u32x4 w;
                    w.x = cvt_pk_bf16(v0[0], v0[1]); w.y = cvt_pk_bf16(v0[2], v0[3]); w.z = cvt_pk_bf16(v1[0], v1[1]); w.w = cvt_pk_bf16(v1[2], v1[3]); *(u32x4*)(C + off + bj * 128) = w; } }
    }
};
struct EpiH2 {
    static constexpr bool PERM = true, AFTER_DRAIN = false;
    const bf16_t* H1; const bf16_t* PP; bf16_t* out;
    __device__ __forceinline__ void operator()(const f32x4 (&acc)[2][2][4][2], const Unit& u, int wr, int wc, int fr, int fq) const {
        const int row0 = u.pm * 256 + wr * 64 + fr, col0 = u.pn * 256 + wc * 32 + 8 * fq;
#pragma unroll
        for (int ai = 0; ai < 2; ++ai)
#pragma unroll
            for (int mp = 0; mp < 2; ++mp) {
                u32x4 qh[2][2], qp[2][2];
#pragma unroll
                for (int mm = 0; mm < 2; ++mm)
#pragma unroll
                    for (int bj = 0; bj < 2; ++bj) { const size_t o = (size_t)(row0 + ai * 128 + (mp * 2 + mm) * 16) * D + col0 + bj * 128; qh[mm][bj] = *(const u32x4*)(H1 + o); qp[mm][bj] = *(const u32x4*)(PP + o); }
#pragma unroll
                for (int mm = 0; mm < 2; ++mm)
#pragma unroll
                    for (int bj = 0; bj < 2; ++bj) { const int m = mp * 2 + mm; const size_t o = (size_t)(row0 + ai * 128 + m * 16) * D + col0 + bj * 128; float h[8], p[8]; unpack8(qh[mm][bj], h); unpack8(qp[mm][bj], p);
                        const f32x4 g0 = acc[ai][bj][m][0], g1 = acc[ai][bj][m][1]; f32x4 v0, v1;
#pragma unroll
                        for (int e = 0; e < 4; ++e) { v0[e] = h[e] + sigmoidf_(g0[e]) * p[e]; v1[e] = h[4 + e] + sigmoidf_(g1[e]) * p[4 + e]; }
                        u32x4 w; w.x = cvt_pk_bf16(v0[0], v0[1]); w.y = cvt_pk_bf16(v0[2], v0[3]); w.z = cvt_pk_bf16(v1[0], v1[1]); w.w = cvt_pk_bf16(v1[2], v1[3]); *(u32x4*)(out + o) = w; }
                asm volatile("" ::: "memory"); }
    }
};

struct P0Job { const float* src; bf16_t* dst; const float* gsc; int K, N, k0, n0; };
__device__ __forceinline__ P0Job p0_decode(const Args& a, int job) {
    constexpr int NJ_IN = 16 * 68, NJ_SQ = 256, NJ_PP = 64, NJ_LO = 8;
    unsigned char* ws = a.ws; P0Job J; J.gsc = nullptr; int kt, nt; int j = job;
    if (j < NJ_IN) { J.src = a.in[8]; J.dst = (bf16_t*)(ws + OFF_WIN); J.gsc = a.in[7]; J.K = 1024; J.N = NZ; kt = j & 15; nt = j >> 4; }
    else if ((j -= NJ_IN) < NJ_SQ) { J.src = a.in[20]; J.dst = (bf16_t*)(ws + OFF_WOUT); J.K = 1024; J.N = 1024; kt = j & 15; nt = j >> 4; }
    else if ((j -= NJ_SQ) < NJ_SQ) { J.src = a.in[21]; J.dst = (bf16_t*)(ws + OFF_WPG); J.K = 1024; J.N = 1024; kt = j & 15; nt = j >> 4; }
    else if ((j -= NJ_SQ) < NJ_PP) { J.src = a.in[22]; J.dst = (bf16_t*)(ws + OFF_WPP); J.K = 256; J.N = 1024; kt = j & 3; nt = j >> 2; }
    else if ((j -= NJ_PP) < NJ_LO) { J.src = a.in[12]; J.dst = (bf16_t*)(ws + OFF_WUP); J.K = 64; J.N = 512; kt = 0; nt = j; }
    else { j -= NJ_LO; J.src = a.in[14]; J.dst = (bf16_t*)(ws + OFF_AUP); J.K = 64; J.N = 512; kt = 0; nt = j; }
    J.k0 = kt * 64; J.n0 = nt * 64; return J;
}
__device__ void p0_prep(const Args& a, LAS unsigned char* lds) {
    const int tid = threadIdx.x, G = gridDim.x, blk = blockIdx.x, wave = tid >> 6, lane = tid & 63;
    LAS float* tile = (LAS float*)lds;
    unsigned char* ws = a.ws;
    constexpr int NJOBS = 16 * 68 + 2 * 256 + 64 + 2 * 8, MAXJ = 7;
    const int li = tid >> 4, lj = (tid & 15) * 4;
    for (int base = blk; base < NJOBS; base += G * MAXJ) {
        f32x4 v[MAXJ][2];
#pragma unroll
        for (int sl = 0; sl < MAXJ; ++sl) { const int job = base + sl * G;
            if (job < NJOBS) { const P0Job J = p0_decode(a, job);
#pragma unroll
                for (int q = 0; q < 2; ++q) { const int i = li + 32 * q; f32x4 x = {0.f, 0.f, 0.f, 0.f};
                    if (J.n0 + lj < J.N) { x = *(const f32x4*)(J.src + (size_t)(J.k0 + i) * J.N + J.n0 + lj); if (J.gsc) x = x * J.gsc[J.k0 + i]; }
                    v[sl][q] = x; } } }
#pragma unroll
        for (int sl = 0; sl < MAXJ; ++sl) { const int job = base + sl * G;
            if (job < NJOBS) { const P0Job J = p0_decode(a, job);
#pragma unroll
                for (int q = 0; q < 2; ++q) { const int i = li + 32 * q;
#pragma unroll
                    for (int e = 0; e < 4; ++e) tile[i * 65 + lj + e] = v[sl][q][e]; }
                LBAR();
#pragma unroll
                for (int it = 0; it < 4; ++it) { const int item = it * 512 + tid, jj = item >> 5, i2 = item & 31;
                    *(unsigned*)(J.dst + (size_t)(J.n0 + jj) * J.K + J.k0 + 2 * i2) = cvt_pk_bf16(tile[(2 * i2) * 65 + jj], tile[(2 * i2 + 1) * 65 + jj]); }
                LBAR(); } }
    }
    bf16_t* XB = (bf16_t*)a.out; float* RS = (float*)(ws + OFF_RS);
    for (int row0 = (blk * 8 + wave) * 2; row0 < MT; row0 += G * 16) {
        f32x4 v[2][4];
#pragma unroll
        for (int r = 0; r < 2; ++r) { const int row = row0 + r; const float* src = row < MP ? a.in[0] + (size_t)row * D : a.in[1] + (size_t)(row - MP) * D;
#pragma unroll
            for (int i = 0; i < 4; ++i) v[r][i] = *(const f32x4*)(src + i * 256 + lane * 4); }
#pragma unroll
        for (int r = 0; r < 2; ++r) { const int row = row0 + r; float ss = 0.f;
#pragma unroll
            for (int i = 0; i < 4; ++i) { const f32x4 x = v[r][i]; ss += x[0] * x[0] + x[1] * x[1] + x[2] * x[2] + x[3] * x[3];
                *(u32x2*)(XB + (size_t)row * D + i * 256 + lane * 4) = pack4(x[0], x[1], x[2], x[3]); }
#pragma unroll
            for (int o = 32; o >= 1; o >>= 1) ss += __shfl_xor(ss, o);
            if (lane == 0) RS[row] = rsqrtf(ss * (1.0f / D) + 1e-6f); }
    }
    bf16_t* PB = (bf16_t*)(ws + OFF_PB);
    constexpr size_t NP4 = (size_t)MT * DP / 4;
    for (size_t i0 = (size_t)blk * 512 + tid; i0 < NP4; i0 += (size_t)G * 512 * 4) {
        f32x4 v[4];
#pragma unroll
        for (int u = 0; u < 4; ++u) { const size_t i = i0 + (size_t)u * G * 512; const size_t e = i * 4;
            if (i < NP4) v[u] = e < (size_t)MP * DP ? *(const f32x4*)(a.in[2] + e) : *(const f32x4*)(a.in[3] + (e - (size_t)MP * DP)); }
#pragma unroll
        for (int u = 0; u < 4; ++u) { const size_t i = i0 + (size_t)u * G * 512; if (i < NP4) *(u32x2*)(PB + i * 4) = pack4(v[u][0], v[u][1], v[u][2], v[u][3]); }
    }
}

__device__ void p1_gemm_in(const Args& a, LAS unsigned char* lds) {
    const int tid = threadIdx.x, G = gridDim.x, blk = blockIdx.x, wave = tid >> 6, lane = tid & 63, fr = lane & 15, fq = lane >> 4;
    unsigned char* ws = a.ws;
    const bf16_t* XB = (const bf16_t*)a.out; const bf16_t* WinT = (const bf16_t*)(ws + OFF_WIN); const float* RS = (const float*)(ws + OFF_RS); bf16_t* Z = (bf16_t*)(ws + OFF_Z);
    {
        pg8::Gemm g{XB, WinT, MP + 256, NZP, D}; pg8::StaticOrder S; S.init(MP + 256, NZP, G, blk); EpiZ E{Z, RS};
        pg8::gemm_phase<EpiZ, pg8::StaticOrder>(lds, g, S, E, nullptr);
    }
    const bool r256 = (G == 256);
    if (!r256 || blk >= 81) {
        const bf16_t* PB = (const bf16_t*)(ws + OFF_PB); const bf16_t* WppT = (const bf16_t*)(ws + OFF_WPP); bf16_t* PP = (bf16_t*)((unsigned char*)a.out + PPD_OFF);
        pg8::Gemm g{PB, WppT, MP, D, DP}; pg8::StaticOrder S; S.init(MP, D, r256 ? 175 : G, r256 ? blk - 81 : blk); EpiF32 E{PP};
        pg8::gemm_phase<EpiF32, pg8::StaticOrder>(lds, g, S, E, nullptr);
    }
}

template <bool smp> __device__ void p2_tile(const Args& a, LAS unsigned char* lds, int tile) {
    const int tid = threadIdx.x, wave = tid >> 6, lane = tid & 63, fr = lane & 15, fq = lane >> 4;
    unsigned char* ws = a.ws;
    const int ntok = smp ? 8 : 64;
    const int m0 = smp ? MP + (tile - 256) * 8 : tile * 64;
    const int t0 = smp ? 0 : (tile & 31) * 64;
    const int bidx = tile >> 5;
    const bf16_t* __restrict__ Z = (const bf16_t*)(ws + OFF_Z); bf16_t* __restrict__ YC = (bf16_t*)a.out; bf16_t* __restrict__ SCN = (bf16_t*)(ws + OFF_SCNS) - (size_t)MP * 8 * 384;
    const float* state_conv = a.in[4]; const float* state_shift = a.in[5]; const float* conv_w = a.in[9]; const float* mu = a.in[10];
    {
        const int c0 = (tid & 63) * 8;
        float cw0[8], cw1[8], cw2[8];
#pragma unroll
        for (int i = 0; i < 8; ++i) { cw0[i] = conv_w[c0 + i]; cw1[i] = conv_w[512 + c0 + i]; cw2[i] = conv_w[1024 + c0 + i]; }
#pragma unroll 2
        for (int tok = tid >> 6; tok < ntok; tok += 8) {
            const int m = m0 + tok, t = t0 + tok;
            const bf16_t* zr = Z + (size_t)m * NZ;
            float fB[8], fC[8], fH[8], fG[8], u0[8], u1[8], u2[8];
            const u32x4 qB = *(const u32x4*)(zr + c0), qC = *(const u32x4*)(zr + 512 + c0), qH = *(const u32x4*)(zr + 1024 + c0), qG = *(const u32x4*)(zr + 1536 + c0);
            if (smp) {
                const float* sc = state_conv + (size_t)(m - MP) * 1024 + c0;
                const f32x4 x0 = *(const f32x4*)(sc), x1 = *(const f32x4*)(sc + 4), y0 = *(const f32x4*)(sc + 512), y1 = *(const f32x4*)(sc + 516);
#pragma unroll
                for (int i = 0; i < 4; ++i) { u2[i] = x0[i]; u2[4 + i] = x1[i]; u1[i] = y0[i]; u1[4 + i] = y1[i]; }
            } else {
                const bf16_t* z1 = t >= 1 ? zr - NZ : zr; const bf16_t* z2 = t >= 2 ? zr - 2 * NZ : zr;
                const u32x4 qC1 = *(const u32x4*)(z1 + 512 + c0), qH1 = *(const u32x4*)(z1 + 1024 + c0), qC2 = *(const u32x4*)(z2 + 512 + c0), qH2 = *(const u32x4*)(z2 + 1024 + c0);
                float c1[8], h1[8], c2[8], h2[8]; unpack8(qC1, c1); unpack8(qH1, h1); unpack8(qC2, c2); unpack8(qH2, h2);
                const float f1 = t >= 1 ? 1.f : 0.f, f2 = t >= 2 ? 1.f : 0.f;
#pragma unroll
                for (int i = 0; i < 8; ++i) { u1[i] = c1[i] * h1[i] * f1; u2[i] = c2[i] * h2[i] * f2; }
            }
            unpack8(qB, fB); unpack8(qC, fC); unpack8(qH, fH); unpack8(qG, fG);
            float y[8];
#pragma unroll
            for (int i = 0; i < 8; ++i) { u0[i] = fC[i] * fH[i]; const float cv = cw0[i] * u2[i] + cw1[i] * u1[i] + cw2[i] * u0[i]; y[i] = fB[i] * cv * siluf_(fG[i]); }
            *(u32x4*)(YC + (size_t)m * D + c0) = pack8(y);
            { float gr[8]; unpack8(*(const u32x4*)(zr + ZC_GR + c0), gr);
#pragma unroll
              for (int i = 0; i < 8; ++i) gr[i] = siluf_(gr[i]);
              *(u32x4*)(YC + (size_t)m * D + 512 + c0) = pack8(gr); }
            float* co = nullptr;
            if (smp) co = a.out + O_CONVS + (size_t)(m - MP) * 1024 + c0; else if (t == TSEQ - 1) co = a.out + O_CONVP + (size_t)bidx * 1024 + c0;
            if (co) {
                *(f32x4*)(co) = (f32x4){u1[0], u1[1], u1[2], u1[3]}; *(f32x4*)(co + 4) = (f32x4){u1[4], u1[5], u1[6], u1[7]};
                *(f32x4*)(co + 512) = (f32x4){u0[0], u0[1], u0[2], u0[3]}; *(f32x4*)(co + 516) = (f32x4){u0[4], u0[5], u0[6], u0[7]}; }
        }
    }
    LAS bf16_t* Awd = (LAS bf16_t*)lds; LAS bf16_t* Aad = Awd + 64 * 72;
    if (smp) {
        const int j0 = (tid & 15) * 8;
        f32x4 m0v = *(const f32x4*)(mu + 1536 + j0), m1v = *(const f32x4*)(mu + 1536 + j0 + 4);
#pragma unroll 2
        for (int tok = tid >> 4; tok < ntok; tok += 32) {
            const int m = m0 + tok;
            const bf16_t* zr = Z + (size_t)m * NZ + ZC_S + 1536 + j0;
            float cur[8], prev[8], zm[8];
            unpack8(*(const u32x4*)zr, cur);
            if (smp) { const float* sp = state_shift + (size_t)(m - MP) * SW + 1536 + j0; const f32x4 x0 = *(const f32x4*)sp, x1 = *(const f32x4*)(sp + 4);
#pragma unroll
                for (int i = 0; i < 4; ++i) { prev[i] = x0[i]; prev[4 + i] = x1[i]; } }
            else { const bool hp = (t0 + tok) >= 1; unpack8(*(const u32x4*)(hp ? zr - NZ : zr), prev);
                if (!hp) {
#pragma unroll
                    for (int i = 0; i < 8; ++i) prev[i] = 0.f; } }
#pragma unroll
            for (int i = 0; i < 8; ++i) { const float mm = i < 4 ? m0v[i] : m1v[i - 4]; zm[i] = cur[i] + (prev[i] - cur[i]) * mm; }
            if (j0 < 64) {
#pragma unroll
                for (int i = 0; i < 8; ++i) { const float e2 = __expf(2.0f * zm[i]); zm[i] = 1.0f - 2.0f * __builtin_amdgcn_rcpf(e2 + 1.0f); }
                *(LAS u32x4*)(Awd + tok * 72 + j0) = pack8(zm);
            } else *(LAS u32x4*)(Aad + tok * 72 + (j0 - 64)) = pack8(zm);
        }
    }
    __syncthreads();
    if (smp) {
        const int h = wave;
        const bf16_t* WupT = (const bf16_t*)(ws + OFF_WUP); const bf16_t* AupT = (const bf16_t*)(ws + OFF_AUP);
        const float* __restrict__ w0 = a.in[11]; const float* __restrict__ a0p = a.in[13]; const float* __restrict__ k_k = a.in[15]; const float* __restrict__ k_a = a.in[16];
        const int nmt = (ntok + 15) >> 4;
#pragma unroll 1
        for (int mt = 0; mt < nmt; ++mt) {
            u32x2 zc[4][3], zq[4][3];
            {   const int tok_ = (mt * 16 + fr) < ntok ? (mt * 16 + fr) : 0; const bf16_t* zr_ = Z + (size_t)(m0 + tok_) * NZ + ZC_S; const bf16_t* zp_ = ((!smp) && (t0 + tok_ >= 1)) ? zr_ - NZ : zr_;
#pragma unroll
                for (int nt = 0; nt < 4; ++nt) { const int c = h * 64 + nt * 16 + 4 * fq;
                    zc[nt][0] = *(const u32x2*)(zr_ + c); zc[nt][1] = *(const u32x2*)(zr_ + 512 + c); zc[nt][2] = *(const u32x2*)(zr_ + 1024 + c);
                    if (!smp) { zq[nt][0] = *(const u32x2*)(zp_ + c); zq[nt][1] = *(const u32x2*)(zp_ + 512 + c); zq[nt][2] = *(const u32x2*)(zp_ + 1024 + c); } } }
            bf16x8 aw[2], aa[2];
#pragma unroll
            for (int ks = 0; ks < 2; ++ks) { aw[ks] = *(const LAS bf16x8*)(Awd + (mt * 16 + fr) * 72 + ks * 32 + fq * 8); aa[ks] = *(const LAS bf16x8*)(Aad + (mt * 16 + fr) * 72 + ks * 32 + fq * 8); }
            f32x4 accw[4], acca[4];
#pragma unroll
            for (int nt = 0; nt < 4; ++nt) { accw[nt] = (f32x4){0.f, 0.f, 0.f, 0.f}; acca[nt] = (f32x4){0.f, 0.f, 0.f, 0.f};
#pragma unroll
                for (int ks = 0; ks < 2; ++ks) { const size_t bo = (size_t)(h * 64 + nt * 16 + fr) * 64 + ks * 32 + fq * 8;
                    accw[nt] = __builtin_amdgcn_mfma_f32_16x16x32_bf16(*(const bf16x8*)(WupT + bo), aw[ks], accw[nt], 0, 0, 0);
                    acca[nt] = __builtin_amdgcn_mfma_f32_16x16x32_bf16(*(const bf16x8*)(AupT + bo), aa[ks], acca[nt], 0, 0, 0); } }
            const bool valid = (mt * 16 + fr) < ntok;
            const int tok = valid ? (mt * 16 + fr) : 0, m = m0 + tok, t = t0 + tok;
            const bf16_t* zr = Z + (size_t)m * NZ + ZC_S;
            const bool hasprev = (!smp) && (t >= 1);
            const bf16_t* zp = hasprev ? zr - NZ : zr;
            const float fp = hasprev ? 1.f : 0.f;
            bf16_t* so = SCN + ((size_t)m * 8 + h) * 384 + 4 * fq;
            float kk[4][4], av[4][4]; float ss = 0.f;
#pragma unroll
            for (int nt = 0; nt < 4; ++nt) {
                const int c = h * 64 + nt * 16 + 4 * fq;
                float cr[4], ck[4], cv[4], pr[4], pk[4], pv[4];
                unpack4(zc[nt][0], cr); unpack4(zc[nt][1], ck); unpack4(zc[nt][2], cv);
                if (smp) { const float* sp = state_shift + (size_t)(m - MP) * SW + c; const f32x4 x0 = *(const f32x4*)sp, x1 = *(const f32x4*)(sp + 512), x2 = *(const f32x4*)(sp + 1024);
#pragma unroll
                    for (int i = 0; i < 4; ++i) { pr[i] = x0[i]; pk[i] = x1[i]; pv[i] = x2[i]; } }
                else { unpack4(zq[nt][0], pr); unpack4(zq[nt][1], pk); unpack4(zq[nt][2], pv);
#pragma unroll
                    for (int i = 0; i < 4; ++i) { pr[i] *= fp; pk[i] *= fp; pv[i] *= fp; } }
                const f32x4 mr = *(const f32x4*)(mu + c), mk = *(const f32x4*)(mu + 512 + c), mv = *(const f32x4*)(mu + 1024 + c);
                const f32x4 w0v = *(const f32x4*)(w0 + c), a0v = *(const f32x4*)(a0p + c), kkv = *(const f32x4*)(k_k + c), kav = *(const f32x4*)(k_a + c);
                float r_[4], e_[4], kp[4], v_[4];
#pragma unroll
                for (int i = 0; i < 4; ++i) {
                    r_[i] = cr[i] + (pr[i] - cr[i]) * mr[i]; const float k = ck[i] + (pk[i] - ck[i]) * mk[i]; v_[i] = cv[i] + (pv[i] - cv[i]) * mv[i];
                    e_[i] = 0.60653065971f * sigmoidf_(w0v[i] + accw[nt][i]);
                    const float al = sigmoidf_(a0v[i] + acca[nt][i]); av[nt][i] = al;
                    const float kq = k * kkv[i]; kk[nt][i] = kq; ss += kq * kq;
                    kp[i] = k * (1.0f + (al - 1.0f) * kav[i]);
                }
                if (valid) {
                *(u32x2*)(so + 0 * 64 + nt * 16) = pack4(r_[0], r_[1], r_[2], r_[3]);
                *(u32x2*)(so + 1 * 64 + nt * 16) = pack4(e_[0], e_[1], e_[2], e_[3]);
                *(u32x2*)(so + 2 * 64 + nt * 16) = pack4(kp[0], kp[1], kp[2], kp[3]);
                *(u32x2*)(so + 3 * 64 + nt * 16) = pack4(v_[0], v_[1], v_[2], v_[3]); }
            }
            ss += __shfl_xor(ss, 16); ss += __shfl_xor(ss, 32);
            const float inv = 1.0f / fmaxf(sqrtf(ss), 1e-12f);
#pragma unroll
            for (int nt = 0; nt < 4; ++nt) {
                float q[4], b[4];
#pragma unroll
                for (int i = 0; i < 4; ++i) { q[i] = kk[nt][i] * inv; b[i] = q[i] * av[nt][i]; }
                if (valid) {
                *(u32x2*)(so + 4 * 64 + nt * 16) = pack4(q[0], q[1], q[2], q[3]);
                *(u32x2*)(so + 5 * 64 + nt * 16) = pack4(b[0], b[1], b[2], b[3]); }
            }
        }
    }
    if (!smp && (tile & 31) == 31) { for (int j = tid; j < SW; j += 512) a.out[O_SHIFTP + (size_t)bidx * SW + j] = bf2f(Z[(size_t)(m0 + 63) * NZ + ZC_S + j]); }
    __syncthreads();
}
__device__ void p2_all(const Args& a, LAS unsigned char* lds) {
    const int tid = threadIdx.x, G = gridDim.x, blk = blockIdx.x;
    for (int t = blk; t < 272; t += G) { if (t < 256) p2_tile<false>(a, lds, t); else p2_tile<true>(a, lds, t); }
    const bf16_t* Z = (const bf16_t*)(a.ws + OFF_Z);
    for (int idx = blk * 512 + tid; idx < MS * SW; idx += G * 512) { const int sidx = idx / SW, j = idx - sidx * SW; a.out[O_SHIFTS + idx] = bf2f(Z[(size_t)(MP + sidx) * NZ + ZC_S + j]); }
}

constexpr int SLOT = 64 * 72;
__device__ __forceinline__ void mm_nt(const LAS bf16_t* X, const LAS bf16_t* Y, int it, int jt0, int fr, int fq, f32x4 (&acc)[2]) {
    bf16x8 xa[2];
#pragma unroll
    for (int ks = 0; ks < 2; ++ks) xa[ks] = *(const LAS bf16x8*)(X + (it * 16 + fr) * 72 + ks * 32 + fq * 8);
#pragma unroll
    for (int u = 0; u < 2; ++u)
#pragma unroll
        for (int ks = 0; ks < 2; ++ks) acc[u] = __builtin_amdgcn_mfma_f32_16x16x32_bf16(*(const LAS bf16x8*)(Y + ((jt0 + u) * 16 + fr) * 72 + ks * 32 + fq * 8), xa[ks], acc[u], 0, 0, 0);
}
__device__ __forceinline__ void mm_nt_p(const LAS bf16_t* X, const LAS bf16_t* Y, int it, int jt0, int fr, int fq, f32x4 (&acc)[2]) {
    bf16x8 xa[2];
#pragma unroll
    for (int ks = 0; ks < 2; ++ks) xa[ks] = *(const LAS bf16x8*)(X + (it * 16 + fr) * 72 + ks * 32 + fq * 8);
#pragma unroll
    for (int u = 0; u < 2; ++u) { const int yrow = jt0 * 16 + 8 * (fr >> 2) + 4 * u + (fr & 3);
#pragma unroll
        for (int ks = 0; ks < 2; ++ks) acc[u] = __builtin_amdgcn_mfma_f32_16x16x32_bf16(*(const LAS bf16x8*)(Y + yrow * 72 + ks * 32 + fq * 8), xa[ks], acc[u], 0, 0, 0); }
}
__device__ __forceinline__ void stg8(bf16_t* dst, int i, int j0, f32x4 v0, f32x4 v1) { u32x4 w; w.x = cvt_pk_bf16(v0[0], v0[1]); w.y = cvt_pk_bf16(v0[2], v0[3]); w.z = cvt_pk_bf16(v1[0], v1[1]); w.w = cvt_pk_bf16(v1[2], v1[3]); *(u32x4*)(dst + i * 64 + j0) = w; }
template <int MASK> __device__ __forceinline__ f32x4 mask4(f32x4 v, int i, int j0) {
#pragma unroll
    for (int e = 0; e < 4; ++e) { const int j = j0 + e; const bool keep = MASK == 0 ? true : MASK == 1 ? (j < i) : MASK == 2 ? (j > i) : (j <= i); v[e] = keep ? v[e] : 0.f; }
    return v;
}
__device__ __forceinline__ void st4(LAS bf16_t* dst, int i, int j0, f32x4 v) { *(LAS u32x2*)(dst + i * 72 + j0) = pack4(v[0], v[1], v[2], v[3]); }
__device__ __forceinline__ f32x4 ld4(const LAS bf16_t* src, int i, int j0) { float f[4]; unpack4(*(const LAS u32x2*)(src + i * 72 + j0), f); return (f32x4){f[0], f[1], f[2], f[3]}; }
__device__ __forceinline__ void st4t(LAS bf16_t* dst, int i, int j0, f32x4 v) {
    const unsigned lo = cvt_pk_bf16(v[0], v[1]), hi = cvt_pk_bf16(v[2], v[3]);
    dst[(j0 + 0) * 72 + i] = (bf16_t)(lo & 0xffffu); dst[(j0 + 1) * 72 + i] = (bf16_t)(lo >> 16); dst[(j0 + 2) * 72 + i] = (bf16_t)(hi & 0xffffu); dst[(j0 + 3) * 72 + i] = (bf16_t)(hi >> 16); }
__device__ __forceinline__ void stg4(bf16_t* dst, int i, int j0, f32x4 v) { *(u32x2*)(dst + i * 64 + j0) = pack4(v[0], v[1], v[2], v[3]); }
#define ZACC() do { acc[0] = (f32x4){0.f, 0.f, 0.f, 0.f}; acc[1] = (f32x4){0.f, 0.f, 0.f, 0.f}; } while (0)

__device__ void p3a_chunks(const Args& a, LAS unsigned char* lds) {
    const int tid = threadIdx.x, G = gridDim.x, blk = blockIdx.x, wave = tid >> 6, lane = tid & 63, fr = lane & 15, fq = lane >> 4;
    unsigned char* ws = a.ws;
    const bf16_t* SCN = (const bf16_t*)(ws + OFF_SCNS) - (size_t)MP * 8 * 384;
    bf16_t* CHK = (bf16_t*)(ws + OFF_CHK); const bf16_t* Z = (const bf16_t*)(ws + OFF_Z); float* RK = (float*)(ws + OFF_RK);
    const bf16_t* WupT = (const bf16_t*)(ws + OFF_WUP); const bf16_t* AupT = (const bf16_t*)(ws + OFF_AUP);
    LAS bf16_t* SL = (LAS bf16_t*)lds;
#define S_(n) (SL + (n) * SLOT)
    LAS bf16_t* zraw = S_(8);
    LAS float* tot = (LAS float*)(lds + 17 * SLOT * 2);
    LAS float* pc = tot + 512;
    LAS float* LWf = (LAS float*)(lds + 2 * SLOT * 2);
    LAS float* LAf = (LAS float*)(lds + 4 * SLOT * 2);
    const int it = wave >> 1, jt0 = (wave & 1) * 2, irow = it * 16 + fr;
    u32x4 rg[6];
#define P3A_LOAD(unit_) do { const int bh_ = (unit_) >> 5, c_ = (unit_) & 31; const int mm0 = (bh_ >> 3) * TSEQ + c_ * 64; const int hh = bh_ & 7; \
        _Pragma("unroll") for (int i = 0; i < 6; ++i) { const int p = tid + 512 * i; if (p < 65 * 40) { const int rr = p / 40, sg = p - rr * 40, seg = sg >> 3, o8 = sg & 7; \
            const int col = seg < 3 ? (ZC_S + seg * 512 + hh * 64) : (ZC_S + 1536 + (seg - 3) * 64); const int mrow = (rr == 0 && c_ == 0) ? mm0 : (mm0 - 1 + rr); \
            rg[i] = *(const u32x4*)(Z + (size_t)mrow * NZ + col + o8 * 8); } } } while (0)
    if (blk < 2048) P3A_LOAD(blk);
    int hcur = -1;
    float mur = 0.f, muk = 0.f, muv = 0.f, muwd = 0.f, muad = 0.f, w0k = 0.f, a0k = 0.f, kkk = 0.f, kak = 0.f, rkk = 0.f;
    for (int unit = blk; unit < 2048; unit += G) {
        const int h = (unit >> 5) & 7, c = unit & 31, k = tid & 63, g = tid >> 6;
        if (h != hcur) {
            const float* mu = a.in[10];
            mur = mu[h * 64 + k]; muk = mu[512 + h * 64 + k]; muv = mu[1024 + h * 64 + k]; muwd = mu[1536 + k]; muad = mu[1600 + k];
            w0k = a.in[11][h * 64 + k]; a0k = a.in[13][h * 64 + k]; kkk = a.in[15][h * 64 + k]; kak = a.in[16][h * 64 + k]; rkk = a.in[17][h * 64 + k];
            const int row = tid >> 3, o8 = tid & 7;
            *(LAS u32x4*)(S_(15) + row * 72 + o8 * 8) = *(const u32x4*)(WupT + (size_t)(h * 64 + row) * 64 + o8 * 8);
            *(LAS u32x4*)(S_(16) + row * 72 + o8 * 8) = *(const u32x4*)(AupT + (size_t)(h * 64 + row) * 64 + o8 * 8);
            hcur = h; }
#pragma unroll
        for (int i = 0; i < 6; ++i) { const int p = tid + 512 * i; if (p < 65 * 40) { const int rr = p / 40, sg = p - rr * 40, seg = sg >> 3, o8 = sg & 7; *(LAS u32x4*)(zraw + rr * 320 + seg * 64 + o8 * 8) = rg[i]; } }
        LBAR();
        float r_[8], kx[8], v_[8];
        {
            const float fp0 = (c != 0) ? 1.f : 0.f;
            float zz[9][5];
#pragma unroll
            for (int rr = 0; rr < 9; ++rr) { const LAS bf16_t* zp_ = zraw + (g * 8 + rr) * 320 + k;
#pragma unroll
                for (int sg = 0; sg < 5; ++sg) zz[rr][sg] = bf2f(zp_[sg * 64]); }
            if (g == 0) {
#pragma unroll
                for (int sg = 0; sg < 5; ++sg) zz[0][sg] *= fp0; }
#pragma unroll
            for (int j = 0; j < 8; ++j) { const int t = g * 8 + j;
                const float c0 = zz[j + 1][0], c1 = zz[j + 1][1], c2 = zz[j + 1][2], c3 = zz[j + 1][3], c4 = zz[j + 1][4];
                const float p0 = zz[j][0], p1 = zz[j][1], p2 = zz[j][2], p3 = zz[j][3], p4 = zz[j][4];
                r_[j] = c0 + (p0 - c0) * mur; kx[j] = c1 + (p1 - c1) * muk; v_[j] = c2 + (p2 - c2) * muv;
                const float wd = c3 + (p3 - c3) * muwd, ad = c4 + (p4 - c4) * muad;
                const float e2 = __expf(2.0f * wd);
                S_(0)[t * 72 + k] = f2bf(1.0f - 2.0f * __builtin_amdgcn_rcpf(e2 + 1.0f)); S_(1)[t * 72 + k] = f2bf(ad); }
        }
        LBAR();
        f32x4 acc[2];
        ZACC(); mm_nt(S_(0), S_(15), it, jt0, fr, fq, acc);
#pragma unroll
        for (int u = 0; u < 2; ++u) *(LAS f32x4*)(LWf + irow * 64 + (jt0 + u) * 16 + 4 * fq) = acc[u];
        ZACC(); mm_nt(S_(1), S_(16), it, jt0, fr, fq, acc);
#pragma unroll
        for (int u = 0; u < 2; ++u) *(LAS f32x4*)(LAf + irow * 64 + (jt0 + u) * 16 + 4 * fq) = acc[u];
        LBAR();
        {
            float ev[8], cs[8], qn[8], bbv[8], kpv[8]; float run = 0.f;
#pragma unroll
            for (int j = 0; j < 8; ++j) { const int t = g * 8 + j;
                const float e = 0.60653065971f * sigmoidf_(w0k + LWf[t * 64 + k]); const float al = sigmoidf_(a0k + LAf[t * 64 + k]);
                const float kq = kx[j] * kkk, kp = kx[j] * (1.0f + (al - 1.0f) * kak);
                float ss = kq * kq, rs_ = r_[j] * kp * rkk;
                ss = rowsum16(ss); rs_ = rowsum16(rs_);
                ss += __shfl_xor(ss, 16); rs_ += __shfl_xor(rs_, 16); ss += __shfl_xor(ss, 32); rs_ += __shfl_xor(rs_, 32);
                const float inv = __builtin_amdgcn_rsqf(fmaxf(ss, 1e-24f));
                qn[j] = kq * inv; bbv[j] = qn[j] * al; kpv[j] = kp;
                if (lane == 0) RK[(size_t)unit * 64 + t] = rs_;
                ev[j] = e; run += e; cs[j] = run; }
            tot[g * 64 + k] = run;
            LBAR();
            float off = 0.f;
#pragma unroll
            for (int gg = 0; gg < 7; ++gg) { const float tv = tot[gg * 64 + k]; off += gg < g ? tv : 0.f; }
            float ak[8], bk[8], kk_[8];
#pragma unroll
            for (int j = 0; j < 8; ++j) { const int t = g * 8 + j; const float cum = off + cs[j];
                const float P = __expf(-cum), Pm1 = __expf(ev[j] - cum), iP = __builtin_amdgcn_rcpf(P);
                const float at = -qn[j] * Pm1, bt = bbv[j] * iP, kt = kpv[j] * iP, rt = r_[j] * P;
                S_(0)[t * 72 + k] = f2bf(at); S_(1)[t * 72 + k] = f2bf(bt); S_(2)[t * 72 + k] = f2bf(kt); S_(3)[t * 72 + k] = f2bf(rt);
                ak[j] = at; bk[j] = bt; kk_[j] = kt;
                if (j == 7 && g == 7) pc[k] = P; }
            *(LAS u32x4*)(S_(4) + k * 72 + g * 8) = pack8(ak); *(LAS u32x4*)(S_(5) + k * 72 + g * 8) = pack8(bk);
            *(LAS u32x4*)(S_(6) + k * 72 + g * 8) = pack8(kk_); *(LAS u32x4*)(S_(7) + k * 72 + g * 8) = pack8(v_);
        }
        LBAR();
        { const int nxt = (unit + G < 2048) ? unit + G : unit; P3A_LOAD(nxt); }
        ZACC(); mm_nt(S_(0), S_(1), it, jt0, fr, fq, acc);
#pragma unroll
        for (int u = 0; u < 2; ++u) { const int j0 = (jt0 + u) * 16 + 4 * fq; f32x4 v = mask4<1>(acc[u], irow, j0); st4(S_(11), irow, j0, v); st4t(S_(12), irow, j0, v);
#pragma unroll
            for (int e = 0; e < 4; ++e) v[e] += (j0 + e == irow) ? 1.f : 0.f;
            st4(S_(13), irow, j0, v); }
        ZACC(); mm_nt(S_(0), S_(2), it, jt0, fr, fq, acc);
#pragma unroll
        for (int u = 0; u < 2; ++u) { const int j0 = (jt0 + u) * 16 + 4 * fq; st4(S_(8), irow, j0, mask4<1>(acc[u], irow, j0)); }
        ZACC(); mm_nt(S_(3), S_(1), it, jt0, fr, fq, acc);
#pragma unroll
        for (int u = 0; u < 2; ++u) { const int j0 = (jt0 + u) * 16 + 4 * fq; st4(S_(9), irow, j0, mask4<3>(acc[u], irow, j0)); }
        ZACC(); mm_nt(S_(3), S_(2), it, jt0, fr, fq, acc);
#pragma unroll
        for (int u = 0; u < 2; ++u) { const int j0 = (jt0 + u) * 16 + 4 * fq; st4(S_(10), irow, j0, mask4<3>(acc[u], irow, j0)); }
        LBAR();
        ZACC(); mm_nt(S_(11), S_(12), it, jt0, fr, fq, acc);
#pragma unroll
        for (int u = 0; u < 2; ++u) { st4(S_(1), irow, (jt0 + u) * 16 + 4 * fq, acc[u]); st4t(S_(2), irow, (jt0 + u) * 16 + 4 * fq, acc[u]); }
        ZACC(); mm_nt(S_(7), S_(8), it, jt0, fr, fq, acc);
#pragma unroll
        for (int u = 0; u < 2; ++u) st4(S_(0), irow, (jt0 + u) * 16 + 4 * fq, acc[u]);
        LBAR();
#pragma unroll
        for (int sgi = 0; sgi < 4; ++sgi) {
            const int pa = (sgi & 1) ? 11 : 1, pta = (sgi & 1) ? 12 : 2, pb = (sgi & 1) ? 1 : 11, ptb = (sgi & 1) ? 2 : 12, tla = (sgi & 1) ? 14 : 13, tlb = (sgi & 1) ? 13 : 14;
            ZACC(); mm_nt(S_(tla), S_(pta), it, jt0, fr, fq, acc);
#pragma unroll
            for (int u = 0; u < 2; ++u) { const int j0 = (jt0 + u) * 16 + 4 * fq; st4(S_(tlb), irow, j0, acc[u] + ld4(S_(tla), irow, j0)); }
            ZACC(); mm_nt(S_(pa), S_(pta), it, jt0, fr, fq, acc);
#pragma unroll
            for (int u = 0; u < 2; ++u) { if (sgi < 3) st4(S_(pb), irow, (jt0 + u) * 16 + 4 * fq, acc[u]); st4t(S_(ptb), irow, (jt0 + u) * 16 + 4 * fq, acc[u]); }
            LBAR();
        }
        ZACC(); mm_nt(S_(13), S_(2), it, jt0, fr, fq, acc);
#pragma unroll
        for (int u = 0; u < 2; ++u) { const int j0 = (jt0 + u) * 16 + 4 * fq; st4(S_(14), irow, j0, acc[u] + ld4(S_(13), irow, j0)); }
        LBAR();
        ZACC(); mm_nt(S_(0), S_(14), it, jt0, fr, fq, acc);
#pragma unroll
        for (int u = 0; u < 2; ++u) st4(S_(1), irow, (jt0 + u) * 16 + 4 * fq, acc[u]);
        ZACC(); mm_nt(S_(4), S_(14), it, jt0, fr, fq, acc);
#pragma unroll
        for (int u = 0; u < 2; ++u) st4(S_(2), irow, (jt0 + u) * 16 + 4 * fq, acc[u]);
        LBAR();
        bf16_t* chk = CHK + (size_t)unit * 16384;
        const int j8 = jt0 * 16 + 8 * fq;
        ZACC();
        mm_nt_p(S_(9), S_(2), it, jt0, fr, fq, acc);
        { float rt8[8]; unpack8(*(const LAS u32x4*)(S_(3) + irow * 72 + j8), rt8);
          stg8(chk, irow, j8, acc[0] + (f32x4){rt8[0], rt8[1], rt8[2], rt8[3]}, acc[1] + (f32x4){rt8[4], rt8[5], rt8[6], rt8[7]}); }
        ZACC();
        mm_nt_p(S_(9), S_(1), it, jt0, fr, fq, acc);
        mm_nt_p(S_(10), S_(7), it, jt0, fr, fq, acc);
        stg8(chk + 4096, irow, j8, acc[0], acc[1]);
        ZACC();
        mm_nt_p(S_(1), S_(5), it, jt0, fr, fq, acc);
        mm_nt_p(S_(7), S_(6), it, jt0, fr, fq, acc);
        { const f32x4 pv0 = *(const LAS f32x4*)(pc + j8), pv1 = *(const LAS f32x4*)(pc + j8 + 4); stg8(chk + 8192, irow, j8, acc[0] * pv0, acc[1] * pv1); }
        ZACC();
        mm_nt_p(S_(5), S_(2), it, jt0, fr, fq, acc);
        { const float pr = pc[irow]; f32x4 v0 = acc[0], v1 = acc[1];
#pragma unroll
          for (int e = 0; e < 4; ++e) { v0[e] = (v0[e] + ((j8 + e == irow) ? 1.f : 0.f)) * pr; v1[e] = (v1[e] + ((j8 + 4 + e == irow) ? 1.f : 0.f)) * pr; }
          stg8(chk + 12288, irow, j8, v0, v1); }
        LBAR();
    }
#undef P3A_LOAD
#undef S_
}

__device__ void p3_sample_step(const Args& a, int blk, int G) {
    const int tid = threadIdx.x;
    unsigned char* ws = a.ws;
    const bf16_t* SCN = (const bf16_t*)(ws + OFF_SCNS) - (size_t)MP * 8 * 384;
    const float* state_wkv = a.in[6]; bf16_t* OS = (bf16_t*)(ws + OFF_OS);
    const int row = tid >> 3, c0 = (tid & 7) * 8;
    constexpr int NI = 4;
    for (int it0 = blk; it0 < MS * NH; it0 += G * NI) {
        u32x4 q[NI][5]; f32x4 sA[NI], sB[NI]; unsigned short vq[NI];
#pragma unroll
        for (int n = 0; n < NI; ++n) { const int itn = (it0 + n * G < MS * NH) ? it0 + n * G : it0; const int s_ = itn >> 3, h = itn & 7, m = MP + s_;
            const bf16_t* sc = SCN + ((size_t)m * 8 + h) * 384; const size_t so = ((size_t)(s_ * 8 + h) * 64 + row) * 64 + c0;
            q[n][0] = *(const u32x4*)(sc + c0); q[n][1] = *(const u32x4*)(sc + 64 + c0); q[n][2] = *(const u32x4*)(sc + 128 + c0); q[n][3] = *(const u32x4*)(sc + 256 + c0); q[n][4] = *(const u32x4*)(sc + 320 + c0);
            vq[n] = sc[192 + row]; sA[n] = *(const f32x4*)(state_wkv + so); sB[n] = *(const f32x4*)(state_wkv + so + 4); }
#pragma unroll
        for (int n = 0; n < NI; ++n) { const int itn = it0 + n * G; if (itn < MS * NH) { const int s_ = itn >> 3, h = itn & 7;
            float r_[8], e_[8], kp[8], kq[8], bb[8];
            unpack8(q[n][0], r_); unpack8(q[n][1], e_); unpack8(q[n][2], kp); unpack8(q[n][3], kq); unpack8(q[n][4], bb);
            const float vv = bf2f(vq[n]);
            const size_t so = ((size_t)(s_ * 8 + h) * 64 + row) * 64 + c0;
            float S[8] = {sA[n][0], sA[n][1], sA[n][2], sA[n][3], sB[n][0], sB[n][1], sB[n][2], sB[n][3]};
            float d = 0.f;
#pragma unroll
            for (int i = 0; i < 8; ++i) d += S[i] * kq[i];
            d += __shfl_xor(d, 1); d += __shfl_xor(d, 2); d += __shfl_xor(d, 4);
            float y = 0.f;
#pragma unroll
            for (int i = 0; i < 8; ++i) { S[i] = S[i] * __expf(-e_[i]) + (-d) * bb[i] + vv * kp[i]; y += S[i] * r_[i]; }
            y += __shfl_xor(y, 1); y += __shfl_xor(y, 2); y += __shfl_xor(y, 4);
            *(f32x4*)(a.out + O_WKVS + so) = (f32x4){S[0], S[1], S[2], S[3]}; *(f32x4*)(a.out + O_WKVS + so + 4) = (f32x4){S[4], S[5], S[6], S[7]};
            if ((tid & 7) == 0) OS[(size_t)s_ * 512 + h * 64 + row] = f2bf(y); } }
    }
}

__device__ void p3b_seq(const Args& a, LAS unsigned char* lds) {
    const int tid = threadIdx.x, G = gridDim.x, blk = blockIdx.x, wave = tid >> 6, lane = tid & 63, fr = lane & 15, fq = lane >> 4;
    unsigned char* ws = a.ws;
    const bf16_t* CHK = (const bf16_t*)(ws + OFF_CHK); bf16_t* SALL = (bf16_t*)(ws + OFF_SALL);
    LAS bf16_t* Shi = (LAS bf16_t*)lds; LAS bf16_t* Slo = Shi + 2 * 16 * 72;
    for (int item = blk; item < 256; item += G) {
        const int xcd_ = item & 7, idx_ = item >> 3;
        const int bh = (G == 256) ? xcd_ * 8 + (idx_ >> 2) : (item >> 2), q = (G == 256) ? (idx_ & 3) : (item & 3), j = wave;
        LBAR();
        for (int i = tid; i < 16 * 72; i += 512) { Shi[i] = 0; Slo[i] = 0; }
        LBAR();
        const bf16_t* chk0 = CHK + (size_t)(bh * 32) * 16384;
        constexpr int PF = 8;
        const size_t goff = 12288 + (size_t)(j * 16 + fr) * 64 + fq * 8, hoff = 8192 + (size_t)(q * 16 + fr) * 64 + j * 16 + 4 * fq;
        bf16x8 GA0[PF], GA1[PF], GB0[PF], GB1[PF]; u32x2 HA[PF], HB[PF];
#define P3B_LOAD(G0, G1, HQ, c0) do { if (wave < 4) { _Pragma("unroll") for (int u = 0; u < PF; ++u) { const bf16_t* cn = chk0 + (size_t)((c0) + u) * 16384; \
            G0[u] = *(const bf16x8*)(cn + goff); G1[u] = *(const bf16x8*)(cn + goff + 32); HQ[u] = *(const u32x2*)(cn + hoff); } } } while (0)
#define P3B_STEPS(G0, G1, HQ, c0) do { _Pragma("unroll") for (int u = 0; u < PF; ++u) { const int c = (c0) + u; \
            if (wave < 4) { \
                const bf16x8 cg0 = G0[u], cg1 = G1[u]; const u32x2 chq = HQ[u]; \
                const LAS bf16_t* sh = Shi + (c & 1) * (16 * 72) + fr * 72 + fq * 8; const LAS bf16_t* sl = Slo + (c & 1) * (16 * 72) + fr * 72 + fq * 8; \
                const bf16x8 h0 = *(const LAS bf16x8*)sh, h1 = *(const LAS bf16x8*)(sh + 32), l0 = *(const LAS bf16x8*)sl, l1 = *(const LAS bf16x8*)(sl + 32); \
                bf16_t* sg = SALL + (size_t)(bh * 32 + c) * 4096 + (q * 16 + fr) * 64 + fq * 8; \
                if (wave == 0) *(bf16x8*)sg = h0; \
                if (wave == 1) *(bf16x8*)(sg + 32) = h1; \
                f32x4 acc = {0.f, 0.f, 0.f, 0.f}; \
                acc = __builtin_amdgcn_mfma_f32_16x16x32_bf16(cg0, h0, acc, 0, 0, 0); acc = __builtin_amdgcn_mfma_f32_16x16x32_bf16(cg1, h1, acc, 0, 0, 0); \
                acc = __builtin_amdgcn_mfma_f32_16x16x32_bf16(cg0, l0, acc, 0, 0, 0); acc = __builtin_amdgcn_mfma_f32_16x16x32_bf16(cg1, l1, acc, 0, 0, 0); \
                float hv[4]; unpack4(chq, hv); \
                const float s0 = acc[0] + hv[0], s1 = acc[1] + hv[1], s2 = acc[2] + hv[2], s3 = acc[3] + hv[3]; \
                const u32x2 ph = pack4(s0, s1, s2, s3); float hf[4]; unpack4(ph, hf); \
                const u32x2 pl = pack4(s0 - hf[0], s1 - hf[1], s2 - hf[2], s3 - hf[3]); \
                const int wo = ((c + 1) & 1) * (16 * 72) + fr * 72 + j * 16 + 4 * fq; \
                *(LAS u32x2*)(Shi + wo) = ph; *(LAS u32x2*)(Slo + wo) = pl; \
                if (c == 31) *(f32x4*)(a.out + O_WKVP + ((size_t)bh * 64 + q * 16 + fr) * 64 + j * 16 + 4 * fq) = (f32x4){s0, s1, s2, s3}; \
            } \
            LBAR(); } } while (0)
        P3B_LOAD(GA0, GA1, HA, 0); P3B_LOAD(GB0, GB1, HB, 8);
        P3B_STEPS(GA0, GA1, HA, 0); P3B_LOAD(GA0, GA1, HA, 16);
        P3B_STEPS(GB0, GB1, HB, 8); P3B_LOAD(GB0, GB1, HB, 24);
        P3B_STEPS(GA0, GA1, HA, 16);
        P3B_STEPS(GB0, GB1, HB, 24);
#undef P3B_LOAD
#undef P3B_STEPS
    }
}

__device__ void p3c_out(const Args& a) {
    const int tid = threadIdx.x, G = gridDim.x, blk = blockIdx.x, wave = tid >> 6, lane = tid & 63, fr = lane & 15, fq = lane >> 4;
    unsigned char* ws = a.ws;
    const bf16_t* SCN = (const bf16_t*)(ws + OFF_SCNS) - (size_t)MP * 8 * 384; const bf16_t* CHK = (const bf16_t*)(ws + OFF_CHK); const bf16_t* SALL = (const bf16_t*)(ws + OFF_SALL); bf16_t* YC = (bf16_t*)a.out;
    const bf16_t* Z = (const bf16_t*)(ws + OFF_Z); const float* RK = (const float*)(ws + OFF_RK); const float* mu = a.in[10];
    const float* r_k = a.in[17]; const float* ln_w = a.in[18]; const float* ln_b = a.in[19];
    for (int pi = blk; pi < 1024; pi += G) {
        const int unit = pi * 2 + (wave >> 2), it = wave & 3, bh = unit >> 5, c = unit & 31, b = bh >> 3, h = bh & 7;
        const int m = b * TSEQ + c * 64 + it * 16 + fr;
        const bf16_t* chk = CHK + (size_t)unit * 16384; const bf16_t* sall = SALL + (size_t)unit * 4096;
        bf16x8 xq[2];
#pragma unroll
        for (int ks = 0; ks < 2; ++ks) xq[ks] = *(const bf16x8*)(chk + (it * 16 + fr) * 64 + ks * 32 + fq * 8);
        const bool hasprev = (c * 64 + it * 16 + fr) >= 1;
        const bf16_t* zv = Z + (size_t)m * NZ + ZC_S + 1024 + h * 64 + 8 * fq; const bf16_t* zvp = hasprev ? zv - NZ : zv; const float fpv = hasprev ? 1.f : 0.f;
        const float rk = RK[(size_t)unit * 64 + it * 16 + fr];
        bf16_t* yp = YC + (size_t)m * D + 512 + h * 64 + 8 * fq;
        f32x4 acc[4]; u32x4 qy[2], qv[2], qvp[2], qg[2];
#pragma unroll
        for (int P = 0; P < 2; ++P) { qy[P] = *(const u32x4*)(chk + 4096 + (it * 16 + fr) * 64 + 32 * P + 8 * fq);
            qv[P] = *(const u32x4*)(zv + 32 * P); qvp[P] = *(const u32x4*)(zvp + 32 * P); qg[P] = *(const u32x4*)(yp + 32 * P); }
#pragma unroll
        for (int jt = 0; jt < 4; ++jt) { acc[jt] = (f32x4){0.f, 0.f, 0.f, 0.f}; const int srow = 32 * (jt >> 1) + 8 * (fr >> 2) + 4 * (jt & 1) + (fr & 3);
#pragma unroll
            for (int ks = 0; ks < 2; ++ks) acc[jt] = __builtin_amdgcn_mfma_f32_16x16x32_bf16(*(const bf16x8*)(sall + srow * 64 + ks * 32 + fq * 8), xq[ks], acc[jt], 0, 0, 0);
        }
        float o[2][8], vv[2][8]; float sm = 0.f;
#pragma unroll
        for (int P = 0; P < 2; ++P) { float yl[8], vc[8], vp[8]; unpack8(qy[P], yl); unpack8(qv[P], vc); unpack8(qvp[P], vp);
            const float* mvp = mu + 1024 + h * 64 + 32 * P + 8 * fq; const f32x4 mv0 = *(const f32x4*)mvp, mv1 = *(const f32x4*)(mvp + 4);
#pragma unroll
            for (int i = 0; i < 8; ++i) { const float mvi = i < 4 ? mv0[i & 3] : mv1[i & 3]; o[P][i] = acc[2 * P + (i >> 2)][i & 3] + yl[i]; sm += o[P][i]; vv[P][i] = vc[i] + (vp[i] * fpv - vc[i]) * mvi; } }
        sm += __shfl_xor(sm, 16); sm += __shfl_xor(sm, 32);
        const float mean = sm * (1.0f / 64.0f); float var = 0.f;
#pragma unroll
        for (int P = 0; P < 2; ++P)
#pragma unroll
            for (int i = 0; i < 8; ++i) { o[P][i] -= mean; var += o[P][i] * o[P][i]; }
        var += __shfl_xor(var, 16); var += __shfl_xor(var, 32);
        const float rstd = rsqrtf(var * (1.0f / 64.0f) + 64e-5f);
#pragma unroll
        for (int P = 0; P < 2; ++P) { const int ch = h * 64 + 32 * P + 8 * fq; const f32x4 lw0 = *(const f32x4*)(ln_w + ch), lw1 = *(const f32x4*)(ln_w + ch + 4), lb0 = *(const f32x4*)(ln_b + ch), lb1 = *(const f32x4*)(ln_b + ch + 4);
            float gt[8], y[8]; unpack8(qg[P], gt);
#pragma unroll
            for (int i = 0; i < 8; ++i) { const float lwi = i < 4 ? lw0[i & 3] : lw1[i & 3], lbi = i < 4 ? lb0[i & 3] : lb1[i & 3]; y[i] = (o[P][i] * rstd * lwi + lbi + rk * vv[P][i]) * gt[i]; }
            *(u32x4*)(yp + 32 * P) = pack8(y); }
    }
    const bf16_t* OS = (const bf16_t*)(ws + OFF_OS);
    const int c = lane * 8, h = lane >> 3, cc = (lane & 7) * 8;
    for (int s = blk * 8 + wave; s < MS; s += G * 8) {
        const int m = MP + s;
        float o[8], r_[8], kp[8], v_[8], g[8];
        const bf16_t* sc = SCN + ((size_t)m * 8 + h) * 384 + cc;
        unpack8(*(const u32x4*)(OS + (size_t)s * 512 + c), o); unpack8(*(const u32x4*)(sc), r_); unpack8(*(const u32x4*)(sc + 128), kp); unpack8(*(const u32x4*)(sc + 192), v_);
        unpack8(*(const u32x4*)(YC + (size_t)m * D + 512 + c), g);
        float sm = 0.f, rk = 0.f;
#pragma unroll
        for (int i = 0; i < 8; ++i) { sm += o[i]; rk += r_[i] * kp[i] * r_k[h * 64 + cc + i]; }
        sm += __shfl_xor(sm, 1); sm += __shfl_xor(sm, 2); sm += __shfl_xor(sm, 4);
        rk += __shfl_xor(rk, 1); rk += __shfl_xor(rk, 2); rk += __shfl_xor(rk, 4);
        const float mean = sm * (1.0f / 64.0f);
        float var = 0.f;
#pragma unroll
        for (int i = 0; i < 8; ++i) { o[i] -= mean; var += o[i] * o[i]; }
        var += __shfl_xor(var, 1); var += __shfl_xor(var, 2); var += __shfl_xor(var, 4);
        const float rstd = rsqrtf(var * (1.0f / 64.0f) + 64e-5f);
        float y[8];
#pragma unroll
        for (int i = 0; i < 8; ++i) y[i] = (o[i] * rstd * ln_w[c + i] + ln_b[c + i] + rk * v_[i]) * g[i];
        *(u32x4*)(YC + (size_t)m * D + 512 + c) = pack8(y);
    }
}

__device__ void p5_out(const Args& a, LAS unsigned char* lds) {
    const int tid = threadIdx.x, G = gridDim.x, blk = blockIdx.x, wave = tid >> 6, lane = tid & 63, fr = lane & 15, fq = lane >> 4;
    unsigned char* ws = a.ws;
    const bf16_t* YC = (const bf16_t*)a.out; const bf16_t* WoutT = (const bf16_t*)(ws + OFF_WOUT); const bf16_t* PB = (const bf16_t*)(ws + OFF_PB); const bf16_t* WppT = (const bf16_t*)(ws + OFF_WPP);
    bf16_t* H1B = (bf16_t*)(ws + OFF_H1B); bf16_t* PP = (bf16_t*)((unsigned char*)a.out + PPD_OFF);
    { pg8::Gemm g{YC, WoutT, MP, D, D}; pg8::StaticOrder S; S.init(MP, D, G, blk); EpiH1 E{a.in[0], H1B}; pg8::gemm_phase<EpiH1, pg8::StaticOrder>(lds, g, S, E, nullptr); }
    for (int t2 = blk; t2 < 256; t2 += G) {
        const int tile = t2 * 2 + (wave >> 2), ks = wave & 3, rt = tile & 7, ct = tile >> 3; const int row = MP + rt * 16 + fr; const size_t o = (size_t)row * D + ct * 16 + 4 * fq;
        f32x4 acc = mini_tile_k<8>(YC + (size_t)row * D + ks * 256, WoutT + (size_t)(ct * 16 + fr) * D + ks * 256, fq);
        f32x4 acp = mini_tile_k<2>(PB + (size_t)row * DP + ks * 64, WppT + (size_t)(ct * 16 + fr) * DP + ks * 64, fq);
        acc = splitk_reduce(lds, acc, wave, lane);
        acp = splitk_reduce(lds, acp, wave, lane);
        if (ks == 0) {
            const f32x4 v = *(const f32x4*)(a.in[1] + (size_t)(row - MP) * D + ct * 16 + 4 * fq) + acc;
            *(u32x2*)(H1B + o) = pack4(v[0], v[1], v[2], v[3]);
            *(u32x2*)(PP + o) = pack4(acp[0], acp[1], acp[2], acp[3]);
        }
    }
}

__device__ void p6_gate(const Args& a, LAS unsigned char* lds) {
    const int tid = threadIdx.x, G = gridDim.x, blk = blockIdx.x, wave = tid >> 6, lane = tid & 63, fr = lane & 15, fq = lane >> 4;
    unsigned char* ws = a.ws;
    const bf16_t* WpgT = (const bf16_t*)(ws + OFF_WPG); const bf16_t* H1B = (const bf16_t*)(ws + OFF_H1B); const bf16_t* PP = (const bf16_t*)((const unsigned char*)a.out + PPD_OFF);
    { pg8::Gemm g{H1B, WpgT, MP, D, D}; pg8::StaticOrder S; S.init(MP, D, G, blk); EpiH2 E{H1B, PP, (bf16_t*)(ws + OFF_H2B)}; pg8::gemm_phase<EpiH2, pg8::StaticOrder>(lds, g, S, E, nullptr); }
    for (int t2 = blk; t2 < 256; t2 += G) {
        const int tile = t2 * 2 + (wave >> 2), ks = wave & 3, rt = tile & 7, ct = tile >> 3; const int row = MP + rt * 16 + fr; const size_t o = (size_t)row * D + ct * 16 + 4 * fq;
        f32x4 g = mini_tile_k<8>(H1B + (size_t)row * D + ks * 256, WpgT + (size_t)(ct * 16 + fr) * D + ks * 256, fq);
        g = splitk_reduce(lds, g, wave, lane);
        if (ks == 0) {
            float h[4], p[4]; unpack4(*(const u32x2*)(H1B + o), h); unpack4(*(const u32x2*)(PP + o), p);
            f32x4 v; v[0] = h[0] + sigmoidf_(g[0]) * p[0]; v[1] = h[1] + sigmoidf_(g[1]) * p[1]; v[2] = h[2] + sigmoidf_(g[2]) * p[2]; v[3] = h[3] + sigmoidf_(g[3]) * p[3];
            *(u32x2*)((bf16_t*)(ws + OFF_H2B) + o) = pack4(v[0], v[1], v[2], v[3]);
        }
    }
}

__device__ void p7_norm(const Args& a) {
    const int tid = threadIdx.x, G = gridDim.x, blk = blockIdx.x, wave = tid >> 6, lane = tid & 63;
    const float* fg = a.in[23]; const bf16_t* H2B = (const bf16_t*)(a.ws + OFF_H2B);
    f32x4 gv[2][2];
#pragma unroll
    for (int i = 0; i < 2; ++i) { gv[i][0] = *(const f32x4*)(fg + i * 512 + lane * 8); gv[i][1] = *(const f32x4*)(fg + i * 512 + lane * 8 + 4); }
    for (int row0 = (blk * 8 + wave) * 4; row0 < MT; row0 += G * 32) {
        u32x4 q[4][2];
#pragma unroll
        for (int r = 0; r < 4; ++r)
#pragma unroll
            for (int i = 0; i < 2; ++i) q[r][i] = *(const u32x4*)(H2B + (size_t)(row0 + r) * D + i * 512 + lane * 8);
#pragma unroll
        for (int r = 0; r < 4; ++r) { float f[2][8]; unpack8(q[r][0], f[0]); unpack8(q[r][1], f[1]); float ss = 0.f;
#pragma unroll
            for (int i = 0; i < 2; ++i)
#pragma unroll
                for (int e = 0; e < 8; ++e) ss += f[i][e] * f[i][e];
#pragma unroll
            for (int o = 32; o >= 1; o >>= 1) ss += __shfl_xor(ss, o);
            const float rs = rsqrtf(ss * (1.0f / D) + 1e-6f);
#pragma unroll
            for (int i = 0; i < 2; ++i) { float* yp = a.out + (size_t)(row0 + r) * D + i * 512 + lane * 8;
                *(f32x4*)(yp) = (f32x4){f[i][0], f[i][1], f[i][2], f[i][3]} * rs * gv[i][0]; *(f32x4*)(yp + 4) = (f32x4){f[i][4], f[i][5], f[i][6], f[i][7]} * rs * gv[i][1]; } }
    }
}

#define XB_TMO      128
#define XB_XCNT(j)  (256  + 64 * (j))
#define XB_XSUB(j)  (1280 + 64 * (j))
#define XB_XGEN(j)  (2304 + 64 * (j))
#define XB_TOP      3328
#define XB_TOPGEN   3392
#define XCD_BAR_WORDS 3456
#define XB_SPIN_CAP (1u << 18)

__device__ __forceinline__ unsigned xb_ld(unsigned* p)              { return __hip_atomic_load(p, __ATOMIC_RELAXED, __HIP_MEMORY_SCOPE_AGENT); }
__device__ __forceinline__ unsigned xb_add(unsigned* p, unsigned v) { return __hip_atomic_fetch_add(p, v, __ATOMIC_RELAXED, __HIP_MEMORY_SCOPE_AGENT); }
__device__ __forceinline__ unsigned xb_xcc_id() { return (unsigned)__builtin_amdgcn_s_getreg((3 << 11) | 20) & 0xFu; }
#define XB_SPIN(cond, bar) do { unsigned _sp = 0; while (cond) { __builtin_amdgcn_s_sleep(1); \
    if ((++_sp & 255u) == 0u) { if (xb_ld(&(bar)[XB_TMO])) break; if (_sp > XB_SPIN_CAP) { atomicAdd(&(bar)[XB_TMO], 1u); break; } } } } while (0)

struct XcdBarrier {
    unsigned* bar; unsigned x;
    volatile LAS unsigned* st;
};

__device__ __forceinline__ XcdBarrier xcd_barrier_post(unsigned* bar, volatile LAS unsigned* st) {
    XcdBarrier b; b.bar = bar; b.x = xb_xcc_id(); b.st = st;
    if (threadIdx.x == 0) (void)xb_add(&bar[XB_XCNT(b.x)], 1u);
    return b;
}
__device__ __forceinline__ void xcd_barrier_complete(unsigned* bar, unsigned x, unsigned& nloc, unsigned& nx) {
    const unsigned G = gridDim.x * gridDim.y * gridDim.z;
    unsigned sum, cnt, mine, sp = 0u;
    for (;;) {
        sum = 0u; cnt = 0u; mine = 0u;
#pragma unroll
        for (unsigned j = 0; j < 16; ++j) { const unsigned c = xb_ld(&bar[XB_XCNT(j)]); sum += c; cnt += (c > 0u) ? 1u : 0u; mine = (j == x) ? c : mine; }
        if (sum == G) break;
        __builtin_amdgcn_s_sleep(1);
        if ((++sp & 255u) == 0u) { if (xb_ld(&bar[XB_TMO])) break; if (sp > XB_SPIN_CAP) { atomicAdd(&bar[XB_TMO], 1u); break; } }
    }
    nloc = mine > 0u ? mine : 1u; nx = cnt > 0u ? cnt : 1u;
}

__device__ __forceinline__ void xcd_barrier(const XcdBarrier& b) {
    asm volatile("s_waitcnt vmcnt(0)" ::: "memory");
    __syncthreads();
    if (threadIdx.x == 0) {
        unsigned* bar = b.bar;
        __builtin_amdgcn_s_waitcnt(0);
        unsigned nloc = b.st[0], nx = b.st[1];
        if (nloc == 0u) { xcd_barrier_complete(bar, b.x, nloc, nx); b.st[0] = nloc; b.st[1] = nx; }
        const unsigned old = xb_add(&bar[XB_XSUB(b.x)], 1u);
        const unsigned gen = old / nloc;
        if (old + 1u == (gen + 1u) * nloc) {
            __builtin_amdgcn_fence(__ATOMIC_RELEASE, "agent");
            asm volatile("s_waitcnt vmcnt(0)" ::: "memory");
            const unsigned og = xb_add(&bar[XB_TOP], 1u);
            const unsigned tg = og / nx;
            if (og + 1u == (tg + 1u) * nx) xb_add(&bar[XB_TOPGEN], 1u);
            else XB_SPIN(xb_ld(&bar[XB_TOPGEN]) == tg, bar);
            __builtin_amdgcn_fence(__ATOMIC_ACQUIRE, "agent");
            xb_add(&bar[XB_XGEN(b.x)], 1u);
            asm volatile("s_waitcnt vmcnt(0)" ::: "memory");
        } else {
            XB_SPIN(xb_ld(&bar[XB_XGEN(b.x)]) == gen, bar);
            __builtin_amdgcn_fence(__ATOMIC_ACQUIRE, "agent");
            asm volatile("s_waitcnt vmcnt(0)" ::: "memory");
        }
    }
    __syncthreads();
}

__global__ void __launch_bounds__(512, 2) fwd(Args a) {
    extern __shared__ __attribute__((aligned(16))) unsigned char lds_raw[];
    LAS unsigned char* lds = (LAS unsigned char*)lds_raw;
    cg::grid_group grid = cg::this_grid();
    volatile LAS unsigned* xst = (volatile LAS unsigned*)(lds + LDS_BYTES - 16);
    if (threadIdx.x == 0) { xst[0] = 0u; xst[1] = 0u; }
    __syncthreads();
    const XcdBarrier xb = xcd_barrier_post((unsigned*)(a.ws + OFF_BAR), xst);
    if (a.ph_hi > 1000) grid.sync();
#define IN(k) (a.ph_lo <= (k) && (k) < a.ph_hi)
#define GSYNC() xcd_barrier(xb)
#define SEAM(k) do { if (IN(k) && IN((k) + 1)) GSYNC(); } while (0)
#ifndef REP_PHASE
#define REP_PHASE -1
#endif
#define REPS(k) ((REP_PHASE == (k)) ? 2 : 1)
    if (IN(0)) for (int r = 0; r < REPS(0); ++r) { if (r) GSYNC(); p0_prep(a, lds); }
    SEAM(0);
    if (IN(1)) for (int r = 0; r < REPS(1); ++r) { if (r) GSYNC(); p1_gemm_in(a, lds); }
    SEAM(1);
    if (IN(2)) for (int r = 0; r < REPS(2); ++r) { if (r) GSYNC(); p2_all(a, lds); }
    if (IN(2) && !IN(3)) {}
    else if (!IN(2) && IN(3)) {}
    if (IN(3)) for (int r = 0; r < REPS(3); ++r) { if (r) GSYNC(); __syncthreads(); p3a_chunks(a, lds); }
    SEAM(3);
    if (IN(4)) for (int r = 0; r < REPS(4); ++r) { if (r) GSYNC(); p3b_seq(a, lds); if (r == 0) p3_sample_step(a, (int)blockIdx.x, (int)gridDim.x); }
    SEAM(4);
    if (IN(5)) p3c_out(a);
    SEAM(5);
    if (IN(6)) p5_out(a, lds);
    SEAM(6);
    if (IN(7)) p6_gate(a, lds);
    SEAM(7);
#if REP_PHASE == 99
    GSYNC(); GSYNC(); GSYNC(); GSYNC();
#endif
    if (IN(8)) p7_norm(a);
}

#ifndef N_LAUNCH_MODE
#define N_LAUNCH_MODE 1
#endif
extern "C" void kernel_launch(void* const* d_in, const int* in_sizes, int n_in, void* d_out, int out_size, void* d_ws, size_t ws_size, hipStream_t stream) {
    static int grid = 0;
    if (grid == 0) {
        if (n_in != 24 || ws_size < WS_END) { fprintf(stderr, "kernel_launch: unexpected n_in %d / ws_size %zu (need %zu)\n", n_in, ws_size, (size_t)WS_END); grid = -1; return; }
        int dev = 0, cus = 0, per_cu = 0;
        (void)hipGetDevice(&dev); (void)hipDeviceGetAttribute(&cus, hipDeviceAttributeMultiprocessorCount, dev);
        if (hipFuncSetAttribute((const void*)fwd, hipFuncAttributeMaxDynamicSharedMemorySize, LDS_BYTES) != hipSuccess) { fprintf(stderr, "kernel_launch: hipFuncSetAttribute failed\n"); grid = -1; return; }
        if (hipOccupancyMaxActiveBlocksPerMultiprocessor(&per_cu, (const void*)fwd, 512, LDS_BYTES) != hipSuccess || per_cu < 1) { fprintf(stderr, "kernel_launch: occupancy query gives %d\n", per_cu); per_cu = 1; }
        (void)hipGetLastError();
        grid = cus;
    }
    if (grid < 0) return;
    Args a{};
    for (int i = 0; i < 24; ++i) a.in[i] = (const float*)d_in[i];
    a.out = (float*)d_out; a.ws = (unsigned char*)d_ws;
    (void)hipMemsetAsync((unsigned char*)d_ws + OFF_BAR, 0, XCD_BAR_WORDS * 4, stream);
    if (N_LAUNCH_MODE == 1) {
        a.ph_lo = 0; a.ph_hi = 9;
        void* args[] = {&a};
        hipError_t e = hipLaunchCooperativeKernel((const void*)fwd, dim3(grid), dim3(512), args, LDS_BYTES, stream);
        if (e != hipSuccess) fprintf(stderr, "kernel_launch: cooperative launch failed: %s (grid %d)\n", hipGetErrorString(e), grid);
    } else {
        for (int ph = 0; ph < 9; ++ph) { a.ph_lo = ph; a.ph_hi = ph + 1; hipLaunchKernelGGL(fwd, dim3(grid), dim3(512), LDS_BYTES, stream, a); }
    }
}
```

```cpp
#include <hip/hip_runtime.h>
#include <hip/hip_cooperative_groups.h>
#include <cstdio>
namespace pg8 {
#define PG8_LAS __attribute__((address_space(3)))
typedef unsigned short bf16_t;
typedef short bf16x8 __attribute__((ext_vector_type(8)));
typedef float f32x4 __attribute__((ext_vector_type(4)));
typedef unsigned u32x4 __attribute__((ext_vector_type(4)));
constexpr int BM = 256, BK = 64, HALF = 128, HTB = HALF * BK * 2  , STAGE_BYTES = 8 * HTB, NXCD = 8, WGM = 8;

__host__ __device__ __forceinline__ int lds_byte(int r, int c) { const int st = (r >> 4) * 2 + (c >> 5), rr = r & 15, cc = c & 31, ob = rr * 64 + cc * 2; return st * 1024 + (ob ^ (((ob >> 9) & 1) << 5)); }
__host__ __device__ __forceinline__ void stage_rc(int b, int& R, int& C) { const int st = b / 1024, sb = b % 1024, swz = sb ^ (((sb >> 9) & 1) << 5); R = (st >> 1) * 16 + swz / 64; C = (st & 1) * 32 + (swz % 64) / 2; }
__host__ __device__ __forceinline__ int perm32(int rho) { const int n = rho >> 4, i = rho & 15; return 8 * (i >> 2) + 4 * n + (i & 3); }

struct Unit { int pm, pn; };
struct Gemm { const bf16_t* A; const bf16_t* Bt; int M, N, K; };

struct StaticOrder {
    int nM, nN, nwg, G, c;
    __host__ __device__ void init(int M, int N, int G_, int c_) { nM = M / BM; nN = N / BM; nwg = nM * nN; G = G_; c = c_; }
    __host__ __device__ bool next(int i, Unit& u) const {
        const long L = (long)i * G + c; if (L >= nwg) return false;
        int wgid = (int)L; { const int q = nwg / NXCD, r = nwg % NXCD, xcd = wgid % NXCD, off = wgid / NXCD; wgid = (xcd < r ? xcd * (q + 1) : r * (q + 1) + (xcd - r) * q) + off; }
        const int nig = WGM * nN, gid = wgid / nig, fm = gid * WGM, gsz = (nM - fm) < WGM ? (nM - fm) : WGM;
        u.pm = fm + ((wgid % nig) % gsz); u.pn = (wgid % nig) / gsz; return true;
    }
    __device__ __forceinline__ void a_ready(const Unit&) const {}
    __device__ __forceinline__ void done(const Unit&) const {}
};
typedef __bf16 bf16v2_t __attribute__((ext_vector_type(2)));
typedef float f32v2_t __attribute__((ext_vector_type(2)));
__device__ __forceinline__ unsigned cvt_pk_bf16(float lo, float hi) { const bf16v2_t r = __builtin_convertvector((f32v2_t){lo, hi}, bf16v2_t); return __builtin_bit_cast(unsigned, r); }
template <class Epi, class Sched, bool STAMP = false>
__device__ __forceinline__ void gemm_phase(PG8_LAS unsigned char* lds, const Gemm g, const Sched& S, const Epi& E, unsigned long long* stamps) {
    const int tid = threadIdx.x, wid = __builtin_amdgcn_readfirstlane(tid >> 6), lane = tid & 63, wr = wid >> 2, wc = wid & 3, fr = lane & 15, fq = lane >> 4;
    const int K = g.K, nt = K / BK;
    int ts_lo = 0, ts_hi = 0, nts = 0; const unsigned long long rt_entry = STAMP ? (unsigned long long)wall_clock64() : 0ull;
#define PG8_STAMP() do { if (STAMP && wid == 0 && nts < 64) { const unsigned long long _c = (unsigned long long)clock64(); \
        ts_lo = (lane == nts) ? (int)(unsigned)_c : ts_lo; ts_hi = (lane == nts) ? (int)(unsigned)(_c >> 32) : ts_hi; ++nts; } } while (0)
    PG8_STAMP();
    unsigned voffA[2], voffB[2];
#pragma unroll
    for (int i = 0; i < 2; ++i) { int R, C; stage_rc(tid * 16 + i * 8192, R, C); const int Rb = Epi::PERM ? ((R & ~31) + perm32(R & 31)) : R;
        voffA[i] = (unsigned)(R * K + C) * 2u; voffB[i] = (unsigned)(Rb * K + C) * 2u; }
    const size_t kstep = (size_t)(BK * 2);
    const size_t hstep = (size_t)HALF * K * 2;
    const size_t tstep = 2 * hstep;
    const unsigned ldsw = (unsigned)wid * 1024u;
    const int aoff = lds_byte(wr * 64 + fr, fq * 8), boff = lds_byte(wc * 32 + fr, fq * 8);
#define PG8_SA(b, h) (((b) * 2 + (h)) * HTB)
#define PG8_SB(b, h) ((4 + (b) * 2 + (h)) * HTB)
#define PG8_STAGE(bufoff, gbase, voff) do { _Pragma("unroll") for (int _i = 0; _i < 2; ++_i) \
        __builtin_amdgcn_global_load_lds((const unsigned*)((const char*)(gbase) + (voff)[_i]), (PG8_LAS unsigned*)(lds + (bufoff) + ldsw + _i * 8192), 16, 0, 0); } while (0)
#define PG8_LDA(dst, b, h) do { _Pragma("unroll") for (int m = 0; m < 4; ++m) _Pragma("unroll") for (int k = 0; k < 2; ++k) dst[m][k] = *(const PG8_LAS bf16x8*)(lds + PG8_SA(b, h) + aoff + m * 2048 + k * 1024); } while (0)
#define PG8_LDB(dst, b, h) do { _Pragma("unroll") for (int n = 0; n < 2; ++n) _Pragma("unroll") for (int k = 0; k < 2; ++k) dst[n][k] = *(const PG8_LAS bf16x8*)(lds + PG8_SB(b, h) + boff + n * 2048 + k * 1024); } while (0)
#define PG8_MMA(ai, bj, At, Bt) do { __builtin_amdgcn_s_setprio(1); _Pragma("unroll") for (int m = 0; m < 4; ++m) _Pragma("unroll") for (int n = 0; n < 2; ++n) _Pragma("unroll") for (int k = 0; k < 2; ++k) \
        acc[ai][bj][m][n] = __builtin_amdgcn_mfma_f32_16x16x32_bf16(Bt[n][k], At[m][k], acc[ai][bj][m][n], 0, 0, 0); __builtin_amdgcn_s_setprio(0); } while (0)
#define PG8_WAIT_V(n) asm volatile("s_waitcnt vmcnt(" #n ")" ::: "memory")
#define PG8_WAIT_L(n) asm volatile("s_waitcnt lgkmcnt(" #n ")" ::: "memory")
#define PG8_BAR __builtin_amdgcn_s_barrier()
#define PG8_SCHED __builtin_amdgcn_sched_barrier(0)
    Unit cur, nxt; int ui = 0;
    if (!S.next(0, cur)) return;
    f32x4 acc[2][2][4][2];
#pragma unroll
    for (int a = 0; a < 2; ++a)
#pragma unroll
        for (int b = 0; b < 2; ++b)
#pragma unroll
            for (int m = 0; m < 4; ++m)
#pragma unroll
                for (int n = 0; n < 2; ++n) acc[a][b][m][n] = (f32x4){0.f, 0.f, 0.f, 0.f};
    bf16x8 At[4][2], B0[2][2], B1[2][2];
    const char* cA = (const char*)g.A + (size_t)cur.pm * tstep; const char* cB = (const char*)g.Bt + (size_t)cur.pn * tstep;
    S.a_ready(cur);
    PG8_STAGE(PG8_SB(0, 0), cB, voffB); PG8_STAGE(PG8_SA(0, 0), cA, voffA); PG8_STAGE(PG8_SB(0, 1), cB + hstep, voffB); PG8_STAGE(PG8_SA(0, 1), cA + hstep, voffA);
    if (wr == 1) PG8_BAR;
    PG8_WAIT_V(4); PG8_BAR;
    PG8_STAGE(PG8_SB(1, 0), cB + kstep, voffB); PG8_STAGE(PG8_SA(1, 0), cA + kstep, voffA); PG8_STAGE(PG8_SB(1, 1), cB + hstep + kstep, voffB);
    PG8_WAIT_V(6); PG8_BAR;
    PG8_STAMP();
    for (;;) {
        const bool has_next = S.next(ui + 1, nxt);
        const char* nA = has_next ? (const char*)g.A + (size_t)nxt.pm * tstep : cA; const char* nB = has_next ? (const char*)g.Bt + (size_t)nxt.pn * tstep : cB;
        for (int t = 0; t < nt; t += 2) {
            const bool last = (t == nt - 2);
            const char* a1 = cA + (size_t)(t + 1) * kstep;
            const char* a2 = last ? nA : cA + (size_t)(t + 2) * kstep; const char* b2 = last ? nB : cB + (size_t)(t + 2) * kstep;
            const char* a3 = a2 + kstep; const char* b3 = b2 + kstep;
            if (last && has_next) S.a_ready(nxt);
            PG8_LDB(B0, 0, 0); PG8_SCHED; PG8_LDA(At, 0, 0); PG8_STAGE(PG8_SA(1, 1), a1 + hstep, voffA);
            PG8_WAIT_L(8); PG8_BAR; PG8_WAIT_L(0); PG8_MMA(0, 0, At, B0); PG8_BAR; PG8_SCHED;
            PG8_LDB(B1, 0, 1); PG8_STAGE(PG8_SB(0, 0), b2, voffB);
            PG8_BAR; PG8_WAIT_L(0); PG8_MMA(0, 1, At, B1); PG8_BAR;
            PG8_LDA(At, 0, 1); PG8_STAGE(PG8_SA(0, 0), a2, voffA);
            PG8_BAR; PG8_WAIT_L(0); PG8_MMA(1, 0, At, B0); PG8_BAR; PG8_SCHED;
            PG8_STAGE(PG8_SB(0, 1), b2 + hstep, voffB);
            PG8_WAIT_V(6); PG8_BAR; PG8_MMA(1, 1, At, B1); PG8_BAR;
            PG8_LDB(B0, 1, 0); PG8_SCHED; PG8_LDA(At, 1, 0); PG8_STAGE(PG8_SA(0, 1), a2 + hstep, voffA);
            PG8_WAIT_L(8); PG8_BAR; PG8_WAIT_L(0); PG8_MMA(0, 0, At, B0); PG8_BAR; PG8_SCHED;
            PG8_LDB(B1, 1, 1); PG8_STAGE(PG8_SB(1, 0), b3, voffB);
            PG8_BAR; PG8_WAIT_L(0); PG8_MMA(0, 1, At, B1); PG8_BAR;
            PG8_LDA(At, 1, 1); PG8_STAGE(PG8_SA(1, 0), a3, voffA);
            PG8_BAR; PG8_WAIT_L(0); PG8_MMA(1, 0, At, B0); PG8_BAR; PG8_SCHED;
            PG8_STAGE(PG8_SB(1, 1), b3 + hstep, voffB);
            PG8_WAIT_V(6); PG8_BAR; PG8_MMA(1, 1, At, B1); PG8_BAR;
        }
        PG8_STAMP();
        if constexpr (!Epi::AFTER_DRAIN) { E(acc, cur, wr, wc, fr, fq); S.done(cur); }
        PG8_STAMP();
        if (!has_next) break;
#pragma unroll
        for (int a = 0; a < 2; ++a)
#pragma unroll
            for (int b = 0; b < 2; ++b)
#pragma unroll
                for (int m = 0; m < 4; ++m)
#pragma unroll
                    for (int n = 0; n < 2; ++n) acc[a][b][m][n] = (f32x4){0.f, 0.f, 0.f, 0.f};
        cur = nxt; cA = nA; cB = nB; ++ui;
    }
    PG8_WAIT_V(0);
    if (wr == 0) PG8_BAR;
    PG8_BAR;
    if constexpr (Epi::AFTER_DRAIN) { E.fused(acc, cur, wr, wc, fr, fq, lds, wid, lane); S.done(cur); }
    PG8_STAMP();
    if (STAMP && wid == 0) { stamps[lane] = lane < nts ? (((unsigned long long)(unsigned)ts_hi << 32) | (unsigned)ts_lo) : 0ull;
        if (lane == 62) stamps[62] = rt_entry; if (lane == 63) stamps[63] = (unsigned long long)wall_clock64(); }
#undef PG8_STAMP
#undef PG8_SA
#undef PG8_SB
#undef PG8_STAGE
#undef PG8_LDA
#undef PG8_LDB
#undef PG8_MMA
#undef PG8_WAIT_V
#undef PG8_WAIT_L
#undef PG8_BAR
#undef PG8_SCHED
}
}

namespace cg = cooperative_groups;
using pg8::bf16_t; using pg8::bf16x8; using pg8::f32x4; using pg8::u32x4; using pg8::Unit; using pg8::cvt_pk_bf16;
typedef unsigned u32x2 __attribute__((ext_vector_type(2)));
#define LAS __attribute__((address_space(3)))
#define LBAR() do { asm volatile("s_waitcnt lgkmcnt(0)" ::: "memory"); __builtin_amdgcn_s_barrier(); asm volatile("" ::: "memory"); } while (0)

constexpr int D = 1024, TSEQ = 2048, NB = 8, MP = NB * TSEQ, MS = 128, MT = MP + MS;
constexpr int RW = 512, NH = 8, SW = 1664, NZ = 4224, NZP = 4352, DP = 256;
constexpr int ZC_S = 2048, ZC_GR = 3712;
constexpr int LDS_BYTES = 159744;

constexpr size_t OFF_WIN = 0;
constexpr size_t OFF_WOUT = OFF_WIN + (size_t)NZP * D * 2;
constexpr size_t OFF_WPG = OFF_WOUT + (size_t)D * D * 2;
constexpr size_t OFF_WPP = OFF_WPG + (size_t)D * D * 2;
constexpr size_t OFF_WUP = OFF_WPP + (size_t)D * DP * 2;
constexpr size_t OFF_AUP = OFF_WUP + (size_t)RW * 64 * 2;
constexpr size_t OFF_RS = OFF_AUP + (size_t)RW * 64 * 2;
constexpr size_t OFF_PB = OFF_RS + (size_t)16640 * 4;
constexpr size_t OFF_Z = OFF_PB + (size_t)MT * DP * 2;
constexpr size_t OFF_SCN = OFF_Z + (size_t)MT * NZ * 2;
constexpr size_t OFF_BAR = OFF_SCN + (size_t)MT * NH * 384 * 2;
constexpr size_t WS_END = OFF_BAR + 16384;
constexpr size_t OFF_H1B = OFF_Z;
constexpr size_t OFF_PPB = OFF_H1B + (size_t)MT * D * 2;
constexpr size_t OFF_H2B = OFF_PPB + (size_t)MT * D * 2;
static_assert(OFF_H2B + (size_t)MT * D * 2 <= OFF_SCN, "overlay");
constexpr size_t PPD_OFF = (size_t)MT * D * 2;
constexpr size_t OFF_CHK = OFF_SCN;
constexpr size_t OFF_SALL = OFF_CHK + (size_t)2048 * 16384 * 2;
constexpr size_t OFF_OS = OFF_SALL + (size_t)2048 * 4096 * 2;
constexpr size_t OFF_SCNS = OFF_OS + (size_t)128 * 512 * 2;
constexpr size_t OFF_RK = OFF_SCNS + (size_t)MS * NH * 384 * 2;
static_assert(OFF_RK + (size_t)2048 * 64 * 4 <= OFF_BAR, "overlay");
constexpr size_t O_Y = 0, O_CONVP = (size_t)MT * D, O_SHIFTP = O_CONVP + 8 * 2 * 512, O_WKVP = O_SHIFTP + 8 * SW,
                 O_CONVS = O_WKVP + 8 * 8 * 64 * 64, O_SHIFTS = O_CONVS + 128 * 2 * 512, O_WKVS = O_SHIFTS + 128 * SW;

struct Args { const float* in[24]; float* out; unsigned char* ws; int ph_lo, ph_hi; };

__device__ __forceinline__ float bf2f(unsigned short b) { return __uint_as_float(((unsigned)b) << 16); }
__device__ __forceinline__ float bflo(unsigned w) { return __uint_as_float(w << 16); }
__device__ __forceinline__ float bfhi(unsigned w) { return __uint_as_float(w & 0xffff0000u); }
__device__ __forceinline__ unsigned short f2bf(float f) { return (unsigned short)(cvt_pk_bf16(f, 0.f) & 0xffffu); }
__device__ __forceinline__ void unpack8(const u32x4 q, float (&f)[8]) {
    f[0] = bflo(q.x); f[1] = bfhi(q.x); f[2] = bflo(q.y); f[3] = bfhi(q.y); f[4] = bflo(q.z); f[5] = bfhi(q.z); f[6] = bflo(q.w); f[7] = bfhi(q.w); }
__device__ __forceinline__ void unpack4(const u32x2 q, float (&f)[4]) { f[0] = bflo(q.x); f[1] = bfhi(q.x); f[2] = bflo(q.y); f[3] = bfhi(q.y); }
__device__ __forceinline__ u32x4 pack8(const float (&f)[8]) { u32x4 q; q.x = cvt_pk_bf16(f[0], f[1]); q.y = cvt_pk_bf16(f[2], f[3]); q.z = cvt_pk_bf16(f[4], f[5]); q.w = cvt_pk_bf16(f[6], f[7]); return q; }
__device__ __forceinline__ u32x2 pack4(float a, float b, float c, float d) { u32x2 q; q.x = cvt_pk_bf16(a, b); q.y = cvt_pk_bf16(c, d); return q; }
__device__ __forceinline__ float sigmoidf_(float x) { return __builtin_amdgcn_rcpf(1.0f + __expf(-x)); }
__device__ __forceinline__ float siluf_(float x) { return x * __builtin_amdgcn_rcpf(1.0f + __expf(-x)); }
template <int CTRL> __device__ __forceinline__ float dppf(float x) { return __int_as_float(__builtin_amdgcn_update_dpp(0, __float_as_int(x), CTRL, 0xf, 0xf, false)); }
__device__ __forceinline__ float rowsum16(float x) { x += dppf<0x128>(x); x += dppf<0x124>(x); x += dppf<0x122>(x); x += dppf<0x121>(x); return x; }

__device__ __forceinline__ f32x4 mini_tile(const bf16_t* arow, const bf16_t* brow, int K, int fq) {
    f32x4 acc = {0.f, 0.f, 0.f, 0.f};
    const bf16_t* ap = arow + fq * 8; const bf16_t* bp = brow + fq * 8;
    for (int k0 = 0; k0 < K; k0 += 256) {
        bf16x8 av[8], bv[8];
#pragma unroll
        for (int j = 0; j < 8; ++j) { av[j] = *(const bf16x8*)(ap + k0 + j * 32); bv[j] = *(const bf16x8*)(bp + k0 + j * 32); }
#pragma unroll
        for (int j = 0; j < 8; ++j) acc = __builtin_amdgcn_mfma_f32_16x16x32_bf16(bv[j], av[j], acc, 0, 0, 0);
    }
    return acc;
}

template <int NSTEP> __device__ __forceinline__ f32x4 mini_tile_k(const bf16_t* arow, const bf16_t* brow, int fq) {
    f32x4 acc = {0.f, 0.f, 0.f, 0.f};
    bf16x8 av[NSTEP], bv[NSTEP];
#pragma unroll
    for (int j = 0; j < NSTEP; ++j) { av[j] = *(const bf16x8*)(arow + fq * 8 + j * 32); bv[j] = *(const bf16x8*)(brow + fq * 8 + j * 32); }
#pragma unroll
    for (int j = 0; j < NSTEP; ++j) acc = __builtin_amdgcn_mfma_f32_16x16x32_bf16(bv[j], av[j], acc, 0, 0, 0);
    return acc;
}
__device__ __forceinline__ f32x4 splitk_reduce(LAS unsigned char* lds, f32x4 acc, int wave, int lane) {
    LAS f32x4* red = (LAS f32x4*)lds;
    __syncthreads();
    red[wave * 64 + lane] = acc;
    __syncthreads();
    if ((wave & 3) == 0) acc = (acc + red[(wave + 1) * 64 + lane]) + (red[(wave + 2) * 64 + lane] + red[(wave + 3) * 64 + lane]);
    return acc;
}

struct EpiZ {
    static constexpr bool PERM = true, AFTER_DRAIN = false;
    bf16_t* Z; const float* rs;
    __device__ __forceinline__ void operator()(const f32x4 (&acc)[2][2][4][2], const Unit& u, int wr, int wc, int fr, int fq) const {
        const int row0 = u.pm * 256 + wr * 64 + fr, col0 = u.pn * 256 + wc * 32 + 8 * fq;
        float sc[2][4];
#pragma unroll
        for (int ai = 0; ai < 2; ++ai)
#pragma unroll
            for (int m = 0; m < 4; ++m) sc[ai][m] = rs[row0 + ai * 128 + m * 16];
#pragma unroll
        for (int ai = 0; ai < 2; ++ai)
#pragma unroll
            for (int m = 0; m < 4; ++m) { const int row = row0 + ai * 128 + m * 16; const float s = sc[ai][m]; bf16_t* rp = Z + (size_t)row * NZ + col0;
#pragma unroll
                for (int bj = 0; bj < 2; ++bj) { if (col0 + bj * 128 < NZ && row < MT) { const f32x4 v0 = acc[ai][bj][m][0] * s, v1 = acc[ai][bj][m][1] * s; u32x4 w;
                    w.x = cvt_pk_bf16(v0[0], v0[1]); w.y = cvt_pk_bf16(v0[2], v0[3]); w.z = cvt_pk_bf16(v1[0], v1[1]); w.w = cvt_pk_bf16(v1[2], v1[3]); *(u32x4*)(rp + bj * 128) = w; } } }
    }
};
struct EpiH1 {
    static constexpr bool PERM = true, AFTER_DRAIN = false;
    const float* x; bf16_t* H1B;
    __device__ __forceinline__ void operator()(const f32x4 (&acc)[2][2][4][2], const Unit& u, int wr, int wc, int fr, int fq) const {
        const int row0 = u.pm * 256 + wr * 64 + fr, col0 = u.pn * 256 + wc * 32 + 8 * fq;
#pragma unroll
        for (int ai = 0; ai < 2; ++ai)
#pragma unroll
            for (int mp = 0; mp < 2; ++mp) {
                f32x4 xv[2][2][2];
#pragma unroll
                for (int mm = 0; mm < 2; ++mm)
#pragma unroll
                    for (int bj = 0; bj < 2; ++bj) { const size_t o = (size_t)(row0 + ai * 128 + (mp * 2 + mm) * 16) * D + col0 + bj * 128; xv[mm][bj][0] = *(const f32x4*)(x + o); xv[mm][bj][1] = *(const f32x4*)(x + o + 4); }
#pragma unroll
                for (int mm = 0; mm < 2; ++mm)
#pragma unroll
                    for (int bj = 0; bj < 2; ++bj) { const int m = mp * 2 + mm; const size_t o = (size_t)(row0 + ai * 128 + m * 16) * D + col0 + bj * 128;
                        const f32x4 v0 = xv[mm][bj][0] + acc[ai][bj][m][0], v1 = xv[mm][bj][1] + acc[ai][bj][m][1]; u32x4 w;
                        w.x = cvt_pk_bf16(v0[0], v0[1]); w.y = cvt_pk_bf16(v0[2], v0[3]); w.z = cvt_pk_bf16(v1[0], v1[1]); w.w = cvt_pk_bf16(v1[2], v1[3]); *(u32x4*)(H1B + o) = w; }
                asm volatile("" ::: "memory"); }
    }
};
struct EpiF32 {
    static constexpr bool PERM = true, AFTER_DRAIN = false;
    bf16_t* C;
    __device__ __forceinline__ void operator()(const f32x4 (&acc)[2][2][4][2], const Unit& u, int wr, int wc, int fr, int fq) const {
        const int row0 = u.pm * 256 + wr * 64 + fr, col0 = u.pn * 256 + wc * 32 + 8 * fq;
#pragma unroll
        for (int ai = 0; ai < 2; ++ai)
#pragma unroll
            for (int m = 0; m < 4; ++m) { const size_t off = (size_t)(row0 + ai * 128 + m * 16) * D + col0;
#pragma unroll
                for (int bj = 0; bj < 2; ++bj) { const f32x4 v0 = acc[ai][bj][m][0], v1 = acc[ai][bj][m][1]; u32x4 w;
                    w.x = cvt_pk_bf16(v0[0], v0[1]); w.y = cvt_pk_bf16(v0[2], v0[3]); w.z = cvt_pk_bf16(v1[0], v1[1]); w.w = cvt_pk_bf16(v1[2], v1[3]); *(u32x4*)(C + off + bj * 128) = w; } }
    }
};
struct EpiH2 {
    static constexpr bool PERM = true, AFTER_DRAIN = false;
    const bf16_t* H1; const bf16_t* PP; bf16_t* out;
    __device__ __forceinline__ void operator()(const f32x4 (&acc)[2][2][4][2], const Unit& u, int wr, int wc, int fr, int fq) const {
        const int row0 = u.pm * 256 + wr * 64 + fr, col0 = u.pn * 256 + wc * 32 + 8 * fq;
#pragma unroll
        for (int ai = 0; ai < 2; ++ai)
#pragma unroll
            for (int mp = 0; mp < 2; ++mp) {
                u32x4 qh[2][2], qp[2][2];
#pragma unroll
                for (int mm = 0; mm < 2; ++mm)
#pragma unroll
                    for (int bj = 0; bj < 2; ++bj) { const size_t o = (size_t)(row0 + ai * 128 + (mp * 2 + mm) * 16) * D + col0 + bj * 128; qh[mm][bj] = *(const u32x4*)(H1 + o); qp[mm][bj] = *(const u32x4*)(PP + o); }
#pragma unroll
                for (int mm = 0; mm < 2; ++mm)
#pragma unroll
                    for (int bj = 0; bj < 2; ++bj) { const int m = mp * 2 + mm; const size_t o = (size_t)(row0 + ai * 128 + m * 16) * D + col0 + bj * 128; float h[8], p[8]; unpack8(qh[mm][bj], h); unpack8(qp[mm][bj], p);
                        const f32x4 g0 = acc[ai][bj][m][0], g1 = acc[ai][bj][m][1]; f32x4 v0, v1;
#pragma unroll
                        for (int e = 0; e < 4; ++e) { v0[e] = h[e] + sigmoidf_(g0[e]) * p[e]; v1[e] = h[4 + e] + sigmoidf_(g1[e]) * p[4 + e]; }
                        u32x4 w; w.x = cvt_pk_bf16(v0[0], v0[1]); w.y = cvt_pk_bf16(v0[2], v0[3]); w.z = cvt_pk_bf16(v1[0], v1[1]); w.w = cvt_pk_bf16(v1[2], v1[3]); *(u32x4*)(out + o) = w; }
                asm volatile("" ::: "memory"); }
    }
};

struct P0Job { const float* src; bf16_t* dst; const float* gsc; int K, N, k0, n0; };
__device__ __forceinline__ P0Job p0_decode(const Args& a, int job) {
    constexpr int NJ_IN = 16 * 68, NJ_SQ = 256, NJ_PP = 64, NJ_LO = 8;
    unsigned char* ws = a.ws; P0Job J; J.gsc = nullptr; int kt, nt; int j = job;
    if (j < NJ_IN) { J.src = a.in[8]; J.dst = (bf16_t*)(ws + OFF_WIN); J.gsc = a.in[7]; J.K = 1024; J.N = NZ; kt = j & 15; nt = j >> 4; }
    else if ((j -= NJ_IN) < NJ_SQ) { J.src = a.in[20]; J.dst = (bf16_t*)(ws + OFF_WOUT); J.K = 1024; J.N = 1024; kt = j & 15; nt = j >> 4; }
    else if ((j -= NJ_SQ) < NJ_SQ) { J.src = a.in[21]; J.dst = (bf16_t*)(ws + OFF_WPG); J.K = 1024; J.N = 1024; kt = j & 15; nt = j >> 4; }
    else if ((j -= NJ_SQ) < NJ_PP) { J.src = a.in[22]; J.dst = (bf16_t*)(ws + OFF_WPP); J.K = 256; J.N = 1024; kt = j & 3; nt = j >> 2; }
    else if ((j -= NJ_PP) < NJ_LO) { J.src = a.in[12]; J.dst = (bf16_t*)(ws + OFF_WUP); J.K = 64; J.N = 512; kt = 0; nt = j; }
    else { j -= NJ_LO; J.src = a.in[14]; J.dst = (bf16_t*)(ws + OFF_AUP); J.K = 64; J.N = 512; kt = 0; nt = j; }
    J.k0 = kt * 64; J.n0 = nt * 64; return J;
}
__device__ void p0_prep(const Args& a, LAS unsigned char* lds) {
    const int tid = threadIdx.x, G = gridDim.x, blk = blockIdx.x, wave = tid >> 6, lane = tid & 63;
    LAS float* tile = (LAS float*)lds;
    unsigned char* ws = a.ws;
    constexpr int NJOBS = 16 * 68 + 2 * 256 + 64 + 2 * 8, MAXJ = 7;
    const int li = tid >> 4, lj = (tid & 15) * 4;
    for (int base = blk; base < NJOBS; base += G * MAXJ) {
        f32x4 v[MAXJ][2];
#pragma unroll
        for (int sl = 0; sl < MAXJ; ++sl) { const int job = base + sl * G;
            if (job < NJOBS) { const P0Job J = p0_decode(a, job);
#pragma unroll
                for (int q = 0; q < 2; ++q) { const int i = li + 32 * q; f32x4 x = {0.f, 0.f, 0.f, 0.f};
                    if (J.n0 + lj < J.N) { x = *(const f32x4*)(J.src + (size_t)(J.k0 + i) * J.N + J.n0 + lj); if (J.gsc) x = x * J.gsc[J.k0 + i]; }
                    v[sl][q] = x; } } }
#pragma unroll
        for (int sl = 0; sl < MAXJ; ++sl) { const int job = base + sl * G;
            if (job < NJOBS) { const P0Job J = p0_decode(a, job);
#pragma unroll
                for (int q = 0; q < 2; ++q) { const int i = li + 32 * q;
#pragma unroll
                    for (int e = 0; e < 4; ++e) tile[i * 65 + lj + e] = v[sl][q][e]; }
                LBAR();
#pragma unroll
                for (int it = 0; it < 4; ++it) { const int item = it * 512 + tid, jj = item >> 5, i2 = item & 31;
                    *(unsigned*)(J.dst + (size_t)(J.n0 + jj) * J.K + J.k0 + 2 * i2) = cvt_pk_bf16(tile[(2 * i2) * 65 + jj], tile[(2 * i2 + 1) * 65 + jj]); }
                LBAR(); } }
    }
    bf16_t* XB = (bf16_t*)a.out; float* RS = (float*)(ws + OFF_RS);
    for (int row0 = (blk * 8 + wave) * 2; row0 < MT; row0 += G * 16) {
        f32x4 v[2][4];
#pragma unroll
        for (int r = 0; r < 2; ++r) { const int row = row0 + r; const float* src = row < MP ? a.in[0] + (size_t)row * D : a.in[1] + (size_t)(row - MP) * D;
#pragma unroll
            for (int i = 0; i < 4; ++i) v[r][i] = *(const f32x4*)(src + i * 256 + lane * 4); }
#pragma unroll
        for (int r = 0; r < 2; ++r) { const int row = row0 + r; float ss = 0.f;
#pragma unroll
            for (int i = 0; i < 4; ++i) { const f32x4 x = v[r][i]; ss += x[0] * x[0] + x[1] * x[1] + x[2] * x[2] + x[3] * x[3];
                *(u32x2*)(XB + (size_t)row * D + i * 256 + lane * 4) = pack4(x[0], x[1], x[2], x[3]); }
#pragma unroll
            for (int o = 32; o >= 1; o >>= 1) ss += __shfl_xor(ss, o);
            if (lane == 0) RS[row] = rsqrtf(ss * (1.0f / D) + 1e-6f); }
    }
    bf16_t* PB = (bf16_t*)(ws + OFF_PB);
    constexpr size_t NP4 = (size_t)MT * DP / 4;
    for (size_t i0 = (size_t)blk * 512 + tid; i0 < NP4; i0 += (size_t)G * 512 * 4) {
        f32x4 v[4];
#pragma unroll
        for (int u = 0; u < 4; ++u) { const size_t i = i0 + (size_t)u * G * 512; const size_t e = i * 4;
            if (i < NP4) v[u] = e < (size_t)MP * DP ? *(const f32x4*)(a.in[2] + e) : *(const f32x4*)(a.in[3] + (e - (size_t)MP * DP)); }
#pragma unroll
        for (int u = 0; u < 4; ++u) { const size_t i = i0 + (size_t)u * G * 512; if (i < NP4) *(u32x2*)(PB + i * 4) = pack4(v[u][0], v[u][1], v[u][2], v[u][3]); }
    }
}

__device__ void p1_gemm_in(const Args& a, LAS unsigned char* lds) {
    const int tid = threadIdx.x, G = gridDim.x, blk = blockIdx.x, wave = tid >> 6, lane = tid & 63, fr = lane & 15, fq = lane >> 4;
    unsigned char* ws = a.ws;
    const bf16_t* XB = (const bf16_t*)a.out; const bf16_t* WinT = (const bf16_t*)(ws + OFF_WIN); const float* RS = (const float*)(ws + OFF_RS); bf16_t* Z = (bf16_t*)(ws + OFF_Z);
    {
        pg8::Gemm g{XB, WinT, MP + 256, NZP, D}; pg8::StaticOrder S; S.init(MP + 256, NZP, G, blk); EpiZ E{Z, RS};
        pg8::gemm_phase<EpiZ, pg8::StaticOrder>(lds, g, S, E, nullptr);
    }
    const bool r256 = (G == 256);
    if (!r256 || blk >= 81) {
        const bf16_t* PB = (const bf16_t*)(ws + OFF_PB); const bf16_t* WppT = (const bf16_t*)(ws + OFF_WPP); bf16_t* PP = (bf16_t*)((unsigned char*)a.out + PPD_OFF);
        pg8::Gemm g{PB, WppT, MP, D, DP}; pg8::StaticOrder S; S.init(MP, D, r256 ? 175 : G, r256 ? blk - 81 : blk); EpiF32 E{PP};
        pg8::gemm_phase<EpiF32, pg8::StaticOrder>(lds, g, S, E, nullptr);
    }
}

template <bool smp> __device__ void p2_tile(const Args& a, LAS unsigned char* lds, int tile) {
    const int tid = threadIdx.x, wave = tid >> 6, lane = tid & 63, fr = lane & 15, fq = lane >> 4;
    unsigned char* ws = a.ws;
    const int ntok = smp ? 8 : 64;
    const int m0 = smp ? MP + (tile - 256) * 8 : tile * 64;
    const int t0 = smp ? 0 : (tile & 31) * 64;
    const int bidx = tile >> 5;
    const bf16_t* __restrict__ Z = (const bf16_t*)(ws + OFF_Z); bf16_t* __restrict__ YC = (bf16_t*)a.out; bf16_t* __restrict__ SCN = (bf16_t*)(ws + OFF_SCNS) - (size_t)MP * 8 * 384;
    const float* state_conv = a.in[4]; const float* state_shift = a.in[5]; const float* conv_w = a.in[9]; const float* mu = a.in[10];
    {
        const int c0 = (tid & 63) * 8;
        float cw0[8], cw1[8], cw2[8];
#pragma unroll
        for (int i = 0; i < 8; ++i) { cw0[i] = conv_w[c0 + i]; cw1[i] = conv_w[512 + c0 + i]; cw2[i] = conv_w[1024 + c0 + i]; }
#pragma unroll 2
        for (int tok = tid >> 6; tok < ntok; tok += 8) {
            const int m = m0 + tok, t = t0 + tok;
            const bf16_t* zr = Z + (size_t)m * NZ;
            float fB[8], fC[8], fH[8], fG[8], u0[8], u1[8], u2[8];
            const u32x4 qB = *(const u32x4*)(zr + c0), qC = *(const u32x4*)(zr + 512 + c0), qH = *(const u32x4*)(zr + 1024 + c0), qG = *(const u32x4*)(zr + 1536 + c0);
            if (smp) {
                const float* sc = state_conv + (size_t)(m - MP) * 1024 + c0;
                const f32x4 x0 = *(const f32x4*)(sc), x1 = *(const f32x4*)(sc + 4), y0 = *(const f32x4*)(sc + 512), y1 = *(const f32x4*)(sc + 516);
#pragma unroll
                for (int i = 0; i < 4; ++i) { u2[i] = x0[i]; u2[4 + i] = x1[i]; u1[i] = y0[i]; u1[4 + i] = y1[i]; }
            } else {
                const bf16_t* z1 = t >= 1 ? zr - NZ : zr; const bf16_t* z2 = t >= 2 ? zr - 2 * NZ : zr;
                const u32x4 qC1 = *(const u32x4*)(z1 + 512 + c0), qH1 = *(const u32x4*)(z1 + 1024 + c0), qC2 = *(const u32x4*)(z2 + 512 + c0), qH2 = *(const u32x4*)(z2 + 1024 + c0);
                float c1[8], h1[8], c2[8], h2[8]; unpack8(qC1, c1); unpack8(qH1, h1); unpack8(qC2, c2); unpack8(qH2, h2);
                const float f1 = t >= 1 ? 1.f : 0.f, f2 = t >= 2 ? 1.f : 0.f;
#pragma unroll
                for (int i = 0; i < 8; ++i) { u1[i] = c1[i] * h1[i] * f1; u2[i] = c2[i] * h2[i] * f2; }
            }
            unpack8(qB, fB); unpack8(qC, fC); unpack8(qH, fH); unpack8(qG, fG);
            float y[8];
#pragma unroll
            for (int i = 0; i < 8; ++i) { u0[i] = fC[i] * fH[i]; const float cv = cw0[i] * u2[i] + cw1[i] * u1[i] + cw2[i] * u0[i]; y[i] = fB[i] * cv * siluf_(fG[i]); }
            *(u32x4*)(YC + (size_t)m * D + c0) = pack8(y);
            if (smp) { float gr[8]; unpack8(*(const u32x4*)(zr + ZC_GR + c0), gr);
#pragma unroll
              for (int i = 0; i < 8; ++i) gr[i] = siluf_(gr[i]);
              *(u32x4*)(YC + (size_t)m * D + 512 + c0) = pack8(gr); }
            float* co = nullptr;
            if (smp) co = a.out + O_CONVS + (size_t)(m - MP) * 1024 + c0; else if (t == TSEQ - 1) co = a.out + O_CONVP + (size_t)bidx * 1024 + c0;
            if (co) {
                *(f32x4*)(co) = (f32x4){u1[0], u1[1], u1[2], u1[3]}; *(f32x4*)(co + 4) = (f32x4){u1[4], u1[5], u1[6], u1[7]};
                *(f32x4*)(co + 512) = (f32x4){u0[0], u0[1], u0[2], u0[3]}; *(f32x4*)(co + 516) = (f32x4){u0[4], u0[5], u0[6], u0[7]}; }
        }
    }
    LAS bf16_t* Awd = (LAS bf16_t*)lds; LAS bf16_t* Aad = Awd + 64 * 72;
    if (smp) {
        const int j0 = (tid & 15) * 8;
        f32x4 m0v = *(const f32x4*)(mu + 1536 + j0), m1v = *(const f32x4*)(mu + 1536 + j0 + 4);
#pragma unroll 2
        for (int tok = tid >> 4; tok < ntok; tok += 32) {
            const int m = m0 + tok;
            const bf16_t* zr = Z + (size_t)m * NZ + ZC_S + 1536 + j0;
            float cur[8], prev[8], zm[8];
            unpack8(*(const u32x4*)zr, cur);
            if (smp) { const float* sp = state_shift + (size_t)(m - MP) * SW + 1536 + j0; const f32x4 x0 = *(const f32x4*)sp, x1 = *(const f32x4*)(sp + 4);
#pragma unroll
                for (int i = 0; i < 4; ++i) { prev[i] = x0[i]; prev[4 + i] = x1[i]; } }
            else { const bool hp = (t0 + tok) >= 1; unpack8(*(const u32x4*)(hp ? zr - NZ : zr), prev);
                if (!hp) {
#pragma unroll
                    for (int i = 0; i < 8; ++i) prev[i] = 0.f; } }
#pragma unroll
            for (int i = 0; i < 8; ++i) { const float mm = i < 4 ? m0v[i] : m1v[i - 4]; zm[i] = cur[i] + (prev[i] - cur[i]) * mm; }
            if (j0 < 64) {
#pragma unroll
                for (int i = 0; i < 8; ++i) { const float e2 = __expf(2.0f * zm[i]); zm[i] = 1.0f - 2.0f * __builtin_amdgcn_rcpf(e2 + 1.0f); }
                *(LAS u32x4*)(Awd + tok * 72 + j0) = pack8(zm);
            } else *(LAS u32x4*)(Aad + tok * 72 + (j0 - 64)) = pack8(zm);
        }
    }
    __syncthreads();
    if (smp) {
        const int h = wave;
        const bf16_t* WupT = (const bf16_t*)(ws + OFF_WUP); const bf16_t* AupT = (const bf16_t*)(ws + OFF_AUP);
        const float* __restrict__ w0 = a.in[11]; const float* __restrict__ a0p = a.in[13]; const float* __restrict__ k_k = a.in[15]; const float* __restrict__ k_a = a.in[16];
        const int nmt = (ntok + 15) >> 4;
#pragma unroll 1
        for (int mt = 0; mt < nmt; ++mt) {
            u32x2 zc[4][3], zq[4][3];
            {   const int tok_ = (mt * 16 + fr) < ntok ? (mt * 16 + fr) : 0; const bf16_t* zr_ = Z + (size_t)(m0 + tok_) * NZ + ZC_S; const bf16_t* zp_ = ((!smp) && (t0 + tok_ >= 1)) ? zr_ - NZ : zr_;
#pragma unroll
                for (int nt = 0; nt < 4; ++nt) { const int c = h * 64 + nt * 16 + 4 * fq;
                    zc[nt][0] = *(const u32x2*)(zr_ + c); zc[nt][1] = *(const u32x2*)(zr_ + 512 + c); zc[nt][2] = *(const u32x2*)(zr_ + 1024 + c);
                    if (!smp) { zq[nt][0] = *(const u32x2*)(zp_ + c); zq[nt][1] = *(const u32x2*)(zp_ + 512 + c); zq[nt][2] = *(const u32x2*)(zp_ + 1024 + c); } } }
            bf16x8 aw[2], aa[2];
#pragma unroll
            for (int ks = 0; ks < 2; ++ks) { aw[ks] = *(const LAS bf16x8*)(Awd + (mt * 16 + fr) * 72 + ks * 32 + fq * 8); aa[ks] = *(const LAS bf16x8*)(Aad + (mt * 16 + fr) * 72 + ks * 32 + fq * 8); }
            f32x4 accw[4], acca[4];
#pragma unroll
            for (int nt = 0; nt < 4; ++nt) { accw[nt] = (f32x4){0.f, 0.f, 0.f, 0.f}; acca[nt] = (f32x4){0.f, 0.f, 0.f, 0.f};
#pragma unroll
                for (int ks = 0; ks < 2; ++ks) { const size_t bo = (size_t)(h * 64 + nt * 16 + fr) * 64 + ks * 32 + fq * 8;
                    accw[nt] = __builtin_amdgcn_mfma_f32_16x16x32_bf16(*(const bf16x8*)(WupT + bo), aw[ks], accw[nt], 0, 0, 0);
                    acca[nt] = __builtin_amdgcn_mfma_f32_16x16x32_bf16(*(const bf16x8*)(AupT + bo), aa[ks], acca[nt], 0, 0, 0); } }
            const bool valid = (mt * 16 + fr) < ntok;
            const int tok = valid ? (mt * 16 + fr) : 0, m = m0 + tok, t = t0 + tok;
            const bf16_t* zr = Z + (size_t)m * NZ + ZC_S;
            const bool hasprev = (!smp) && (t >= 1);
            const bf16_t* zp = hasprev ? zr - NZ : zr;
            const float fp = hasprev ? 1.f : 0.f;
            bf16_t* so = SCN + ((size_t)m * 8 + h) * 384 + 4 * fq;
            float kk[4][4], av[4][4]; float ss = 0.f;
#pragma unroll
            for (int nt = 0; nt < 4; ++nt) {
                const int c = h * 64 + nt * 16 + 4 * fq;
                float cr[4], ck[4], cv[4], pr[4], pk[4], pv[4];
                unpack4(zc[nt][0], cr); unpack4(zc[nt][1], ck); unpack4(zc[nt][2], cv);
                if (smp) { const float* sp = state_shift + (size_t)(m - MP) * SW + c; const f32x4 x0 = *(const f32x4*)sp, x1 = *(const f32x4*)(sp + 512), x2 = *(const f32x4*)(sp + 1024);
#pragma unroll
                    for (int i = 0; i < 4; ++i) { pr[i] = x0[i]; pk[i] = x1[i]; pv[i] = x2[i]; } }
                else { unpack4(zq[nt][0], pr); unpack4(zq[nt][1], pk); unpack4(zq[nt][2], pv);
#pragma unroll
                    for (int i = 0; i < 4; ++i) { pr[i] *= fp; pk[i] *= fp; pv[i] *= fp; } }
                const f32x4 mr = *(const f32x4*)(mu + c), mk = *(const f32x4*)(mu + 512 + c), mv = *(const f32x4*)(mu + 1024 + c);
                const f32x4 w0v = *(const f32x4*)(w0 + c), a0v = *(const f32x4*)(a0p + c), kkv = *(const f32x4*)(k_k + c), kav = *(const f32x4*)(k_a + c);
                float r_[4], e_[4], kp[4], v_[4];
#pragma unroll
                for (int i = 0; i < 4; ++i) {
                    r_[i] = cr[i] + (pr[i] - cr[i]) * mr[i]; const float k = ck[i] + (pk[i] - ck[i]) * mk[i]; v_[i] = cv[i] + (pv[i] - cv[i]) * mv[i];
                    e_[i] = 0.60653065971f * sigmoidf_(w0v[i] + accw[nt][i]);
                    const float al = sigmoidf_(a0v[i] + acca[nt][i]); av[nt][i] = al;
                    const float kq = k * kkv[i]; kk[nt][i] = kq; ss += kq * kq;
                    kp[i] = k * (1.0f + (al - 1.0f) * kav[i]);
                }
                if (valid) {
                *(u32x2*)(so + 0 * 64 + nt * 16) = pack4(r_[0], r_[1], r_[2], r_[3]);
                *(u32x2*)(so + 1 * 64 + nt * 16) = pack4(e_[0], e_[1], e_[2], e_[3]);
                *(u32x2*)(so + 2 * 64 + nt * 16) = pack4(kp[0], kp[1], kp[2], kp[3]);
                *(u32x2*)(so + 3 * 64 + nt * 16) = pack4(v_[0], v_[1], v_[2], v_[3]); }
            }
            ss += __shfl_xor(ss, 16); ss += __shfl_xor(ss, 32);
            const float inv = 1.0f / fmaxf(sqrtf(ss), 1e-12f);
#pragma unroll
            for (int nt = 0; nt < 4; ++nt) {
                float q[4], b[4];
#pragma unroll
                for (int i = 0; i < 4; ++i) { q[i] = kk[nt][i] * inv; b[i] = q[i] * av[nt][i]; }
                if (valid) {
                *(u32x2*)(so + 4 * 64 + nt * 16) = pack4(q[0], q[1], q[2], q[3]);
                *(u32x2*)(so + 5 * 64 + nt * 16) = pack4(b[0], b[1], b[2], b[3]); }
            }
        }
    }
    if (!smp && (tile & 31) == 31) { for (int j = tid; j < SW; j += 512) a.out[O_SHIFTP + (size_t)bidx * SW + j] = bf2f(Z[(size_t)(m0 + 63) * NZ + ZC_S + j]); }
    __syncthreads();
}
__device__ void p2_all(const Args& a, LAS unsigned char* lds) {
    const int tid = threadIdx.x, G = gridDim.x, blk = blockIdx.x;
    for (int t = blk; t < 272; t += G) { if (t < 256) p2_tile<false>(a, lds, t); else p2_tile<true>(a, lds, t); }
    const bf16_t* Z = (const bf16_t*)(a.ws + OFF_Z);
    for (int idx = blk * 512 + tid; idx < MS * SW; idx += G * 512) { const int sidx = idx / SW, j = idx - sidx * SW; a.out[O_SHIFTS + idx] = bf2f(Z[(size_t)(MP + sidx) * NZ + ZC_S + j]); }
}

constexpr int SLOT = 64 * 72;
__device__ __forceinline__ void mm_nt(const LAS bf16_t* X, const LAS bf16_t* Y, int it, int jt0, int fr, int fq, f32x4 (&acc)[2]) {
    bf16x8 xa[2];
#pragma unroll
    for (int ks = 0; ks < 2; ++ks) xa[ks] = *(const LAS bf16x8*)(X + (it * 16 + fr) * 72 + ks * 32 + fq * 8);
#pragma unroll
    for (int u = 0; u < 2; ++u)
#pragma unroll
        for (int ks = 0; ks < 2; ++ks) acc[u] = __builtin_amdgcn_mfma_f32_16x16x32_bf16(*(const LAS bf16x8*)(Y + ((jt0 + u) * 16 + fr) * 72 + ks * 32 + fq * 8), xa[ks], acc[u], 0, 0, 0);
}
__device__ __forceinline__ void mm_nt_p(const LAS bf16_t* X, const LAS bf16_t* Y, int it, int jt0, int fr, int fq, f32x4 (&acc)[2]) {
    bf16x8 xa[2];
#pragma unroll
    for (int ks = 0; ks < 2; ++ks) xa[ks] = *(const LAS bf16x8*)(X + (it * 16 + fr) * 72 + ks * 32 + fq * 8);
#pragma unroll
    for (int u = 0; u < 2; ++u) { const int yrow = jt0 * 16 + 8 * (fr >> 2) + 4 * u + (fr & 3);
#pragma unroll
        for (int ks = 0; ks < 2; ++ks) acc[u] = __builtin_amdgcn_mfma_f32_16x16x32_bf16(*(const LAS bf16x8*)(Y + yrow * 72 + ks * 32 + fq * 8), xa[ks], acc[u], 0, 0, 0); }
}
__device__ __forceinline__ void stg8(bf16_t* dst, int i, int j0, f32x4 v0, f32x4 v1) { u32x4 w; w.x = cvt_pk_bf16(v0[0], v0[1]); w.y = cvt_pk_bf16(v0[2], v0[3]); w.z = cvt_pk_bf16(v1[0], v1[1]); w.w = cvt_pk_bf16(v1[2], v1[3]); *(u32x4*)(dst + i * 64 + j0) = w; }
template <int MASK> __device__ __forceinline__ f32x4 mask4(f32x4 v, int i, int j0) {
#pragma unroll
    for (int e = 0; e < 4; ++e) { const int j = j0 + e; const bool keep = MASK == 0 ? true : MASK == 1 ? (j < i) : MASK == 2 ? (j > i) : (j <= i); v[e] = keep ? v[e] : 0.f; }
    return v;
}
__device__ __forceinline__ void st4(LAS bf16_t* dst, int i, int j0, f32x4 v) { *(LAS u32x2*)(dst + i * 72 + j0) = pack4(v[0], v[1], v[2], v[3]); }
__device__ __forceinline__ f32x4 ld4(const LAS bf16_t* src, int i, int j0) { float f[4]; unpack4(*(const LAS u32x2*)(src + i * 72 + j0), f); return (f32x4){f[0], f[1], f[2], f[3]}; }
__device__ __forceinline__ void st4t(LAS bf16_t* dst, int i, int j0, f32x4 v) {
    const unsigned lo = cvt_pk_bf16(v[0], v[1]), hi = cvt_pk_bf16(v[2], v[3]);
    dst[(j0 + 0) * 72 + i] = (bf16_t)(lo & 0xffffu); dst[(j0 + 1) * 72 + i] = (bf16_t)(lo >> 16); dst[(j0 + 2) * 72 + i] = (bf16_t)(hi & 0xffffu); dst[(j0 + 3) * 72 + i] = (bf16_t)(hi >> 16); }
__device__ __forceinline__ void stg4(bf16_t* dst, int i, int j0, f32x4 v) { *(u32x2*)(dst + i * 64 + j0) = pack4(v[0], v[1], v[2], v[3]); }
#define ZACC() do { acc[0] = (f32x4){0.f, 0.f, 0.f, 0.f}; acc[1] = (f32x4){0.f, 0.f, 0.f, 0.f}; } while (0)

__device__ void p3a_chunks(const Args& a, LAS unsigned char* lds) {
    const int tid = threadIdx.x, G = gridDim.x, blk = blockIdx.x, wave = tid >> 6, lane = tid & 63, fr = lane & 15, fq = lane >> 4;
    unsigned char* ws = a.ws;
    const bf16_t* SCN = (const bf16_t*)(ws + OFF_SCNS) - (size_t)MP * 8 * 384;
    bf16_t* CHK = (bf16_t*)(ws + OFF_CHK); const bf16_t* Z = (const bf16_t*)(ws + OFF_Z); float* RK = (float*)(ws + OFF_RK);
    const bf16_t* WupT = (const bf16_t*)(ws + OFF_WUP); const bf16_t* AupT = (const bf16_t*)(ws + OFF_AUP);
    LAS bf16_t* SL = (LAS bf16_t*)lds;
#define S_(n) (SL + (n) * SLOT)
    LAS bf16_t* zraw = S_(8);
    LAS float* tot = (LAS float*)(lds + 17 * SLOT * 2);
    LAS float* pc = tot + 512;
    LAS float* LWf = (LAS float*)(lds + 2 * SLOT * 2);
    LAS float* LAf = (LAS float*)(lds + 4 * SLOT * 2);
    const int it = wave >> 1, jt0 = (wave & 1) * 2, irow = it * 16 + fr;
    u32x4 rg[6];
#define P3A_LOAD(unit_) do { const int bh_ = (unit_) >> 5, c_ = (unit_) & 31; const int mm0 = (bh_ >> 3) * TSEQ + c_ * 64; const int hh = bh_ & 7; \
        _Pragma("unroll") for (int i = 0; i < 6; ++i) { const int p = tid + 512 * i; if (p < 65 * 40) { const int rr = p / 40, sg = p - rr * 40, seg = sg >> 3, o8 = sg & 7; \
            const int col = seg < 3 ? (ZC_S + seg * 512 + hh * 64) : (ZC_S + 1536 + (seg - 3) * 64); const int mrow = (rr == 0 && c_ == 0) ? mm0 : (mm0 - 1 + rr); \
            rg[i] = *(const u32x4*)(Z + (size_t)mrow * NZ + col + o8 * 8); } } } while (0)
    if (blk < 2048) P3A_LOAD(blk);
    int hcur = -1;
    float mur = 0.f, muk = 0.f, muv = 0.f, muwd = 0.f, muad = 0.f, w0k = 0.f, a0k = 0.f, kkk = 0.f, kak = 0.f, rkk = 0.f;
    for (int unit = blk; unit < 2048; unit += G) {
        const int h = (unit >> 5) & 7, c = unit & 31, k = tid & 63, g = tid >> 6;
        if (h != hcur) {
            const float* mu = a.in[10];
            mur = mu[h * 64 + k]; muk = mu[512 + h * 64 + k]; muv = mu[1024 + h * 64 + k]; muwd = mu[1536 + k]; muad = mu[1600 + k];
            w0k = a.in[11][h * 64 + k]; a0k = a.in[13][h * 64 + k]; kkk = a.in[15][h * 64 + k]; kak = a.in[16][h * 64 + k]; rkk = a.in[17][h * 64 + k];
            const int row = tid >> 3, o8 = tid & 7;
            *(LAS u32x4*)(S_(15) + row * 72 + o8 * 8) = *(const u32x4*)(WupT + (size_t)(h * 64 + row) * 64 + o8 * 8);
            *(LAS u32x4*)(S_(16) + row * 72 + o8 * 8) = *(const u32x4*)(AupT + (size_t)(h * 64 + row) * 64 + o8 * 8);
            hcur = h; }
#pragma unroll
        for (int i = 0; i < 6; ++i) { const int p = tid + 512 * i; if (p < 65 * 40) { const int rr = p / 40, sg = p - rr * 40, seg = sg >> 3, o8 = sg & 7; *(LAS u32x4*)(zraw + rr * 320 + seg * 64 + o8 * 8) = rg[i]; } }
        LBAR();
        float r_[8], kx[8], v_[8];
        {
            const float fp0 = (c != 0) ? 1.f : 0.f;
            float zz[9][5];
#pragma unroll
            for (int rr = 0; rr < 9; ++rr) { const LAS bf16_t* zp_ = zraw + (g * 8 + rr) * 320 + k;
#pragma unroll
                for (int sg = 0; sg < 5; ++sg) zz[rr][sg] = bf2f(zp_[sg * 64]); }
            if (g == 0) {
#pragma unroll
                for (int sg = 0; sg < 5; ++sg) zz[0][sg] *= fp0; }
#pragma unroll
            for (int j = 0; j < 8; ++j) { const int t = g * 8 + j;
                const float c0 = zz[j + 1][0], c1 = zz[j + 1][1], c2 = zz[j + 1][2], c3 = zz[j + 1][3], c4 = zz[j + 1][4];
                const float p0 = zz[j][0], p1 = zz[j][1], p2 = zz[j][2], p3 = zz[j][3], p4 = zz[j][4];
                r_[j] = c0 + (p0 - c0) * mur; kx[j] = c1 + (p1 - c1) * muk; v_[j] = c2 + (p2 - c2) * muv;
                const float wd = c3 + (p3 - c3) * muwd, ad = c4 + (p4 - c4) * muad;
                const float e2 = __expf(2.0f * wd);
                S_(0)[t * 72 + k] = f2bf(1.0f - 2.0f * __builtin_amdgcn_rcpf(e2 + 1.0f)); S_(1)[t * 72 + k] = f2bf(ad); }
        }
        LBAR();
        f32x4 acc[2];
        ZACC(); mm_nt(S_(0), S_(15), it, jt0, fr, fq, acc);
#pragma unroll
        for (int u = 0; u < 2; ++u) *(LAS f32x4*)(LWf + irow * 64 + (jt0 + u) * 16 + 4 * fq) = acc[u];
        ZACC(); mm_nt(S_(1), S_(16), it, jt0, fr, fq, acc);
#pragma unroll
        for (int u = 0; u < 2; ++u) *(LAS f32x4*)(LAf + irow * 64 + (jt0 + u) * 16 + 4 * fq) = acc[u];
        LBAR();
        {
            float ev[8], cs[8], qn[8], bbv[8], kpv[8]; float run = 0.f;
#pragma unroll
            for (int j = 0; j < 8; ++j) { const int t = g * 8 + j;
                const float e = 0.60653065971f * sigmoidf_(w0k + LWf[t * 64 + k]); const float al = sigmoidf_(a0k + LAf[t * 64 + k]);
                const float kq = kx[j] * kkk, kp = kx[j] * (1.0f + (al - 1.0f) * kak);
                float ss = kq * kq, rs_ = r_[j] * kp * rkk;
                ss = rowsum16(ss); rs_ = rowsum16(rs_);
                ss += __shfl_xor(ss, 16); rs_ += __shfl_xor(rs_, 16); ss += __shfl_xor(ss, 32); rs_ += __shfl_xor(rs_, 32);
                const float inv = __builtin_amdgcn_rsqf(fmaxf(ss, 1e-24f));
                qn[j] = kq * inv; bbv[j] = qn[j] * al; kpv[j] = kp;
                if (lane == 0) RK[(size_t)unit * 64 + t] = rs_;
                ev[j] = e; run += e; cs[j] = run; }
            tot[g * 64 + k] = run;
            LBAR();
            float off = 0.f;
#pragma unroll
            for (int gg = 0; gg < 7; ++gg) { const float tv = tot[gg * 64 + k]; off += gg < g ? tv : 0.f; }
            float ak[8], bk[8], kk_[8];
#pragma unroll
            for (int j = 0; j < 8; ++j) { const int t = g * 8 + j; const float cum = off + cs[j];
                const float P = __expf(-cum), Pm1 = __expf(ev[j] - cum), iP = __builtin_amdgcn_rcpf(P);
                const float at = -qn[j] * Pm1, bt = bbv[j] * iP, kt = kpv[j] * iP, rt = r_[j] * P;
                S_(0)[t * 72 + k] = f2bf(at); S_(1)[t * 72 + k] = f2bf(bt); S_(2)[t * 72 + k] = f2bf(kt); S_(3)[t * 72 + k] = f2bf(rt);
                ak[j] = at; bk[j] = bt; kk_[j] = kt;
                if (j == 7 && g == 7) pc[k] = P; }
            *(LAS u32x4*)(S_(4) + k * 72 + g * 8) = pack8(ak); *(LAS u32x4*)(S_(5) + k * 72 + g * 8) = pack8(bk);
            *(LAS u32x4*)(S_(6) + k * 72 + g * 8) = pack8(kk_); *(LAS u32x4*)(S_(7) + k * 72 + g * 8) = pack8(v_);
        }
        LBAR();
        { const int nxt = (unit + G < 2048) ? unit + G : unit; P3A_LOAD(nxt); }
        ZACC(); mm_nt(S_(0), S_(1), it, jt0, fr, fq, acc);
#pragma unroll
        for (int u = 0; u < 2; ++u) { const int j0 = (jt0 + u) * 16 + 4 * fq; f32x4 v = mask4<1>(acc[u], irow, j0); st4(S_(11), irow, j0, v); st4t(S_(12), irow, j0, v);
#pragma unroll
            for (int e = 0; e < 4; ++e) v[e] += (j0 + e == irow) ? 1.f : 0.f;
            st4(S_(13), irow, j0, v); }
        ZACC(); mm_nt(S_(0), S_(2), it, jt0, fr, fq, acc);
#pragma unroll
        for (int u = 0; u < 2; ++u) { const int j0 = (jt0 + u) * 16 + 4 * fq; st4(S_(8), irow, j0, mask4<1>(acc[u], irow, j0)); }
        ZACC(); mm_nt(S_(3), S_(1), it, jt0, fr, fq, acc);
#pragma unroll
        for (int u = 0; u < 2; ++u) { const int j0 = (jt0 + u) * 16 + 4 * fq; st4(S_(9), irow, j0, mask4<3>(acc[u], irow, j0)); }
        ZACC(); mm_nt(S_(3), S_(2), it, jt0, fr, fq, acc);
#pragma unroll
        for (int u = 0; u < 2; ++u) { const int j0 = (jt0 + u) * 16 + 4 * fq; st4(S_(10), irow, j0, mask4<3>(acc[u], irow, j0)); }
        LBAR();
        ZACC(); mm_nt(S_(11), S_(12), it, jt0, fr, fq, acc);
#pragma unroll
        for (int u = 0; u < 2; ++u) { st4(S_(1), irow, (jt0 + u) * 16 + 4 * fq, acc[u]); st4t(S_(2), irow, (jt0 + u) * 16 + 4 * fq, acc[u]); }
        ZACC(); mm_nt(S_(7), S_(8), it, jt0, fr, fq, acc);
#pragma unroll
        for (int u = 0; u < 2; ++u) st4(S_(0), irow, (jt0 + u) * 16 + 4 * fq, acc[u]);
        LBAR();
#pragma unroll
        for (int sgi = 0; sgi < 4; ++sgi) {
            const int pa = (sgi & 1) ? 11 : 1, pta = (sgi & 1) ? 12 : 2, pb = (sgi & 1) ? 1 : 11, ptb = (sgi & 1) ? 2 : 12, tla = (sgi & 1) ? 14 : 13, tlb = (sgi & 1) ? 13 : 14;
            ZACC(); mm_nt(S_(tla), S_(pta), it, jt0, fr, fq, acc);
#pragma unroll
            for (int u = 0; u < 2; ++u) { const int j0 = (jt0 + u) * 16 + 4 * fq; st4(S_(tlb), irow, j0, acc[u] + ld4(S_(tla), irow, j0)); }
            ZACC(); mm_nt(S_(pa), S_(pta), it, jt0, fr, fq, acc);
#pragma unroll
            for (int u = 0; u < 2; ++u) { if (sgi < 3) st4(S_(pb), irow, (jt0 + u) * 16 + 4 * fq, acc[u]); st4t(S_(ptb), irow, (jt0 + u) * 16 + 4 * fq, acc[u]); }
            LBAR();
        }
        ZACC(); mm_nt(S_(13), S_(2), it, jt0, fr, fq, acc);
#pragma unroll
        for (int u = 0; u < 2; ++u) { const int j0 = (jt0 + u) * 16 + 4 * fq; st4(S_(14), irow, j0, acc[u] + ld4(S_(13), irow, j0)); }
        LBAR();
        ZACC(); mm_nt(S_(0), S_(14), it, jt0, fr, fq, acc);
#pragma unroll
        for (int u = 0; u < 2; ++u) st4(S_(1), irow, (jt0 + u) * 16 + 4 * fq, acc[u]);
        ZACC(); mm_nt(S_(4), S_(14), it, jt0, fr, fq, acc);
#pragma unroll
        for (int u = 0; u < 2; ++u) st4(S_(2), irow, (jt0 + u) * 16 + 4 * fq, acc[u]);
        LBAR();
        bf16_t* chk = CHK + (size_t)unit * 16384;
        const int j8 = jt0 * 16 + 8 * fq;
        ZACC();
        mm_nt_p(S_(9), S_(2), it, jt0, fr, fq, acc);
        { float rt8[8]; unpack8(*(const LAS u32x4*)(S_(3) + irow * 72 + j8), rt8);
          stg8(chk, irow, j8, acc[0] + (f32x4){rt8[0], rt8[1], rt8[2], rt8[3]}, acc[1] + (f32x4){rt8[4], rt8[5], rt8[6], rt8[7]}); }
        ZACC();
        mm_nt_p(S_(9), S_(1), it, jt0, fr, fq, acc);
        mm_nt_p(S_(10), S_(7), it, jt0, fr, fq, acc);
        stg8(chk + 4096, irow, j8, acc[0], acc[1]);
        ZACC();
        mm_nt_p(S_(1), S_(5), it, jt0, fr, fq, acc);
        mm_nt_p(S_(7), S_(6), it, jt0, fr, fq, acc);
        { const f32x4 pv0 = *(const LAS f32x4*)(pc + j8), pv1 = *(const LAS f32x4*)(pc + j8 + 4); stg8(chk + 8192, irow, j8, acc[0] * pv0, acc[1] * pv1); }
        ZACC();
        mm_nt_p(S_(5), S_(2), it, jt0, fr, fq, acc);
        { const float pr = pc[irow]; f32x4 v0 = acc[0], v1 = acc[1];
#pragma unroll
          for (int e = 0; e < 4; ++e) { v0[e] = (v0[e] + ((j8 + e == irow) ? 1.f : 0.f)) * pr; v1[e] = (v1[e] + ((j8 + 4 + e == irow) ? 1.f : 0.f)) * pr; }
          stg8(chk + 12288, irow, j8, v0, v1); }
        LBAR();
    }
#undef P3A_LOAD
#undef S_
}

__device__ void p3_sample_step(const Args& a, int blk, int G) {
    const int tid = threadIdx.x;
    unsigned char* ws = a.ws;
    const bf16_t* SCN = (const bf16_t*)(ws + OFF_SCNS) - (size_t)MP * 8 * 384;
    const float* state_wkv = a.in[6]; bf16_t* OS = (bf16_t*)(ws + OFF_OS);
    const int row = tid >> 3, c0 = (tid & 7) * 8;
    constexpr int NI = 4;
    for (int it0 = blk; it0 < MS * NH; it0 += G * NI) {
        u32x4 q[NI][5]; f32x4 sA[NI], sB[NI]; unsigned short vq[NI];
#pragma unroll
        for (int n = 0; n < NI; ++n) { const int itn = (it0 + n * G < MS * NH) ? it0 + n * G : it0; const int s_ = itn >> 3, h = itn & 7, m = MP + s_;
            const bf16_t* sc = SCN + ((size_t)m * 8 + h) * 384; const size_t so = ((size_t)(s_ * 8 + h) * 64 + row) * 64 + c0;
            q[n][0] = *(const u32x4*)(sc + c0); q[n][1] = *(const u32x4*)(sc + 64 + c0); q[n][2] = *(const u32x4*)(sc + 128 + c0); q[n][3] = *(const u32x4*)(sc + 256 + c0); q[n][4] = *(const u32x4*)(sc + 320 + c0);
            vq[n] = sc[192 + row]; sA[n] = *(const f32x4*)(state_wkv + so); sB[n] = *(const f32x4*)(state_wkv + so + 4); }
#pragma unroll
        for (int n = 0; n < NI; ++n) { const int itn = it0 + n * G; if (itn < MS * NH) { const int s_ = itn >> 3, h = itn & 7;
            float r_[8], e_[8], kp[8], kq[8], bb[8];
            unpack8(q[n][0], r_); unpack8(q[n][1], e_); unpack8(q[n][2], kp); unpack8(q[n][3], kq); unpack8(q[n][4], bb);
            const float vv = bf2f(vq[n]);
            const size_t so = ((size_t)(s_ * 8 + h) * 64 + row) * 64 + c0;
            float S[8] = {sA[n][0], sA[n][1], sA[n][2], sA[n][3], sB[n][0], sB[n][1], sB[n][2], sB[n][3]};
            float d = 0.f;
#pragma unroll
            for (int i = 0; i < 8; ++i) d += S[i] * kq[i];
            d += __shfl_xor(d, 1); d += __shfl_xor(d, 2); d += __shfl_xor(d, 4);
            float y = 0.f;
#pragma unroll
            for (int i = 0; i < 8; ++i) { S[i] = S[i] * __expf(-e_[i]) + (-d) * bb[i] + vv * kp[i]; y += S[i] * r_[i]; }
            y += __shfl_xor(y, 1); y += __shfl_xor(y, 2); y += __shfl_xor(y, 4);
            *(f32x4*)(a.out + O_WKVS + so) = (f32x4){S[0], S[1], S[2], S[3]}; *(f32x4*)(a.out + O_WKVS + so + 4) = (f32x4){S[4], S[5], S[6], S[7]};
            if ((tid & 7) == 0) OS[(size_t)s_ * 512 + h * 64 + row] = f2bf(y); } }
    }
}

__device__ void p3b_seq(const Args& a, LAS unsigned char* lds) {
    const int tid = threadIdx.x, G = gridDim.x, blk = blockIdx.x, wave = tid >> 6, lane = tid & 63, fr = lane & 15, fq = lane >> 4;
    unsigned char* ws = a.ws;
    const bf16_t* CHK = (const bf16_t*)(ws + OFF_CHK); bf16_t* SALL = (bf16_t*)(ws + OFF_SALL);
    LAS bf16_t* Shi = (LAS bf16_t*)lds; LAS bf16_t* Slo = Shi + 2 * 16 * 72;
    for (int item = blk; item < 256; item += G) {
        const int xcd_ = item & 7, idx_ = item >> 3;
        const int bh = (G == 256) ? xcd_ * 8 + (idx_ >> 2) : (item >> 2), q = (G == 256) ? (idx_ & 3) : (item & 3), j = wave;
        LBAR();
        for (int i = tid; i < 16 * 72; i += 512) { Shi[i] = 0; Slo[i] = 0; }
        LBAR();
        const bf16_t* chk0 = CHK + (size_t)(bh * 32) * 16384;
        constexpr int PF = 8;
        const size_t goff = 12288 + (size_t)(j * 16 + fr) * 64 + fq * 8, hoff = 8192 + (size_t)(q * 16 + fr) * 64 + j * 16 + 4 * fq;
        bf16x8 GA0[PF], GA1[PF], GB0[PF], GB1[PF]; u32x2 HA[PF], HB[PF];
#define P3B_LOAD(G0, G1, HQ, c0) do { if (wave < 4) { _Pragma("unroll") for (int u = 0; u < PF; ++u) { const bf16_t* cn = chk0 + (size_t)((c0) + u) * 16384; \
            G0[u] = *(const bf16x8*)(cn + goff); G1[u] = *(const bf16x8*)(cn + goff + 32); HQ[u] = *(const u32x2*)(cn + hoff); } } } while (0)
#define P3B_STEPS(G0, G1, HQ, c0) do { _Pragma("unroll") for (int u = 0; u < PF; ++u) { const int c = (c0) + u; \
            if (wave < 4) { \
                const bf16x8 cg0 = G0[u], cg1 = G1[u]; const u32x2 chq = HQ[u]; \
                const LAS bf16_t* sh = Shi + (c & 1) * (16 * 72) + fr * 72 + fq * 8; const LAS bf16_t* sl = Slo + (c & 1) * (16 * 72) + fr * 72 + fq * 8; \
                const bf16x8 h0 = *(const LAS bf16x8*)sh, h1 = *(const LAS bf16x8*)(sh + 32), l0 = *(const LAS bf16x8*)sl, l1 = *(const LAS bf16x8*)(sl + 32); \
                bf16_t* sg = SALL + (size_t)(bh * 32 + c) * 4096 + (q * 16 + fr) * 64 + fq * 8; \
                if (wave == 0) *(bf16x8*)sg = h0; \
                if (wave == 1) *(bf16x8*)(sg + 32) = h1; \
                f32x4 acc = {0.f, 0.f, 0.f, 0.f}; \
                acc = __builtin_amdgcn_mfma_f32_16x16x32_bf16(cg0, h0, acc, 0, 0, 0); acc = __builtin_amdgcn_mfma_f32_16x16x32_bf16(cg1, h1, acc, 0, 0, 0); \
                acc = __builtin_amdgcn_mfma_f32_16x16x32_bf16(cg0, l0, acc, 0, 0, 0); acc = __builtin_amdgcn_mfma_f32_16x16x32_bf16(cg1, l1, acc, 0, 0, 0); \
                float hv[4]; unpack4(chq, hv); \
                const float s0 = acc[0] + hv[0], s1 = acc[1] + hv[1], s2 = acc[2] + hv[2], s3 = acc[3] + hv[3]; \
                const u32x2 ph = pack4(s0, s1, s2, s3); float hf[4]; unpack4(ph, hf); \
                const u32x2 pl = pack4(s0 - hf[0], s1 - hf[1], s2 - hf[2], s3 - hf[3]); \
                const int wo = ((c + 1) & 1) * (16 * 72) + fr * 72 + j * 16 + 4 * fq; \
                *(LAS u32x2*)(Shi + wo) = ph; *(LAS u32x2*)(Slo + wo) = pl; \
                if (c == 31) *(f32x4*)(a.out + O_WKVP + ((size_t)bh * 64 + q * 16 + fr) * 64 + j * 16 + 4 * fq) = (f32x4){s0, s1, s2, s3}; \
            } \
            LBAR(); } } while (0)
        P3B_LOAD(GA0, GA1, HA, 0); P3B_LOAD(GB0, GB1, HB, 8);
        P3B_STEPS(GA0, GA1, HA, 0); P3B_LOAD(GA0, GA1, HA, 16);
        P3B_STEPS(GB0, GB1, HB, 8); P3B_LOAD(GB0, GB1, HB, 24);
        P3B_STEPS(GA0, GA1, HA, 16);
        P3B_STEPS(GB0, GB1, HB, 24);
#undef P3B_LOAD
#undef P3B_STEPS
    }
}

__device__ void p3c_out(const Args& a) {
    const int tid = threadIdx.x, G = gridDim.x, blk = blockIdx.x, wave = tid >> 6, lane = tid & 63, fr = lane & 15, fq = lane >> 4;
    unsigned char* ws = a.ws;
    const bf16_t* SCN = (const bf16_t*)(ws + OFF_SCNS) - (size_t)MP * 8 * 384; const bf16_t* CHK = (const bf16_t*)(ws + OFF_CHK); const bf16_t* SALL = (const bf16_t*)(ws + OFF_SALL); bf16_t* YC = (bf16_t*)a.out;
    const bf16_t* Z = (const bf16_t*)(ws + OFF_Z); const float* RK = (const float*)(ws + OFF_RK); const float* mu = a.in[10];
    const float* r_k = a.in[17]; const float* ln_w = a.in[18]; const float* ln_b = a.in[19];
    for (int pi = blk; pi < 1024; pi += G) {
        const int unit = pi * 2 + (wave >> 2), it = wave & 3, bh = unit >> 5, c = unit & 31, b = bh >> 3, h = bh & 7;
        const int m = b * TSEQ + c * 64 + it * 16 + fr;
        const bf16_t* chk = CHK + (size_t)unit * 16384; const bf16_t* sall = SALL + (size_t)unit * 4096;
        bf16x8 xq[2];
#pragma unroll
        for (int ks = 0; ks < 2; ++ks) xq[ks] = *(const bf16x8*)(chk + (it * 16 + fr) * 64 + ks * 32 + fq * 8);
        const bool hasprev = (c * 64 + it * 16 + fr) >= 1;
        const bf16_t* zv = Z + (size_t)m * NZ + ZC_S + 1024 + h * 64 + 8 * fq; const bf16_t* zvp = hasprev ? zv - NZ : zv; const float fpv = hasprev ? 1.f : 0.f;
        const float rk = RK[(size_t)unit * 64 + it * 16 + fr];
        bf16_t* yp = YC + (size_t)m * D + 512 + h * 64 + 8 * fq;
        f32x4 acc[4]; u32x4 qy[2], qv[2], qvp[2], qg[2];
#pragma unroll
        for (int P = 0; P < 2; ++P) { qy[P] = *(const u32x4*)(chk + 4096 + (it * 16 + fr) * 64 + 32 * P + 8 * fq);
            qv[P] = *(const u32x4*)(zv + 32 * P); qvp[P] = *(const u32x4*)(zvp + 32 * P); qg[P] = *(const u32x4*)(zv + (ZC_GR - ZC_S - 1024) + 32 * P); }
#pragma unroll
        for (int jt = 0; jt < 4; ++jt) { acc[jt] = (f32x4){0.f, 0.f, 0.f, 0.f}; const int srow = 32 * (jt >> 1) + 8 * (fr >> 2) + 4 * (jt & 1) + (fr & 3);
#pragma unroll
            for (int ks = 0; ks < 2; ++ks) acc[jt] = __builtin_amdgcn_mfma_f32_16x16x32_bf16(*(const bf16x8*)(sall + srow * 64 + ks * 32 + fq * 8), xq[ks], acc[jt], 0, 0, 0);
        }
        float o[2][8], vv[2][8]; float sm = 0.f;
#pragma unroll
        for (int P = 0; P < 2; ++P) { float yl[8], vc[8], vp[8]; unpack8(qy[P], yl); unpack8(qv[P], vc); unpack8(qvp[P], vp);
            const float* mvp = mu + 1024 + h * 64 + 32 * P + 8 * fq; const f32x4 mv0 = *(const f32x4*)mvp, mv1 = *(const f32x4*)(mvp + 4);
#pragma unroll
            for (int i = 0; i < 8; ++i) { const float mvi = i < 4 ? mv0[i & 3] : mv1[i & 3]; o[P][i] = acc[2 * P + (i >> 2)][i & 3] + yl[i]; sm += o[P][i]; vv[P][i] = vc[i] + (vp[i] * fpv - vc[i]) * mvi; } }
        sm += __shfl_xor(sm, 16); sm += __shfl_xor(sm, 32);
        const float mean = sm * (1.0f / 64.0f); float var = 0.f;
#pragma unroll
        for (int P = 0; P < 2; ++P)
#pragma unroll
            for (int i = 0; i < 8; ++i) { o[P][i] -= mean; var += o[P][i] * o[P][i]; }
        var += __shfl_xor(var, 16); var += __shfl_xor(var, 32);
        const float rstd = rsqrtf(var * (1.0f / 64.0f) + 64e-5f);
#pragma unroll
        for (int P = 0; P < 2; ++P) { const int ch = h * 64 + 32 * P + 8 * fq; const f32x4 lw0 = *(const f32x4*)(ln_w + ch), lw1 = *(const f32x4*)(ln_w + ch + 4), lb0 = *(const f32x4*)(ln_b + ch), lb1 = *(const f32x4*)(ln_b + ch + 4);
            float gt[8], y[8]; unpack8(qg[P], gt);
#pragma unroll
            for (int i = 0; i < 8; ++i) gt[i] = siluf_(gt[i]);
#pragma unroll
            for (int i = 0; i < 8; ++i) { const float lwi = i < 4 ? lw0[i & 3] : lw1[i & 3], lbi = i < 4 ? lb0[i & 3] : lb1[i & 3]; y[i] = (o[P][i] * rstd * lwi + lbi + rk * vv[P][i]) * gt[i]; }
            *(u32x4*)(yp + 32 * P) = pack8(y); }
    }
    const bf16_t* OS = (const bf16_t*)(ws + OFF_OS);
    const int c = lane * 8, h = lane >> 3, cc = (lane & 7) * 8;
    for (int s = blk * 8 + wave; s < MS; s += G * 8) {
        const int m = MP + s;
        float o[8], r_[8], kp[8], v_[8], g[8];
        const bf16_t* sc = SCN + ((size_t)m * 8 + h) * 384 + cc;
        unpack8(*(const u32x4*)(OS + (size_t)s * 512 + c), o); unpack8(*(const u32x4*)(sc), r_); unpack8(*(const u32x4*)(sc + 128), kp); unpack8(*(const u32x4*)(sc + 192), v_);
        unpack8(*(const u32x4*)(YC + (size_t)m * D + 512 + c), g);
        float sm = 0.f, rk = 0.f;
#pragma unroll
        for (int i = 0; i < 8; ++i) { sm += o[i]; rk += r_[i] * kp[i] * r_k[h * 64 + cc + i]; }
        sm += __shfl_xor(sm, 1); sm += __shfl_xor(sm, 2); sm += __shfl_xor(sm, 4);
        rk += __shfl_xor(rk, 1); rk += __shfl_xor(rk, 2); rk += __shfl_xor(rk, 4);
        const float mean = sm * (1.0f / 64.0f);
        float var = 0.f;
#pragma unroll
        for (int i = 0; i < 8; ++i) { o[i] -= mean; var += o[i] * o[i]; }
        var += __shfl_xor(var, 1); var += __shfl_xor(var, 2); var += __shfl_xor(var, 4);
        const float rstd = rsqrtf(var * (1.0f / 64.0f) + 64e-5f);
        float y[8];
#pragma unroll
        for (int i = 0; i < 8; ++i) y[i] = (o[i] * rstd * ln_w[c + i] + ln_b[c + i] + rk * v_[i]) * g[i];
        *(u32x4*)(YC + (size_t)m * D + 512 + c) = pack8(y);
    }
}

__device__ void p5_out(const Args& a, LAS unsigned char* lds) {
    const int tid = threadIdx.x, G = gridDim.x, blk = blockIdx.x, wave = tid >> 6, lane = tid & 63, fr = lane & 15, fq = lane >> 4;
    unsigned char* ws = a.ws;
    const bf16_t* YC = (const bf16_t*)a.out; const bf16_t* WoutT = (const bf16_t*)(ws + OFF_WOUT); const bf16_t* PB = (const bf16_t*)(ws + OFF_PB); const bf16_t* WppT = (const bf16_t*)(ws + OFF_WPP);
    bf16_t* H1B = (bf16_t*)(ws + OFF_H1B); bf16_t* PP = (bf16_t*)((unsigned char*)a.out + PPD_OFF);
    { pg8::Gemm g{YC, WoutT, MP, D, D}; pg8::StaticOrder S; S.init(MP, D, G, blk); EpiH1 E{a.in[0], H1B}; pg8::gemm_phase<EpiH1, pg8::StaticOrder>(lds, g, S, E, nullptr); }
    for (int t2 = blk; t2 < 256; t2 += G) {
        const int tile = t2 * 2 + (wave >> 2), ks = wave & 3, rt = tile & 7, ct = tile >> 3; const int row = MP + rt * 16 + fr; const size_t o = (size_t)row * D + ct * 16 + 4 * fq;
        f32x4 acc = mini_tile_k<8>(YC + (size_t)row * D + ks * 256, WoutT + (size_t)(ct * 16 + fr) * D + ks * 256, fq);
        f32x4 acp = mini_tile_k<2>(PB + (size_t)row * DP + ks * 64, WppT + (size_t)(ct * 16 + fr) * DP + ks * 64, fq);
        acc = splitk_reduce(lds, acc, wave, lane);
        acp = splitk_reduce(lds, acp, wave, lane);
        if (ks == 0) {
            const f32x4 v = *(const f32x4*)(a.in[1] + (size_t)(row - MP) * D + ct * 16 + 4 * fq) + acc;
            *(u32x2*)(H1B + o) = pack4(v[0], v[1], v[2], v[3]);
            *(u32x2*)(PP + o) = pack4(acp[0], acp[1], acp[2], acp[3]);
        }
    }
}

__device__ void p6_gate(const Args& a, LAS unsigned char* lds) {
    const int tid = threadIdx.x, G = gridDim.x, blk = blockIdx.x, wave = tid >> 6, lane = tid & 63, fr = lane & 15, fq = lane >> 4;
    unsigned char* ws = a.ws;
    const bf16_t* WpgT = (const bf16_t*)(ws + OFF_WPG); const bf16_t* H1B = (const bf16_t*)(ws + OFF_H1B); const bf16_t* PP = (const bf16_t*)((const unsigned char*)a.out + PPD_OFF);
    { pg8::Gemm g{H1B, WpgT, MP, D, D}; pg8::StaticOrder S; S.init(MP, D, G, blk); EpiH2 E{H1B, PP, (bf16_t*)(ws + OFF_H2B)}; pg8::gemm_phase<EpiH2, pg8::StaticOrder>(lds, g, S, E, nullptr); }
    for (int t2 = blk; t2 < 256; t2 += G) {
        const int tile = t2 * 2 + (wave >> 2), ks = wave & 3, rt = tile & 7, ct = tile >> 3; const int row = MP + rt * 16 + fr; const size_t o = (size_t)row * D + ct * 16 + 4 * fq;
        f32x4 g = mini_tile_k<8>(H1B + (size_t)row * D + ks * 256, WpgT + (size_t)(ct * 16 + fr) * D + ks * 256, fq);
        g = splitk_reduce(lds, g, wave, lane);
        if (ks == 0) {
            float h[4], p[4]; unpack4(*(const u32x2*)(H1B + o), h); unpack4(*(const u32x2*)(PP + o), p);
            f32x4 v; v[0] = h[0] + sigmoidf_(g[0]) * p[0]; v[1] = h[1] + sigmoidf_(g[1]) * p[1]; v[2] = h[2] + sigmoidf_(g[2]) * p[2]; v[3] = h[3] + sigmoidf_(g[3]) * p[3];
            *(u32x2*)((bf16_t*)(ws + OFF_H2B) + o) = pack4(v[0], v[1], v[2], v[3]);
        }
    }
}

__device__ void p7_norm(const Args& a) {
    const int tid = threadIdx.x, G = gridDim.x, blk = blockIdx.x, wave = tid >> 6, lane = tid & 63;
    const float* fg = a.in[23]; const bf16_t* H2B = (const bf16_t*)(a.ws + OFF_H2B);
    f32x4 gv[2][2];
#pragma unroll
    for (int i = 0; i < 2; ++i) { gv[i][0] = *(const f32x4*)(fg + i * 512 + lane * 8); gv[i][1] = *(const f32x4*)(fg + i * 512 + lane * 8 + 4); }
    for (int row0 = (blk * 8 + wave) * 4; row0 < MT; row0 += G * 32) {
        u32x4 q[4][2];
#pragma unroll
        for (int r = 0; r < 4; ++r)
#pragma unroll
            for (int i = 0; i < 2; ++i) q[r][i] = *(const u32x4*)(H2B + (size_t)(row0 + r) * D + i * 512 + lane * 8);
#pragma unroll
        for (int r = 0; r < 4; ++r) { float f[2][8]; unpack8(q[r][0], f[0]); unpack8(q[r][1], f[1]); float ss = 0.f;
#pragma unroll
            for (int i = 0; i < 2; ++i)
#pragma unroll
                for (int e = 0; e < 8; ++e) ss += f[i][e] * f[i][e];
#pragma unroll
            for (int o = 32; o >= 1; o >>= 1) ss += __shfl_xor(ss, o);
            const float rs = rsqrtf(ss * (1.0f / D) + 1e-6f);
#pragma unroll
            for (int i = 0; i < 2; ++i) { float* yp = a.out + (size_t)(row0 + r) * D + i * 512 + lane * 8;
                *(f32x4*)(yp) = (f32x4){f[i][0], f[i][1], f[i][2], f[i][3]} * rs * gv[i][0]; *(f32x4*)(yp + 4) = (f32x4){f[i][4], f[i][5], f[i][6], f[i][7]} * rs * gv[i][1]; } }
    }
}

#define XB_TMO      128
#define XB_XCNT(j)  (256  + 64 * (j))
#define XB_XSUB(j)  (1280 + 64 * (j))
#define XB_XGEN(j)  (2304 + 64 * (j))
#define XB_TOP      3328
#define XB_TOPGEN   3392
#define XCD_BAR_WORDS 3456
#define XB_SPIN_CAP (1u << 18)

__device__ __forceinline__ unsigned xb_ld(unsigned* p)              { return __hip_atomic_load(p, __ATOMIC_RELAXED, __HIP_MEMORY_SCOPE_AGENT); }
__device__ __forceinline__ unsigned xb_add(unsigned* p, unsigned v) { return __hip_atomic_fetch_add(p, v, __ATOMIC_RELAXED, __HIP_MEMORY_SCOPE_AGENT); }
__device__ __forceinline__ unsigned xb_xcc_id() { return (unsigned)__builtin_amdgcn_s_getreg((3 << 11) | 20) & 0xFu; }
#define XB_SPIN(cond, bar) do { unsigned _sp = 0; while (cond) { __builtin_amdgcn_s_sleep(1); \
    if ((++_sp & 255u) == 0u) { if (xb_ld(&(bar)[XB_TMO])) break; if (_sp > XB_SPIN_CAP) { atomicAdd(&(bar)[XB_TMO], 1u); break; } } } } while (0)

struct XcdBarrier {
    unsigned* bar; unsigned x;
    volatile LAS unsigned* st;
};

__device__ __forceinline__ XcdBarrier xcd_barrier_post(unsigned* bar, volatile LAS unsigned* st) {
    XcdBarrier b; b.bar = bar; b.x = xb_xcc_id(); b.st = st;
    if (threadIdx.x == 0) (void)xb_add(&bar[XB_XCNT(b.x)], 1u);
    return b;
}
__device__ __forceinline__ void xcd_barrier_complete(unsigned* bar, unsigned x, unsigned& nloc, unsigned& nx) {
    const unsigned G = gridDim.x * gridDim.y * gridDim.z;
    unsigned sum, cnt, mine, sp = 0u;
    for (;;) {
        sum = 0u; cnt = 0u; mine = 0u;
#pragma unroll
        for (unsigned j = 0; j < 16; ++j) { const unsigned c = xb_ld(&bar[XB_XCNT(j)]); sum += c; cnt += (c > 0u) ? 1u : 0u; mine = (j == x) ? c : mine; }
        if (sum == G) break;
        __builtin_amdgcn_s_sleep(1);
        if ((++sp & 255u) == 0u) { if (xb_ld(&bar[XB_TMO])) break; if (sp > XB_SPIN_CAP) { atomicAdd(&bar[XB_TMO], 1u); break; } }
    }
    nloc = mine > 0u ? mine : 1u; nx = cnt > 0u ? cnt : 1u;
}

__device__ __forceinline__ void xcd_barrier(const XcdBarrier& b) {
    asm volatile("s_waitcnt vmcnt(0)" ::: "memory");
    __syncthreads();
    if (threadIdx.x == 0) {
        unsigned* bar = b.bar;
        __builtin_amdgcn_s_waitcnt(0);
        unsigned nloc = b.st[0], nx = b.st[1];
        if (nloc == 0u) { xcd_barrier_complete(bar, b.x, nloc, nx); b.st[0] = nloc; b.st[1] = nx; }
        const unsigned old = xb_add(&bar[XB_XSUB(b.x)], 1u);
        const unsigned gen = old / nloc;
        if (old + 1u == (gen + 1u) * nloc) {
            __builtin_amdgcn_fence(__ATOMIC_RELEASE, "agent");
            asm volatile("s_waitcnt vmcnt(0)" ::: "memory");
            const unsigned og = xb_add(&bar[XB_TOP], 1u);
            const unsigned tg = og / nx;
            if (og + 1u == (tg + 1u) * nx) xb_add(&bar[XB_TOPGEN], 1u);
            else XB_SPIN(xb_ld(&bar[XB_TOPGEN]) == tg, bar);
            __builtin_amdgcn_fence(__ATOMIC_ACQUIRE, "agent");
            xb_add(&bar[XB_XGEN(b.x)], 1u);
            asm volatile("s_waitcnt vmcnt(0)" ::: "memory");
        } else {
            XB_SPIN(xb_ld(&bar[XB_XGEN(b.x)]) == gen, bar);
            __builtin_amdgcn_fence(__ATOMIC_ACQUIRE, "agent");
            asm volatile("s_waitcnt vmcnt(0)" ::: "memory");
        }
    }
    __syncthreads();
}

__global__ void __launch_bounds__(512, 2) fwd(Args a) {
    extern __shared__ __attribute__((aligned(16))) unsigned char lds_raw[];
    LAS unsigned char* lds = (LAS unsigned char*)lds_raw;
    cg::grid_group grid = cg::this_grid();
    volatile LAS unsigned* xst = (volatile LAS unsigned*)(lds + LDS_BYTES - 16);
    if (threadIdx.x == 0) { xst[0] = 0u; xst[1] = 0u; }
    __syncthreads();
    const XcdBarrier xb = xcd_barrier_post((unsigned*)(a.ws + OFF_BAR), xst);
    if (a.ph_hi > 1000) grid.sync();
#define IN(k) (a.ph_lo <= (k) && (k) < a.ph_hi)
#define GSYNC() xcd_barrier(xb)
#define SEAM(k) do { if (IN(k) && IN((k) + 1)) GSYNC(); } while (0)
#ifndef REP_PHASE
#define REP_PHASE -1
#endif
#define REPS(k) ((REP_PHASE == (k)) ? 2 : 1)
    if (IN(0)) for (int r = 0; r < REPS(0); ++r) { if (r) GSYNC(); p0_prep(a, lds); }
    SEAM(0);
    if (IN(1)) for (int r = 0; r < REPS(1); ++r) { if (r) GSYNC(); p1_gemm_in(a, lds); }
    SEAM(1);
    if (IN(2)) for (int r = 0; r < REPS(2); ++r) { if (r) GSYNC(); p2_all(a, lds); }
    if (IN(2) && !IN(3)) {}
    else if (!IN(2) && IN(3)) {}
    if (IN(3)) for (int r = 0; r < REPS(3); ++r) { if (r) GSYNC(); __syncthreads(); p3a_chunks(a, lds); }
    SEAM(3);
    if (IN(4)) for (int r = 0; r < REPS(4); ++r) { if (r) GSYNC(); p3b_seq(a, lds); if (r == 0) p3_sample_step(a, (int)blockIdx.x, (int)gridDim.x); }
    SEAM(4);
    if (IN(5)) p3c_out(a);
    SEAM(5);
    if (IN(6)) p5_out(a, lds);
    SEAM(6);
    if (IN(7)) p6_gate(a, lds);
    SEAM(7);
#if REP_PHASE == 99
    GSYNC(); GSYNC(); GSYNC(); GSYNC();
#endif
    if (IN(8)) p7_norm(a);
}

#ifndef N_LAUNCH_MODE
#define N_LAUNCH_MODE 1
#endif
extern "C" void kernel_launch(void* const* d_in, const int* in_sizes, int n_in, void* d_out, int out_size, void* d_ws, size_t ws_size, hipStream_t stream) {
    static int grid = 0;
    if (grid == 0) {
        if (n_in != 24 || ws_size < WS_END) { fprintf(stderr, "kernel_launch: unexpected n_in %d / ws_size %zu (need %zu)\n", n_in, ws_size, (size_t)WS_END); grid = -1; return; }
        int dev = 0, cus = 0, per_cu = 0;
        (void)hipGetDevice(&dev); (void)hipDeviceGetAttribute(&cus, hipDeviceAttributeMultiprocessorCount, dev);
        if (hipFuncSetAttribute((const void*)fwd, hipFuncAttributeMaxDynamicSharedMemorySize, LDS_BYTES) != hipSuccess) { fprintf(stderr, "kernel_launch: hipFuncSetAttribute failed\n"); grid = -1; return; }
        if (hipOccupancyMaxActiveBlocksPerMultiprocessor(&per_cu, (const void*)fwd, 512, LDS_BYTES) != hipSuccess || per_cu < 1) { fprintf(stderr, "kernel_launch: occupancy query gives %d\n", per_cu); per_cu = 1; }
        (void)hipGetLastError();
        grid = cus;
    }
    if (grid < 0) return;
    Args a{};
    for (int i = 0; i < 24; ++i) a.in[i] = (const float*)d_in[i];
    a.out = (float*)d_out; a.ws = (unsigned char*)d_ws;
    (void)hipMemsetAsync((unsigned char*)d_ws + OFF_BAR, 0, XCD_BAR_WORDS * 4, stream);
    if (N_LAUNCH_MODE == 1) {
        a.ph_lo = 0; a.ph_hi = 9;
        void* args[] = {&a};
        hipError_t e = hipLaunchCooperativeKernel((const void*)fwd, dim3(grid), dim3(512), args, LDS_BYTES, stream);
        if (e != hipSuccess) fprintf(stderr, "kernel_launch: cooperative launch failed: %s (grid %d)\n", hipGetErrorString(e), grid);
    } else {
        for (int ph = 0; ph < 9; ++ph) { a.ph_lo = ph; a.ph_hi = ph + 1; hipLaunchKernelGGL(fwd, dim3(grid), dim3(512), LDS_BYTES, stream, a); }
    }
}
```
